# Optimizing an MI355X kernel written in HIP

```python
import jax, jax.numpy as jnp
from jax import lax
import numpy as np

D_MODEL = 1024
BATCH = 1
SEQ = 16384
DEPTH = 4
DEC_BATCH = 8
DEC_SEQ = 32
PAST_LEN = 2048

CHUNK = 64
N_MIXERS = 2
N_CONV = (DEPTH + 1) // 2
N_FOX = DEPTH // 2
CONV_WIDTH = 3
N_HEADS = 16
HEAD_DIM = D_MODEL // N_HEADS
D_FF = 4 * D_MODEL
Q_BLOCK = 128
EPS = 1e-5
NEG = -1e30
FORGET_BIAS_CENTER = 2.0

kernel_name = "chunk_stream_conv_fox_hybrid"


def rmsnorm(x, g):
    xf = x.astype(jnp.float32)
    r = lax.rsqrt(jnp.mean(xf * xf, axis=-1, keepdims=True) + EPS)
    return (xf * r * g.astype(jnp.float32)).astype(x.dtype)


def conv_mixer(x, past, w_in, w_conv, w_out):
    T = x.shape[1]
    bch = x @ w_in
    b, c, h = jnp.split(bch, 3, axis=-1)
    u = c * h
    up = jnp.concatenate([past.astype(u.dtype), u], axis=1)
    conv = sum(w_conv[j] * up[:, j:j + T] for j in range(CONV_WIDTH))
    y = (b * conv) @ w_out
    return y, up[:, -(CONV_WIDTH - 1):]


def fox_project(x, w_in, b_f):
    N, T, _ = x.shape
    z = x @ w_in
    q = z[..., :D_MODEL].reshape(N, T, N_HEADS, HEAD_DIM) * (HEAD_DIM ** -0.5)
    k = z[..., D_MODEL:2 * D_MODEL].reshape(N, T, N_HEADS, HEAD_DIM)
    v = z[..., 2 * D_MODEL:3 * D_MODEL].reshape(N, T, N_HEADS, HEAD_DIM)
    logf = jax.nn.log_sigmoid((z[..., 3 * D_MODEL:] + b_f).astype(jnp.float32))
    return q, k, v, logf


def fox_prompt_attn(q, k, v, logf):
    B, S, H, Dh = q.shape
    nb = S // Q_BLOCK
    c = jnp.cumsum(logf.astype(jnp.float32), axis=1)
    c_k = c.transpose(0, 2, 1)
    kpos = jnp.arange(S)
    qb = q.reshape(B, nb, Q_BLOCK, H, Dh).transpose(1, 0, 2, 3, 4)
    cb = c.reshape(B, nb, Q_BLOCK, H).transpose(1, 0, 3, 2)

    def block(args):
        qi, ci, i = args
        qpos = i * Q_BLOCK + jnp.arange(Q_BLOCK)
        s = jnp.einsum('bqhd,bkhd->bhqk', qi, k, preferred_element_type=jnp.float32)
        s = s + ci[..., None] - c_k[:, :, None, :]
        s = jnp.where(kpos[None, :] <= qpos[:, None], s, NEG)
        p = jax.nn.softmax(s, axis=-1)
        return jnp.einsum('bhqk,bkhd->bqhd', p.astype(v.dtype), v)

    out = lax.map(block, (qb, cb, jnp.arange(nb)))
    return out.transpose(1, 0, 2, 3, 4).reshape(B, S, H * Dh)


def fox_sample_attn(q, k_all, v_all, logf_all, past_len):
    N, T, H, Dh = q.shape
    L = k_all.shape[1]
    c = jnp.cumsum(logf_all.astype(jnp.float32), axis=1).transpose(0, 2, 1)
    c_q = c[:, :, past_len:]
    s = jnp.einsum('bqhd,bkhd->bhqk', q, k_all, preferred_element_type=jnp.float32)
    s = s + c_q[..., None] - c[:, :, None, :]
    qpos = past_len + jnp.arange(T)
    kpos = jnp.arange(L)
    s = jnp.where(kpos[None, :] <= qpos[:, None], s, NEG)
    p = jax.nn.softmax(s, axis=-1)
    out = jnp.einsum('bhqk,bkhd->bqhd', p.astype(v_all.dtype), v_all)
    return out.reshape(N, T, H * Dh)


def trunk(x, conv_past, fox_past, norm_mix, norm_mlp, norm_final, conv_w_in, conv_w, conv_w_out,
          fox_w_in, fox_b_f, fox_w_out, mlp_w1, mlp_w2):
    conv_states, ks, vs, lfs = [], [], [], []
    for i in range(DEPTH):
        j = i // N_MIXERS
        h = rmsnorm(x, norm_mix[i])
        if i % N_MIXERS == 0:
            y, st = conv_mixer(h, conv_past[j], conv_w_in[j], conv_w[j], conv_w_out[j])
            conv_states.append(st)
        else:
            q, k, v, logf = fox_project(h, fox_w_in[j], fox_b_f[j])
            if fox_past is None:
                o = fox_prompt_attn(q, k, v, logf)
            else:
                ck, cv, cl = fox_past
                k_all = jnp.concatenate([ck[j].astype(k.dtype), k], axis=1)
                v_all = jnp.concatenate([cv[j].astype(v.dtype), v], axis=1)
                l_all = jnp.concatenate([cl[j].astype(jnp.float32), logf], axis=1)
                o = fox_sample_attn(q, k_all, v_all, l_all, ck.shape[2])
            y = o @ fox_w_out[j]
            ks.append(k)
            vs.append(v)
            lfs.append(logf)
        x = x + y
        h = rmsnorm(x, norm_mlp[i])
        x = x + jnp.square(jax.nn.relu(h @ mlp_w1[i])) @ mlp_w2[i]
    x = rmsnorm(x, norm_final)
    return x, jnp.stack(conv_states), jnp.stack(ks), jnp.stack(vs), jnp.stack(lfs)


def setup_inputs(seed: int = 0) -> dict:
    key = jax.random.key(seed)
    ks = jax.random.split(key, 20)
    f32 = jnp.float32
    nrm = lambda k, shape, scale: jax.random.normal(k, shape, f32) * scale
    d = D_MODEL
    return {
        "x_prompt": nrm(ks[0], (BATCH, SEQ, d), 1.0),
        "x_sample": nrm(ks[1], (DEC_BATCH, DEC_SEQ, d), 1.0),
        "state_conv": nrm(ks[2], (N_CONV, DEC_BATCH, CONV_WIDTH - 1, d), 1.0),
        "cache_k": nrm(ks[3], (N_FOX, DEC_BATCH, PAST_LEN, N_HEADS, HEAD_DIM), 1.0),
        "cache_v": nrm(ks[4], (N_FOX, DEC_BATCH, PAST_LEN, N_HEADS, HEAD_DIM), 1.0),
        "cache_logf": jax.nn.log_sigmoid(FORGET_BIAS_CENTER + nrm(ks[5], (N_FOX, DEC_BATCH, PAST_LEN, N_HEADS), 1.0)),
        "norm_mix": 1.0 + nrm(ks[6], (DEPTH, d), 0.02),
        "norm_mlp": 1.0 + nrm(ks[7], (DEPTH, d), 0.02),
        "norm_final": 1.0 + nrm(ks[8], (d,), 0.02),
        "conv_w_in": nrm(ks[9], (N_CONV, d, 3 * d), d ** -0.5),
        "conv_w": nrm(ks[10], (N_CONV, CONV_WIDTH, d), CONV_WIDTH ** -0.5),
        "conv_w_out": nrm(ks[11], (N_CONV, d, d), d ** -0.5),
        "fox_w_in": nrm(ks[12], (N_FOX, d, 3 * d + N_HEADS), d ** -0.5),
        "fox_b_f": FORGET_BIAS_CENTER + nrm(ks[13], (N_FOX, N_HEADS), 0.5),
        "fox_w_out": nrm(ks[14], (N_FOX, d, d), d ** -0.5),
        "mlp_w1": nrm(ks[15], (DEPTH, d, D_FF), d ** -0.5),
        "mlp_w2": nrm(ks[16], (DEPTH, D_FF, d), D_FF ** -0.5),
    }


def reference(x_prompt, x_sample, state_conv, cache_k, cache_v, cache_logf, norm_mix, norm_mlp,
              norm_final, conv_w_in, conv_w, conv_w_out, fox_w_in, fox_b_f, fox_w_out, mlp_w1, mlp_w2):
    weights = (norm_mix, norm_mlp, norm_final, conv_w_in, conv_w, conv_w_out,
               fox_w_in, fox_b_f, fox_w_out, mlp_w1, mlp_w2)
    zero_conv = jnp.zeros((N_CONV, x_prompt.shape[0], CONV_WIDTH - 1, D_MODEL), x_prompt.dtype)
    y_prompt, p_conv, p_k, p_v, p_logf = trunk(x_prompt, zero_conv, None, *weights)
    y_sample, s_conv, s_k, s_v, s_logf = trunk(x_sample, state_conv, (cache_k, cache_v, cache_logf), *weights)
    return (y_prompt, y_sample, p_conv, p_k, p_v, p_logf, s_conv, s_k, s_v, s_logf)
```

```cpp
#include <hip/hip_runtime.h>
#include <hip/hip_cooperative_groups.h>
#include <cstdio>
#include <cstdint>
namespace cg = cooperative_groups;
#ifndef REPEAT_KIND
#define REPEAT_KIND -1
#endif
#ifndef MULTI_LAUNCH
#define MULTI_LAUNCH 0
#endif
constexpr int D = 1024, SEQ = 16384, NSB = 8, TS = 32, PAST = 2048, MS = NSB * TS, M = SEQ + MS, FF = 4096, NH = 16;
constexpr int HLD = 4096 + 64;
constexpr int LSP = 2112;
constexpr int KVROWS = SEQ + NSB * LSP;
constexpr float EPS = 1e-5f;
constexpr float LOG2E = 1.4426950408889634f;
constexpr float QC2 = 0.125f * 1.4426950408889634f;
namespace pg8 {
#define PG8_LAS __attribute__((address_space(3)))
typedef unsigned short bf16_t;
typedef short bf16x8 __attribute__((ext_vector_type(8)));
typedef float f32x4 __attribute__((ext_vector_type(4)));
typedef unsigned u32x4 __attribute__((ext_vector_type(4)));
constexpr int BM = 256, BK = 64, HALF = 128, HTB = HALF * BK * 2  , STAGE_BYTES = 8 * HTB, NXCD = 8, WGM = 8;

__host__ __device__ __forceinline__ int lds_byte(int r, int c) { const int st = (r >> 4) * 2 + (c >> 5), rr = r & 15, cc = c & 31, ob = rr * 64 + cc * 2; return st * 1024 + (ob ^ (((ob >> 9) & 1) << 5)); }
__host__ __device__ __forceinline__ void stage_rc(int b, int& R, int& C) { const int st = b / 1024, sb = b % 1024, swz = sb ^ (((sb >> 9) & 1) << 5); R = (st >> 1) * 16 + swz / 64; C = (st & 1) * 32 + (swz % 64) / 2; }
__host__ __device__ __forceinline__ int perm32(int rho) { const int n = rho >> 4, i = rho & 15; return 8 * (i >> 2) + 4 * n + (i & 3); }

struct Unit { int pm, pn; };
struct Gemm { const bf16_t* A; const bf16_t* Bt; int M, N, K, lda, ldb; };

struct StaticOrder {
    int nM, nN, nwg, G, c;
    __host__ __device__ void init(int M, int N, int G_, int c_) { nM = M / BM; nN = N / BM; nwg = nM * nN; G = G_; c = c_; }
    __host__ __device__ bool next(int i, Unit& u) const {
        const long L = (long)i * G + c; if (L >= nwg) return false;
        int wgid = (int)L; { const int q = nwg / NXCD, r = nwg % NXCD, xcd = wgid % NXCD, off = wgid / NXCD; wgid = (xcd < r ? xcd * (q + 1) : r * (q + 1) + (xcd - r) * q) + off; }
        const int nig = WGM * nN, gid = wgid / nig, fm = gid * WGM, gsz = (nM - fm) < WGM ? (nM - fm) : WGM;
        u.pm = fm + ((wgid % nig) % gsz); u.pn = (wgid % nig) / gsz; return true;
    }
    __device__ __forceinline__ void a_ready(const Unit&) const {}
    __device__ __forceinline__ void done(const Unit&) const {}
};
__device__ __forceinline__ unsigned cvt_pk_bf16(float lo, float hi) { unsigned r; asm volatile("v_cvt_pk_bf16_f32 %0, %1, %2" : "=v"(r) : "v"(lo), "v"(hi)); return r; }
typedef float f32x2 __attribute__((ext_vector_type(2)));
struct EpiG {
    static constexpr bool PERM = true, AFTER_DRAIN = false;
    int mode;
    bf16_t* O; int ldc;
    const float* rpart_in;
    float* Xf; bf16_t* Xb; float* rpart_out;
    bf16_t *Qb, *Kb, *Vb; float *outKp, *outVp, *outKs, *outVs; unsigned* qkm;
    const PG8_LAS float* rl; int pm0;
    const float* XinP;
    __device__ __forceinline__ void operator()(const f32x4 (&acc)[2][2][4][2], const Unit& u, int wr, int wc, int fr, int fq) const {
        const int rowb = u.pm * BM + wr * 64 + fr;
        const int colb = u.pn * BM + wc * 32 + 8 * fq;
        if (mode == 2) {
#pragma unroll
            for (int ai = 0; ai < 2; ++ai) {
#pragma unroll
                for (int mp = 0; mp < 2; ++mp) {
                f32x4 pre[2][2][2];
#pragma unroll
                for (int mm = 0; mm < 2; ++mm) { const float* xi = XinP + (size_t)(rowb + ai * HALF + (2 * mp + mm) * 16) * 1024 + colb;
#pragma unroll
                    for (int bj = 0; bj < 2; ++bj) { pre[mm][bj][0] = *(const f32x4*)(xi + bj * HALF); pre[mm][bj][1] = *(const f32x4*)(xi + bj * HALF + 4); } }
                asm volatile("" : "+v"(pre[0][0][0]), "+v"(pre[0][0][1]), "+v"(pre[0][1][0]), "+v"(pre[0][1][1]), "+v"(pre[1][0][0]), "+v"(pre[1][0][1]), "+v"(pre[1][1][0]), "+v"(pre[1][1][1]));
#pragma unroll
                for (int mm = 0; mm < 2; ++mm) { const int m = 2 * mp + mm;
                    const int row = rowb + ai * HALF + m * 16;
                    float* xp = Xf + (size_t)row * 1024 + colb; bf16_t* bp = Xb + (size_t)row * 1024 + colb; float ss = 0.f;
#pragma unroll
                    for (int bj = 0; bj < 2; ++bj) {
                        f32x4 x0 = pre[mm][bj][0], x1 = pre[mm][bj][1];
                        x0 += acc[ai][bj][m][0]; x1 += acc[ai][bj][m][1];
                        *(f32x4*)(xp + bj * HALF) = x0; *(f32x4*)(xp + bj * HALF + 4) = x1;
                        ss += (x0[0] * x0[0] + x0[1] * x0[1]) + (x0[2] * x0[2] + x0[3] * x0[3]) + (x1[0] * x1[0] + x1[1] * x1[1]) + (x1[2] * x1[2] + x1[3] * x1[3]);
                        u32x4 w; w.x = cvt_pk_bf16(x0[0], x0[1]); w.y = cvt_pk_bf16(x0[2], x0[3]); w.z = cvt_pk_bf16(x1[0], x1[1]); w.w = cvt_pk_bf16(x1[2], x1[3]);
                        *(u32x4*)(bp + bj * HALF) = w;
                    }
                    ss += __shfl_xor(ss, 16); ss += __shfl_xor(ss, 32);
                    if (fq == 0) rpart_out[(size_t)row * 16 + u.pn * 4 + wc] = ss;
                }
                }
            }
            return;
        }
        float rinv[2][4];
        if (u.pm == pm0) {
#pragma unroll
            for (int ai = 0; ai < 2; ++ai)
#pragma unroll
                for (int m = 0; m < 4; ++m) rinv[ai][m] = rl[wr * 64 + fr + ai * HALF + m * 16];
        } else
#pragma unroll
        for (int ai = 0; ai < 2; ++ai)
#pragma unroll
            for (int m = 0; m < 4; ++m) {
                const f32x4* rp = (const f32x4*)(rpart_in + (size_t)(rowb + ai * HALF + m * 16) * 16);
                const f32x4 a = rp[0], b = rp[1], c = rp[2], d = rp[3];
                const float s = ((a[0] + a[1]) + (a[2] + a[3])) + ((b[0] + b[1]) + (b[2] + b[3])) + ((c[0] + c[1]) + (c[2] + c[3])) + ((d[0] + d[1]) + (d[2] + d[3]));
                rinv[ai][m] = 1.0f / sqrtf(s * (1.0f / 1024.0f) + 1e-5f);
            }
        if (mode == 0 || mode == 3) {
#pragma unroll
            for (int ai = 0; ai < 2; ++ai)
#pragma unroll
                for (int m = 0; m < 4; ++m) {
                    bf16_t* rowp = O + (size_t)(rowb + ai * HALF + m * 16) * ldc + colb; const float r = rinv[ai][m];
#pragma unroll
                    for (int bj = 0; bj < 2; ++bj) {
                        f32x4 v0 = acc[ai][bj][m][0] * r, v1 = acc[ai][bj][m][1] * r;
                        if (mode == 3) {
#pragma unroll
                            for (int e = 0; e < 4; ++e) { const float a0 = fmaxf(v0[e], 0.f), a1 = fmaxf(v1[e], 0.f); v0[e] = a0 * a0; v1[e] = a1 * a1; }
                        }
                        u32x4 w; w.x = cvt_pk_bf16(v0[0], v0[1]); w.y = cvt_pk_bf16(v0[2], v0[3]); w.z = cvt_pk_bf16(v1[0], v1[1]); w.w = cvt_pk_bf16(v1[2], v1[3]);
                        *(u32x4*)(rowp + bj * HALF) = w;
                    }
                }
            return;
        }
        const int t = u.pn >> 2; const int colq = (u.pn & 3) * BM + wc * 32 + 8 * fq;
        const bool samp = (u.pm >= 64);
        float mx[2] = {0.f, 0.f};
#pragma unroll
        for (int ai = 0; ai < 2; ++ai)
#pragma unroll
            for (int m = 0; m < 4; ++m) {
                const int row = rowb + ai * HALF + m * 16; const float r = rinv[ai][m];
                const int sr = row - 16384;
                const size_t kvrow = samp ? (size_t)(16384 + (sr >> 5) * 2112 + 2048 + (sr & 31)) : (size_t)row;
#pragma unroll
                for (int bj = 0; bj < 2; ++bj) {
                    f32x4 v0 = acc[ai][bj][m][0] * r, v1 = acc[ai][bj][m][1] * r;
                    if (t < 2) {
                        float s = (v0[0] * v0[0] + v0[1] * v0[1]) + (v0[2] * v0[2] + v0[3] * v0[3]) + (v1[0] * v1[0] + v1[1] * v1[1]) + (v1[2] * v1[2] + v1[3] * v1[3]);
                        s += __shfl_xor(s, 16); s += __shfl_xor(s, 32); mx[bj] = fmaxf(mx[bj], s);
                    }
                    if (t == 0) {
                        v0 = v0 * 0.18033688011112042f; v1 = v1 * 0.18033688011112042f;
                        u32x4 w; w.x = cvt_pk_bf16(v0[0], v0[1]); w.y = cvt_pk_bf16(v0[2], v0[3]); w.z = cvt_pk_bf16(v1[0], v1[1]); w.w = cvt_pk_bf16(v1[2], v1[3]);
                        *(u32x4*)(Qb + (size_t)row * 1024 + colq + bj * HALF) = w;
                    } else {
                        u32x4 w; w.x = cvt_pk_bf16(v0[0], v0[1]); w.y = cvt_pk_bf16(v0[2], v0[3]); w.z = cvt_pk_bf16(v1[0], v1[1]); w.w = cvt_pk_bf16(v1[2], v1[3]);
                        bf16_t* kb = (t == 1 ? Kb : Vb) + kvrow * 1024 + colq + bj * HALF;
                        *(u32x4*)kb = w;
                        float* ob = samp ? ((t == 1 ? outKs : outVs) + (size_t)sr * 1024) : ((t == 1 ? outKp : outVp) + (size_t)row * 1024);
                        ob += colq + bj * HALF;
                        *(f32x4*)ob = v0; *(f32x4*)(ob + 4) = v1;
                    }
                }
            }
        if (t < 2) {
#pragma unroll
            for (int bj = 0; bj < 2; ++bj) {
                float v = mx[bj];
                v = fmaxf(v, __shfl_xor(v, 1)); v = fmaxf(v, __shfl_xor(v, 2)); v = fmaxf(v, __shfl_xor(v, 4)); v = fmaxf(v, __shfl_xor(v, 8));
                const int head = (u.pn & 3) * 4 + bj * 2 + (wc >> 1);
                if ((threadIdx.x & 63) == 0) atomicMax(qkm + t * 32 + head * 2 + (wc & 1), __float_as_uint(v));
            }
        }
    }
};
template <class Epi, class Sched, bool ALIGN_EPI = false, bool SP2 = false>
__device__ __forceinline__ void gemm_phase(PG8_LAS unsigned char* lds, const Gemm g, const Sched& S, const Epi& E) {
    const int tid = threadIdx.x, wid = __builtin_amdgcn_readfirstlane(tid >> 6), lane = tid & 63, wr = wid >> 2, wc = wid & 3, fr = lane & 15, fq = lane >> 4;
    const int K = g.K, nt = K / BK;
    unsigned voffA[2], voffB[2];
#pragma unroll
    for (int i = 0; i < 2; ++i) { int R, C; stage_rc(tid * 16 + i * 8192, R, C); const int Rb = Epi::PERM ? ((R & ~31) + perm32(R & 31)) : R;
        voffA[i] = (unsigned)(R * g.lda + C) * 2u; voffB[i] = (unsigned)(Rb * g.ldb + C) * 2u; }
    const size_t kstep = (size_t)(BK * 2);
    const size_t hstep = (size_t)HALF * g.ldb * 2;
    const size_t tstep = 2 * hstep;
    const size_t hstepA = (size_t)HALF * g.lda * 2, tstepA = 2 * hstepA;
    const unsigned ldsw = (unsigned)wid * 1024u;
    const int aoff = lds_byte(wr * 64 + fr, fq * 8), boff = lds_byte(wc * 32 + fr, fq * 8);
#define PG8_SA(b, h) (((b) * 2 + (h)) * HTB)
#define PG8_SB(b, h) ((4 + (b) * 2 + (h)) * HTB)
#define PG8_STAGE(bufoff, gbase, voff) do { _Pragma("unroll") for (int _i = 0; _i < 2; ++_i) \
        __builtin_amdgcn_global_load_lds((const unsigned*)((const char*)(gbase) + (voff)[_i]), (PG8_LAS unsigned*)(lds + (bufoff) + ldsw + _i * 8192), 16, 0, 0); } while (0)
#define PG8_LDA(dst, b, h) do { _Pragma("unroll") for (int m = 0; m < 4; ++m) _Pragma("unroll") for (int k = 0; k < 2; ++k) dst[m][k] = *(const PG8_LAS bf16x8*)(lds + PG8_SA(b, h) + aoff + m * 2048 + k * 1024); } while (0)
#define PG8_LDB(dst, b, h) do { _Pragma("unroll") for (int n = 0; n < 2; ++n) _Pragma("unroll") for (int k = 0; k < 2; ++k) dst[n][k] = *(const PG8_LAS bf16x8*)(lds + PG8_SB(b, h) + boff + n * 2048 + k * 1024); } while (0)
#define PG8_MMA(ai, bj, At, Bt) do { __builtin_amdgcn_s_setprio(1); _Pragma("unroll") for (int m = 0; m < 4; ++m) _Pragma("unroll") for (int n = 0; n < 2; ++n) _Pragma("unroll") for (int k = 0; k < 2; ++k) \
        acc[ai][bj][m][n] = __builtin_amdgcn_mfma_f32_16x16x32_bf16(Bt[n][k], At[m][k], acc[ai][bj][m][n], 0, 0, 0); __builtin_amdgcn_s_setprio(0); } while (0)
#define PG8_WAIT_V(n) asm volatile("s_waitcnt vmcnt(" #n ")" ::: "memory")
#define PG8_WAIT_L(n) asm volatile("s_waitcnt lgkmcnt(" #n ")" ::: "memory")
#define PG8_BAR __builtin_amdgcn_s_barrier()
#define PG8_SCHED __builtin_amdgcn_sched_barrier(0)
    Unit cur, nxt; int ui = 0;
    if (!S.next(0, cur)) return;
    f32x4 acc[2][2][4][2];
#pragma unroll
    for (int a = 0; a < 2; ++a)
#pragma unroll
        for (int b = 0; b < 2; ++b)
#pragma unroll
            for (int m = 0; m < 4; ++m)
#pragma unroll
                for (int n = 0; n < 2; ++n) acc[a][b][m][n] = (f32x4){0.f, 0.f, 0.f, 0.f};
    bf16x8 At[4][2], B0[2][2], B1[2][2];
    const char* cA = (const char*)g.A + (size_t)cur.pm * tstepA; const char* cB = (const char*)g.Bt + (size_t)cur.pn * tstep;
    S.a_ready(cur);
    if constexpr (SP2) {
        PG8_STAGE(PG8_SB(0, 0), cB, voffB); PG8_STAGE(PG8_SB(0, 1), cB + hstep, voffB); PG8_STAGE(PG8_SA(0, 0), cA, voffA); PG8_STAGE(PG8_SA(0, 1), cA + hstepA, voffA);
        if (wr == 1) PG8_BAR;
        PG8_WAIT_V(2); PG8_BAR;
        PG8_STAGE(PG8_SB(1, 0), cB + kstep, voffB); PG8_STAGE(PG8_SA(1, 0), cA + kstep, voffA); PG8_STAGE(PG8_SB(1, 1), cB + hstep + kstep, voffB);
        PG8_WAIT_V(6); PG8_BAR;
    } else {
        PG8_STAGE(PG8_SB(0, 0), cB, voffB); PG8_STAGE(PG8_SA(0, 0), cA, voffA); PG8_STAGE(PG8_SB(0, 1), cB + hstep, voffB); PG8_STAGE(PG8_SA(0, 1), cA + hstepA, voffA);
        if (wr == 1) PG8_BAR;
        PG8_WAIT_V(4); PG8_BAR;
        PG8_STAGE(PG8_SB(1, 0), cB + kstep, voffB); PG8_STAGE(PG8_SA(1, 0), cA + kstep, voffA); PG8_STAGE(PG8_SB(1, 1), cB + hstep + kstep, voffB);
        PG8_WAIT_V(6); PG8_BAR;
    }
    for (;;) {
        const bool has_next = S.next(ui + 1, nxt);
        const char* nA = has_next ? (const char*)g.A + (size_t)nxt.pm * tstepA : cA; const char* nB = has_next ? (const char*)g.Bt + (size_t)nxt.pn * tstep : cB;
        for (int t = 0; t < nt; t += 2) {
            const bool last = (t == nt - 2);
            const char* a1 = cA + (size_t)(t + 1) * kstep;
            const char* a2 = last ? nA : cA + (size_t)(t + 2) * kstep; const char* b2 = last ? nB : cB + (size_t)(t + 2) * kstep;
            const char* a3 = a2 + kstep; const char* b3 = b2 + kstep;
            if (last && has_next) S.a_ready(nxt);
            if constexpr (SP2) {
            PG8_LDB(B0, 0, 0); PG8_LDB(B1, 0, 1); PG8_SCHED; PG8_LDA(At, 0, 0); PG8_STAGE(PG8_SA(1, 1), a1 + hstepA, voffA);
            PG8_WAIT_V(8); PG8_WAIT_L(0); PG8_BAR; PG8_MMA(0, 0, At, B0); PG8_MMA(0, 1, At, B1); PG8_BAR; PG8_SCHED;
            PG8_LDA(At, 0, 1); PG8_STAGE(PG8_SB(0, 0), b2, voffB); PG8_STAGE(PG8_SB(0, 1), b2 + hstep, voffB); PG8_STAGE(PG8_SA(0, 0), a2, voffA);
            PG8_WAIT_V(8); PG8_WAIT_L(0); PG8_BAR; PG8_MMA(1, 0, At, B0); PG8_MMA(1, 1, At, B1); PG8_BAR; PG8_SCHED;
            PG8_LDB(B0, 1, 0); PG8_LDB(B1, 1, 1); PG8_SCHED; PG8_LDA(At, 1, 0); PG8_STAGE(PG8_SA(0, 1), a2 + hstepA, voffA);
            PG8_WAIT_V(8); PG8_WAIT_L(0); PG8_BAR; PG8_MMA(0, 0, At, B0); PG8_MMA(0, 1, At, B1); PG8_BAR; PG8_SCHED;
            PG8_LDA(At, 1, 1); PG8_STAGE(PG8_SB(1, 0), b3, voffB); PG8_STAGE(PG8_SB(1, 1), b3 + hstep, voffB); PG8_STAGE(PG8_SA(1, 0), a3, voffA);
            PG8_WAIT_V(8); PG8_WAIT_L(0); PG8_BAR; PG8_MMA(1, 0, At, B0); PG8_MMA(1, 1, At, B1); PG8_BAR; PG8_SCHED;
            } else {
            PG8_LDB(B0, 0, 0); PG8_SCHED; PG8_LDA(At, 0, 0); PG8_STAGE(PG8_SA(1, 1), a1 + hstepA, voffA);
            PG8_WAIT_L(8); PG8_BAR; PG8_WAIT_L(0); PG8_MMA(0, 0, At, B0); PG8_BAR; PG8_SCHED;
            PG8_LDB(B1, 0, 1); PG8_STAGE(PG8_SB(0, 0), b2, voffB);
            PG8_BAR; PG8_WAIT_L(0); PG8_MMA(0, 1, At, B1); PG8_BAR;
            PG8_LDA(At, 0, 1); PG8_STAGE(PG8_SA(0, 0), a2, voffA);
            PG8_BAR; PG8_WAIT_L(0); PG8_MMA(1, 0, At, B0); PG8_BAR; PG8_SCHED;
            PG8_STAGE(PG8_SB(0, 1), b2 + hstep, voffB);
            PG8_WAIT_V(6); PG8_BAR; PG8_MMA(1, 1, At, B1); PG8_BAR;
            PG8_LDB(B0, 1, 0); PG8_SCHED; PG8_LDA(At, 1, 0); PG8_STAGE(PG8_SA(0, 1), a2 + hstepA, voffA);
            PG8_WAIT_L(8); PG8_BAR; PG8_WAIT_L(0); PG8_MMA(0, 0, At, B0); PG8_BAR; PG8_SCHED;
            PG8_LDB(B1, 1, 1); PG8_STAGE(PG8_SB(1, 0), b3, voffB);
            PG8_BAR; PG8_WAIT_L(0); PG8_MMA(0, 1, At, B1); PG8_BAR;
            PG8_LDA(At, 1, 1); PG8_STAGE(PG8_SA(1, 0), a3, voffA);
            PG8_BAR; PG8_WAIT_L(0); PG8_MMA(1, 0, At, B0); PG8_BAR; PG8_SCHED;
            PG8_STAGE(PG8_SB(1, 1), b3 + hstep, voffB);
            PG8_WAIT_V(6); PG8_BAR; PG8_MMA(1, 1, At, B1); PG8_BAR;
            }
        }
        if constexpr (ALIGN_EPI) { if (wr == 0) PG8_BAR; }
        if constexpr (!Epi::AFTER_DRAIN) { E(acc, cur, wr, wc, fr, fq); S.done(cur); }
        if (!has_next) break;
#pragma unroll
        for (int a = 0; a < 2; ++a)
#pragma unroll
            for (int b = 0; b < 2; ++b)
#pragma unroll
                for (int m = 0; m < 4; ++m)
#pragma unroll
                    for (int n = 0; n < 2; ++n) acc[a][b][m][n] = (f32x4){0.f, 0.f, 0.f, 0.f};
        cur = nxt; cA = nA; cB = nB; ++ui;
        if constexpr (ALIGN_EPI) { if (wr == 1) PG8_BAR; }
    }
    PG8_WAIT_V(0);
    if constexpr (!ALIGN_EPI) { if (wr == 0) PG8_BAR; }
    PG8_BAR;
    if constexpr (Epi::AFTER_DRAIN) { E.fused(acc, cur, wr, wc, fr, fq, lds, wid, lane); S.done(cur); }
#undef PG8_SA
#undef PG8_SB
#undef PG8_STAGE
#undef PG8_LDA
#undef PG8_LDB
#undef PG8_MMA
#undef PG8_WAIT_V
#undef PG8_WAIT_L
#undef PG8_BAR
#undef PG8_SCHED
}
}

#define LAS __attribute__((address_space(3)))
typedef unsigned short bf16_t;
typedef short bf16x8 __attribute__((ext_vector_type(8)));
typedef short s16x4 __attribute__((ext_vector_type(4)));
typedef float f32x4 __attribute__((ext_vector_type(4)));
typedef float f32x16 __attribute__((ext_vector_type(16)));
typedef unsigned u32x4 __attribute__((ext_vector_type(4)));
typedef unsigned u32x2 __attribute__((ext_vector_type(2)));
typedef float f32x2_t __attribute__((ext_vector_type(2)));
typedef __bf16 bf16x2_t __attribute__((ext_vector_type(2)));
__device__ __forceinline__ unsigned pk2(float lo, float hi) { f32x2_t v = {lo, hi}; bf16x2_t b = __builtin_convertvector(v, bf16x2_t); return __builtin_bit_cast(unsigned, b); }
__device__ __forceinline__ float bf_lo(unsigned w) { return __uint_as_float(w << 16); }
__device__ __forceinline__ float bf_hi(unsigned w) { return __uint_as_float(w & 0xffff0000u); }
__device__ __forceinline__ float wave_sum(float v) {
#pragma unroll
    for (int o = 1; o < 64; o <<= 1) v += __shfl_xor(v, o);
    return v;
}
__device__ __forceinline__ float rinv_row(const float* rpart, int row) {
    const f32x4* rp = (const f32x4*)(rpart + (size_t)row * 16);
    const f32x4 a = rp[0], b = rp[1], c = rp[2], d = rp[3];
    const float s = ((a[0] + a[1]) + (a[2] + a[3])) + ((b[0] + b[1]) + (b[2] + b[3])) + ((c[0] + c[1]) + (c[2] + c[3])) + ((d[0] + d[1]) + (d[2] + d[3]));
    return 1.0f / sqrtf(s * (1.0f / 1024.0f) + EPS);
}

constexpr size_t MiB = 1u << 20;
constexpr size_t WS_QKM = 0;
constexpr size_t WS_BAR = 65536;
constexpr size_t WS_RPART = 1 * MiB;
constexpr size_t WS_LF = 3 * MiB;
constexpr size_t WS_C2P = 5 * MiB;
constexpr size_t WS_C2S = 7 * MiB;
constexpr size_t WS_WF = 9 * MiB;
constexpr size_t WS_W = 10 * MiB;
constexpr size_t W_CIN = WS_W, W_COUT = WS_W + 12 * MiB, W_FIN = WS_W + 16 * MiB, W_FO = WS_W + 28 * MiB, W_1 = WS_W + 32 * MiB, W_2 = WS_W + 64 * MiB;
constexpr size_t WS_XF = 110 * MiB;
constexpr size_t WS_XB = 175 * MiB;
constexpr size_t WS_A2 = 208 * MiB;
constexpr size_t WS_OV = 241 * MiB;
constexpr size_t WS_Q = WS_OV, WS_K = WS_OV + 33 * MiB, WS_V = WS_OV + 99 * MiB;
constexpr size_t WS_END = WS_OV + 166 * MiB;

constexpr size_t O_Y = 0, O_PCONV = 17039360, O_PK = 17043456, O_PV = 50597888, O_PLF = 84152320, O_SCONV = 84676608, O_SK = 84709376, O_SV = 85233664, O_SLF = 85757952;

constexpr int WLDS = 17408;
constexpr int LDS_CTL = 8 * WLDS;
constexpr int LDS_BYTES = 8 * WLDS + 256;

struct Args { const float* in[17]; float* out; unsigned char* ws; int lo, hi; };

__device__ __forceinline__ int crow(int r, int hi) { return (r & 3) + 8 * (r >> 2) + 4 * hi; }
__device__ __forceinline__ void glds16(const void* gsrc, unsigned lds_dst) { unsigned keep;
    asm volatile("s_mov_b32 %0, m0\n\ts_mov_b32 m0, %2\n\ts_nop 0\n\tglobal_load_lds_dwordx4 %1, off\n\ts_mov_b32 m0, %0" : "=&s"(keep) : "v"(gsrc), "s"(lds_dst) : "memory"); }
__device__ __forceinline__ void glds4(const void* gsrc, unsigned lds_dst) { unsigned keep;
    asm volatile("s_mov_b32 %0, m0\n\ts_mov_b32 m0, %2\n\ts_nop 0\n\tglobal_load_lds_dword %1, off\n\ts_mov_b32 m0, %0" : "=&s"(keep) : "v"(gsrc), "s"(lds_dst) : "memory"); }
#define SBAR() __builtin_amdgcn_sched_barrier(0)
struct VFrag { s16x4 lo[8], hi[8]; };
template <int d0> __device__ __forceinline__ void pv_reads(VFrag& f, int vb) {
#pragma unroll
        for (int ks = 0; ks < 4; ++ks) {
            asm volatile("ds_read_b64_tr_b16 %0,%1 offset:%c2" : "=&v"(f.lo[d0 * 4 + ks]) : "v"(vb), "i"(d0 * 4096 + ks * 1024) : "memory");
            asm volatile("ds_read_b64_tr_b16 %0,%1 offset:%c2" : "=&v"(f.hi[d0 * 4 + ks]) : "v"(vb), "i"(d0 * 4096 + ks * 1024 + 512) : "memory"); }
}
__device__ __forceinline__ void pv_mfma(f32x16* o, VFrag& f, bf16x8 pa0, bf16x8 pa1, bf16x8 pa2, bf16x8 pa3) {
    asm volatile("s_waitcnt lgkmcnt(0)" : "+v"(f.lo[0]), "+v"(f.lo[1]), "+v"(f.lo[2]), "+v"(f.lo[3]), "+v"(f.lo[4]), "+v"(f.lo[5]), "+v"(f.lo[6]), "+v"(f.lo[7]),
                 "+v"(f.hi[0]), "+v"(f.hi[1]), "+v"(f.hi[2]), "+v"(f.hi[3]), "+v"(f.hi[4]), "+v"(f.hi[5]), "+v"(f.hi[6]), "+v"(f.hi[7]) :: "memory");
#define PK(k) (bf16x8){f.lo[k][0], f.lo[k][1], f.lo[k][2], f.lo[k][3], f.hi[k][0], f.hi[k][1], f.hi[k][2], f.hi[k][3]}
    o[0] = __builtin_amdgcn_mfma_f32_32x32x16_bf16(pa0, PK(0), o[0], 0, 0, 0);
    o[1] = __builtin_amdgcn_mfma_f32_32x32x16_bf16(pa0, PK(4), o[1], 0, 0, 0);
    o[0] = __builtin_amdgcn_mfma_f32_32x32x16_bf16(pa1, PK(1), o[0], 0, 0, 0);
    o[1] = __builtin_amdgcn_mfma_f32_32x32x16_bf16(pa1, PK(5), o[1], 0, 0, 0);
    o[0] = __builtin_amdgcn_mfma_f32_32x32x16_bf16(pa2, PK(2), o[0], 0, 0, 0);
    o[1] = __builtin_amdgcn_mfma_f32_32x32x16_bf16(pa2, PK(6), o[1], 0, 0, 0);
    o[0] = __builtin_amdgcn_mfma_f32_32x32x16_bf16(pa3, PK(3), o[0], 0, 0, 0);
    o[1] = __builtin_amdgcn_mfma_f32_32x32x16_bf16(pa3, PK(7), o[1], 0, 0, 0);
#undef PK
}
constexpr int ANS = 4;
constexpr int A_K = 0, A_V = ANS * 8192, A_C = 2 * ANS * 8192, A_WSF = A_C + ANS * 2048, A_OST = A_WSF + 2048, A_END = A_OST + 8 * 4096;
static_assert(A_END <= 8 * WLDS, "attention LDS map");
__device__ __forceinline__ void attn_unit(LAS unsigned char* sh, const bf16_t* Qb, const bf16_t* __restrict__ Kb, const bf16_t* __restrict__ Vb, bf16_t* Ob,
                                          const float* __restrict__ c2seq, long qrow0, long kvbase, int p0, int nrows, int h, float TH, float CS1, int lane, int wave) {
    const int r32 = lane & 31, hi = lane >> 5;
    const unsigned lbase = (unsigned)(uintptr_t)sh;
    const bool active = wave * 32 < nrows;
    const int pw = p0 + 32 * wave;
    bf16x8 qr[4];
    { const bf16_t* Qw = Qb + (qrow0 + (active ? wave * 32 : 0) + r32) * D + h * 64;
#pragma unroll
      for (int d0 = 0; d0 < 4; ++d0) qr[d0] = *(const bf16x8*)(Qw + d0 * 16 + hi * 8); }
    const int plast = p0 + nrows - 1, tl_u = plast >> 6, tl_w = (pw + 31) >> 6;
    float cref = c2seq[p0];
    float crefw = c2seq[active ? pw : p0];
    float cv0; { const int t = tl_u - lane; int idx = 64 * t + 63; idx = idx > plast ? plast : idx; cv0 = c2seq[idx < 0 ? 0 : idx]; }
    asm volatile("" : "+v"(cref), "+v"(crefw), "+v"(cv0), "+v"(qr[0]), "+v"(qr[1]), "+v"(qr[2]), "+v"(qr[3]));
    int tstart = 0;
    for (int tb = tl_u; tb >= 0; tb -= 64) {
        const int t = tb - lane; int idx = 64 * t + 63; idx = idx > plast ? plast : idx;
        const float cv = (tb == tl_u) ? cv0 : ((t >= 0) ? c2seq[idx] : 0.f);
        const bool skip = (t >= 0) && (cref - cv < -TH);
        const unsigned long long bal = __ballot(skip);
        if (bal) { tstart = tb - (__ffsll((long long)bal) - 1) + 1; break; }
    }
    tstart = __builtin_amdgcn_readfirstlane(tstart);
    const int n = tl_u - tstart + 1;
    const bf16_t* ksrc = Kb + (kvbase + lane) * D + h * 64 + wave * 8;
    const bf16_t* vsrc = Vb + (kvbase + 16 * (wave & 3) + (lane >> 2)) * D + h * 64 + (wave >> 2) * 32 + (lane & 3) * 8;
    const float* csrc = c2seq + lane;
#define ISSUE(i_) do { const int t_ = tl_u - (i_), sl_ = (i_) & (ANS - 1); \
    glds16(ksrc + (long)t_ * 64 * D, lbase + A_K + sl_ * 8192 + wave * 1024); \
    glds16(vsrc + (long)t_ * 64 * D, lbase + A_V + sl_ * 8192 + wave * 1024); \
    glds4(csrc + t_ * 64, lbase + A_C + sl_ * 2048 + wave * 256); } while (0)
    float mhat = 0.f, l_reg = 0.f; f32x16 o[2]; o[0] = f32x16{}; o[1] = f32x16{};
    float mmin = -INFINITY;
    bool wdone = false;
    LAS float* wsf = (LAS float*)(sh + A_WSF + wave * 256);
    const int vb0 = (int)(lbase + A_V) + ((lane >> 4) & 1) * 32 + (lane & 3) * 8 + (4 * hi + ((lane & 15) >> 2)) * 64;
    const LAS unsigned char* kb0 = sh + A_K + hi * 1024 + r32 * 16;
    asm volatile("" : "+v"(qr[0]), "+v"(qr[1]), "+v"(qr[2]), "+v"(qr[3]));
    if (0 < n) ISSUE(0);
    if (1 < n) ISSUE(1);
    if (2 < n) ISSUE(2);
    for (int i = 0; i < n; ++i) {
        const int rem = n - 1 - i;
        if (rem >= 2) asm volatile("s_waitcnt vmcnt(6)" ::: "memory"); else if (rem == 1) asm volatile("s_waitcnt vmcnt(3)" ::: "memory"); else asm volatile("s_waitcnt vmcnt(0)" ::: "memory");
        asm volatile("s_waitcnt lgkmcnt(0)\n\ts_barrier" ::: "memory");
        if (i + 3 < n) ISSUE(i + 3);
        const int t = tl_u - i, sl = i & (ANS - 1);
        const LAS unsigned char* cp = sh + A_C + sl * 2048 + wave * 256;
        if (active && t < tl_w && !wdone) { const float cend = *(const LAS float*)(cp + 63 * 4); if (crefw - cend < -TH || (cref - cend) + CS1 - mmin < -152.0f) wdone = true; }
        if (active && t <= tl_w && !wdone) {
            f32x16 p0v, p1v;
            const LAS unsigned char* kbp = kb0 + sl * 8192;
            bf16x8 kf[8];
#pragma unroll
            for (int d0 = 0; d0 < 4; ++d0) { kf[2 * d0] = *(const LAS bf16x8*)(kbp + d0 * 2048); kf[2 * d0 + 1] = *(const LAS bf16x8*)(kbp + d0 * 2048 + 512); }
            { const float X = cref - mhat;
#pragma unroll
              for (int g = 0; g < 4; ++g) {
                  const f32x4 ca = *(const LAS f32x4*)(cp + (8 * g + 4 * hi) * 4), cb = *(const LAS f32x4*)(cp + (32 + 8 * g + 4 * hi) * 4);
#pragma unroll
                  for (int e = 0; e < 4; ++e) { p0v[4 * g + e] = X - ca[e]; p1v[4 * g + e] = X - cb[e]; }
              } }
            asm volatile("" : "+v"(kf[0]), "+v"(kf[1]), "+v"(kf[2]), "+v"(kf[3]), "+v"(kf[4]), "+v"(kf[5]), "+v"(kf[6]), "+v"(kf[7]));
#pragma unroll
            for (int d0 = 0; d0 < 4; ++d0) {
                p0v = __builtin_amdgcn_mfma_f32_32x32x16_bf16(kf[2 * d0], qr[d0], p0v, 0, 0, 0);
                p1v = __builtin_amdgcn_mfma_f32_32x32x16_bf16(kf[2 * d0 + 1], qr[d0], p1v, 0, 0, 0);
            }
            if (t == tl_w) {
                const int qpos = pw + r32, kq = 64 * t + 4 * hi;
#pragma unroll
                for (int r = 0; r < 16; ++r) { const int kv = kq + (r & 3) + 8 * (r >> 2); if (kv > qpos) p0v[r] = -INFINITY; if (kv + 32 > qpos) p1v[r] = -INFINITY; }
            }
            float rm, rm2;
            { float a_ = __builtin_fmaxf(__builtin_fmaxf(p0v[0], p0v[1]), p1v[0]), b_ = __builtin_fmaxf(__builtin_fmaxf(p0v[2], p0v[3]), p1v[1]); a_ = __builtin_fmaxf(__builtin_fmaxf(a_, p1v[2]), p1v[3]);
#pragma unroll
              for (int r = 4; r < 16; r += 4) { a_ = __builtin_fmaxf(__builtin_fmaxf(a_, p0v[r]), p0v[r + 1]); b_ = __builtin_fmaxf(__builtin_fmaxf(b_, p0v[r + 2]), p0v[r + 3]); a_ = __builtin_fmaxf(__builtin_fmaxf(a_, p1v[r]), p1v[r + 1]); b_ = __builtin_fmaxf(__builtin_fmaxf(b_, p1v[r + 2]), p1v[r + 3]); }
              rm = __builtin_fmaxf(a_, b_); rm2 = rm; (void)rm2; }
            { auto rr = __builtin_amdgcn_permlane32_swap(__float_as_uint(rm), __float_as_uint(rm), false, false); rm = fmaxf(__uint_as_float(rr[0]), __uint_as_float(rr[1])); }
            if (t == tl_w) {
                mhat = rm;
                { float mm = mhat; mm = fminf(mm, __shfl_xor(mm, 1)); mm = fminf(mm, __shfl_xor(mm, 2)); mm = fminf(mm, __shfl_xor(mm, 4)); mm = fminf(mm, __shfl_xor(mm, 8)); mm = fminf(mm, __shfl_xor(mm, 16)); mmin = mm; }
#pragma unroll
                for (int r = 0; r < 16; ++r) { p0v[r] -= rm; p1v[r] -= rm; }
            } else if (__any(rm > 4.0f)) {
                const float dl = fmaxf(rm, 0.f); mhat += dl;
                { float mm = mhat; mm = fminf(mm, __shfl_xor(mm, 1)); mm = fminf(mm, __shfl_xor(mm, 2)); mm = fminf(mm, __shfl_xor(mm, 4)); mm = fminf(mm, __shfl_xor(mm, 8)); mm = fminf(mm, __shfl_xor(mm, 16)); mmin = mm; }
#pragma unroll
                for (int r = 0; r < 16; ++r) { p0v[r] -= dl; p1v[r] -= dl; }
                const float f = __builtin_amdgcn_exp2f(-dl); l_reg *= f;
                if (hi == 0) wsf[r32] = f;
                asm volatile("s_waitcnt lgkmcnt(0)" ::: "memory");
#pragma unroll
                for (int r = 0; r < 16; ++r) { const float fr_ = wsf[crow(r, hi)]; o[0][r] *= fr_; o[1][r] *= fr_; }
                asm volatile("s_waitcnt lgkmcnt(0)" ::: "memory");
            }
            float sacc = 0.f;
#pragma unroll
            for (int r = 0; r < 16; ++r) { p0v[r] = __builtin_amdgcn_exp2f(p0v[r]); p1v[r] = __builtin_amdgcn_exp2f(p1v[r]); sacc += p0v[r] + p1v[r]; }
            l_reg += sacc;
            VFrag vf; pv_reads<0>(vf, vb0 + sl * 8192); pv_reads<1>(vf, vb0 + sl * 8192);
            u32x4 pw0, pw1, pw2, pw3;
            pw0 = (u32x4){pk2(p0v[0], p0v[1]), pk2(p0v[2], p0v[3]), pk2(p0v[4], p0v[5]), pk2(p0v[6], p0v[7])};
            pw1 = (u32x4){pk2(p0v[8], p0v[9]), pk2(p0v[10], p0v[11]), pk2(p0v[12], p0v[13]), pk2(p0v[14], p0v[15])};
            pw2 = (u32x4){pk2(p1v[0], p1v[1]), pk2(p1v[2], p1v[3]), pk2(p1v[4], p1v[5]), pk2(p1v[6], p1v[7])};
            pw3 = (u32x4){pk2(p1v[8], p1v[9]), pk2(p1v[10], p1v[11]), pk2(p1v[12], p1v[13]), pk2(p1v[14], p1v[15])};
            pv_mfma(o, vf, __builtin_bit_cast(bf16x8, pw0), __builtin_bit_cast(bf16x8, pw1), __builtin_bit_cast(bf16x8, pw2), __builtin_bit_cast(bf16x8, pw3));
        }
    }
#undef ISSUE
    if (active) {
        { auto rr = __builtin_amdgcn_permlane32_swap(__float_as_uint(l_reg), __float_as_uint(l_reg), false, false); l_reg = __uint_as_float(rr[0]) + __uint_as_float(rr[1]); }
        if (hi == 0) wsf[32 + r32] = l_reg;
        asm volatile("s_waitcnt lgkmcnt(0)" ::: "memory");
        float rli[16];
#pragma unroll
        for (int r = 0; r < 16; ++r) rli[r] = __builtin_amdgcn_rcpf(wsf[32 + crow(r, hi)]);
        LAS bf16_t* stg = (LAS bf16_t*)(sh + A_OST + wave * 4096);
#pragma unroll
        for (int r = 0; r < 16; ++r) { const int orow = crow(r, hi);
#pragma unroll
            for (int d0 = 0; d0 < 2; ++d0) stg[orow * 64 + d0 * 32 + r32] = (bf16_t)(pk2(o[d0][r] * rli[r], 0.f) & 0xffffu); }
        asm volatile("s_waitcnt lgkmcnt(0)" ::: "memory");
        bf16_t* Ow = Ob + (qrow0 + wave * 32) * D + h * 64;
#pragma unroll
        for (int i = 0; i < 4; ++i) { const int row = i * 8 + (lane >> 3), ch = lane & 7; const u32x4 v = *(const LAS u32x4*)(stg + row * 64 + ch * 8); *(u32x4*)(Ow + (long)row * D + ch * 8) = v; }
    }
    asm volatile("s_waitcnt lgkmcnt(0)\n\ts_barrier" ::: "memory");
}

__device__ __forceinline__ void transpose_item(const float* W, int K, int N, int ldw, const float* g, bf16_t* WT, LAS float* scr, int item, int lane, int ldo = 0) {
    if (ldo == 0) ldo = K;
    const int nblk = N / 32, kb = item / nblk, nb = item % nblk, k0 = 64 * kb, n0 = 32 * nb;
    float tv[32];
#pragma unroll
    for (int i = 0; i < 32; ++i) tv[i] = W[(size_t)(k0 + 2 * i + (lane >> 5)) * ldw + n0 + (lane & 31)];
#pragma unroll
    for (int i = 0; i < 32; ++i) scr[(2 * i + (lane >> 5)) * 33 + (lane & 31)] = tv[i];
    asm volatile("s_waitcnt lgkmcnt(0)" ::: "memory");
    const int c = lane & 7;
    float gv[8];
#pragma unroll
    for (int e = 0; e < 8; ++e) gv[e] = g ? g[k0 + 8 * c + e] : 1.0f;
#pragma unroll
    for (int j = 0; j < 4; ++j) { const int n = (lane >> 3) + 8 * j; const LAS float* s = scr + (8 * c) * 33 + n;
        u32x4 o; o.x = pk2(s[0 * 33] * gv[0], s[1 * 33] * gv[1]); o.y = pk2(s[2 * 33] * gv[2], s[3 * 33] * gv[3]); o.z = pk2(s[4 * 33] * gv[4], s[5 * 33] * gv[5]); o.w = pk2(s[6 * 33] * gv[6], s[7 * 33] * gv[7]);
        *(u32x4*)(WT + (size_t)(n0 + n) * ldo + k0 + 8 * c) = o; }
    asm volatile("s_waitcnt lgkmcnt(0)" ::: "memory");
}


__device__ __forceinline__ void epi_small(const pg8::EpiG& E, int row, int col, f32x4 v, int lane, float r, const float* xinS) {
    if (E.mode == 2) {
        float* xp = E.Xf + (size_t)row * 1024 + col; f32x4 x = *(const f32x4*)(xinS + (size_t)(row - SEQ) * 1024 + col); x += v; *(f32x4*)xp = x;
        u32x2 w; w.x = pk2(x[0], x[1]); w.y = pk2(x[2], x[3]); *(u32x2*)(E.Xb + (size_t)row * 1024 + col) = w;
        float ss = (x[0] * x[0] + x[1] * x[1]) + (x[2] * x[2] + x[3] * x[3]);
        ss += __shfl_xor(ss, 1); ss += __shfl_xor(ss, 2); ss += __shfl_xor(ss, 4); ss += __shfl_xor(ss, 8);
        if ((lane & 15) == 0) E.rpart_out[(size_t)row * 16 + (col >> 6)] = ss;
        return;
    }
    v = v * r;
    if (E.mode == 0 || E.mode == 3) {
        if (E.mode == 3) {
#pragma unroll
            for (int e = 0; e < 4; ++e) { const float a0 = fmaxf(v[e], 0.f); v[e] = a0 * a0; } }
        u32x2 w; w.x = pk2(v[0], v[1]); w.y = pk2(v[2], v[3]); *(u32x2*)(E.O + (size_t)row * E.ldc + col) = w;
        return;
    }
    const int t = col >> 10, cq = col & 1023, sr = row - SEQ;
    if (t < 2) {
        float s = (v[0] * v[0] + v[1] * v[1]) + (v[2] * v[2] + v[3] * v[3]);
        s += __shfl_xor(s, 1); s += __shfl_xor(s, 2); s += __shfl_xor(s, 4); s += __shfl_xor(s, 8);
        if ((lane & 15) == 0) atomicMax(E.qkm + (t == 0 ? 80 : 64) + (cq >> 6), __float_as_uint(s));
    }
    if (t == 0) { v = v * QC2; u32x2 w; w.x = pk2(v[0], v[1]); w.y = pk2(v[2], v[3]); *(u32x2*)(E.Qb + (size_t)row * 1024 + cq) = w; }
    else {
        const size_t kvrow = (size_t)(SEQ + (sr >> 5) * LSP + PAST + (sr & 31));
        u32x2 w; w.x = pk2(v[0], v[1]); w.y = pk2(v[2], v[3]); *(u32x2*)((t == 1 ? E.Kb : E.Vb) + kvrow * 1024 + cq) = w;
        *(f32x4*)((t == 1 ? E.outKs : E.outVs) + (size_t)sr * 1024 + cq) = v;
    }
}
__device__ __forceinline__ void small_gemm(LAS unsigned char* lds, const bf16_t* A, int lda, const bf16_t* Bt, int ldb, int N, int K, const pg8::EpiG& E, int vcu, int G, int tid, int wave, const float* xinS) {
    const int lane = tid & 63, r32 = lane & 31, hi = lane >> 5, lrow = lane >> 3, lpc = lane & 7;
    LAS float* red = (LAS float*)lds;
    LAS unsigned char* stg = lds + wave * 13824;
    const int ntile = 8 * (N >> 6), kw = K >> 3;
    for (int tile = vcu; tile < ntile; tile += G) {
        const int rb = tile & 7, cb = tile >> 3;
        const bf16_t* ag = A + (size_t)(SEQ + rb * 32 + lrow) * lda + wave * kw + lpc * 8;
        const bf16_t* bg = Bt + (size_t)(cb * 64 + lrow) * ldb + wave * kw + lpc * 8;
        f32x16 c0 = f32x16{}, c1 = f32x16{};
        const float rrow = (E.mode == 2) ? 1.0f : rinv_row(E.rpart_in, SEQ + rb * 32 + (tid >> 4));
        for (int k0 = 0; k0 < kw; k0 += 128) {
            u32x4 ra[2][4], rv[2][8];
#pragma unroll
            for (int sb = 0; sb < 2; ++sb) {
#pragma unroll
                for (int i = 0; i < 4; ++i) ra[sb][i] = *(const u32x4*)(ag + (size_t)(8 * i) * lda + k0 + sb * 64);
#pragma unroll
                for (int i = 0; i < 8; ++i) rv[sb][i] = *(const u32x4*)(bg + (size_t)(8 * i) * ldb + k0 + sb * 64);
            }
            asm volatile("" : "+v"(ra[0][0]), "+v"(ra[0][1]), "+v"(ra[0][2]), "+v"(ra[0][3]), "+v"(ra[1][0]), "+v"(ra[1][1]), "+v"(ra[1][2]), "+v"(ra[1][3]),
                              "+v"(rv[0][0]), "+v"(rv[0][1]), "+v"(rv[0][2]), "+v"(rv[0][3]), "+v"(rv[0][4]), "+v"(rv[0][5]), "+v"(rv[0][6]), "+v"(rv[0][7]),
                              "+v"(rv[1][0]), "+v"(rv[1][1]), "+v"(rv[1][2]), "+v"(rv[1][3]), "+v"(rv[1][4]), "+v"(rv[1][5]), "+v"(rv[1][6]), "+v"(rv[1][7]));
#pragma unroll
            for (int sb = 0; sb < 2; ++sb) {
#pragma unroll
                for (int i = 0; i < 4; ++i) *(LAS u32x4*)(stg + (8 * i + lrow) * 144 + lpc * 16) = ra[sb][i];
#pragma unroll
                for (int i = 0; i < 8; ++i) *(LAS u32x4*)(stg + 4608 + (8 * i + lrow) * 144 + lpc * 16) = rv[sb][i];
                bf16x8 fa[4], fb0[4], fb1[4];
#pragma unroll
                for (int ks = 0; ks < 4; ++ks) { fa[ks] = *(const LAS bf16x8*)(stg + r32 * 144 + (2 * ks + hi) * 16);
                    fb0[ks] = *(const LAS bf16x8*)(stg + 4608 + r32 * 144 + (2 * ks + hi) * 16); fb1[ks] = *(const LAS bf16x8*)(stg + 4608 + (32 + r32) * 144 + (2 * ks + hi) * 16); }
#pragma unroll
                for (int ks = 0; ks < 4; ++ks) {
                    c0 = __builtin_amdgcn_mfma_f32_32x32x16_bf16(fb0[ks], fa[ks], c0, 0, 0, 0);
                    c1 = __builtin_amdgcn_mfma_f32_32x32x16_bf16(fb1[ks], fa[ks], c1, 0, 0, 0);
                }
            }
        }
        __syncthreads();
        LAS float* wr_ = red + wave * (32 * 68) + r32 * 68 + 4 * hi;
#pragma unroll
        for (int g = 0; g < 4; ++g) {
            *(LAS f32x4*)(wr_ + 8 * g) = (f32x4){c0[4 * g], c0[4 * g + 1], c0[4 * g + 2], c0[4 * g + 3]};
            *(LAS f32x4*)(wr_ + 32 + 8 * g) = (f32x4){c1[4 * g], c1[4 * g + 1], c1[4 * g + 2], c1[4 * g + 3]};
        }
        __syncthreads();
        const int m = tid >> 4, c4 = (tid & 15) * 4;
        f32x4 v = *(const LAS f32x4*)(red + m * 68 + c4);
#pragma unroll
        for (int w = 1; w < 8; ++w) v += *(const LAS f32x4*)(red + w * (32 * 68) + m * 68 + c4);
        epi_small(E, SEQ + rb * 32 + m, cb * 64 + c4, v, lane, rrow, xinS);
        __syncthreads();
    }
}

#define XB_TMO      128
#define XB_XCNT(j)  (256  + 64 * (j))
#define XB_XSUB(j)  (1280 + 64 * (j))
#define XB_XGEN(j)  (2304 + 64 * (j))
#define XB_TOP      3328
#define XB_TOPGEN   3392
#define XCD_BAR_WORDS 3456
#define XB_SPIN_CAP (1u << 18)

__device__ __forceinline__ unsigned xb_ld(unsigned* p)              { return __hip_atomic_load(p, __ATOMIC_RELAXED, __HIP_MEMORY_SCOPE_AGENT); }
__device__ __forceinline__ unsigned xb_add(unsigned* p, unsigned v) { return __hip_atomic_fetch_add(p, v, __ATOMIC_RELAXED, __HIP_MEMORY_SCOPE_AGENT); }
__device__ __forceinline__ unsigned xb_xcc_id() { return (unsigned)__builtin_amdgcn_s_getreg((3 << 11) | 20) & 0xFu; }
#define XB_SPIN(cond, bar) do { unsigned _sp = 0; while (cond) { __builtin_amdgcn_s_sleep(1); \
    if ((++_sp & 255u) == 0u) { if (xb_ld(&(bar)[XB_TMO])) break; if (_sp > XB_SPIN_CAP) { atomicAdd(&(bar)[XB_TMO], 1u); break; } } } } while (0)

struct XcdBarrier {
    unsigned* bar; unsigned x;
    volatile LAS unsigned* st;
};

__device__ __forceinline__ XcdBarrier xcd_barrier_post(unsigned* bar, volatile LAS unsigned* st) {
    XcdBarrier b; b.bar = bar; b.x = xb_xcc_id(); b.st = st;
    if (threadIdx.x == 0) (void)xb_add(&bar[XB_XCNT(b.x)], 1u);
    return b;
}
__device__ __forceinline__ void xcd_barrier_complete(unsigned* bar, unsigned x, unsigned& nloc, unsigned& nx) {
    const unsigned G = gridDim.x * gridDim.y * gridDim.z;
    unsigned sum, cnt, mine, sp = 0u;
    for (;;) {
        sum = 0u; cnt = 0u; mine = 0u;
#pragma unroll
        for (unsigned j = 0; j < 16; ++j) { const unsigned c = xb_ld(&bar[XB_XCNT(j)]); sum += c; cnt += (c > 0u) ? 1u : 0u; mine = (j == x) ? c : mine; }
        if (sum == G) break;
        __builtin_amdgcn_s_sleep(1);
        if ((++sp & 255u) == 0u) { if (xb_ld(&bar[XB_TMO])) break; if (sp > XB_SPIN_CAP) { atomicAdd(&bar[XB_TMO], 1u); break; } }
    }
    nloc = mine > 0u ? mine : 1u; nx = cnt > 0u ? cnt : 1u;
}

__device__ __forceinline__ void xcd_barrier(const XcdBarrier& b) {
    asm volatile("s_waitcnt vmcnt(0)" ::: "memory");
    __syncthreads();
    if (threadIdx.x == 0) {
        unsigned* bar = b.bar;
        __builtin_amdgcn_s_waitcnt(0);
        unsigned nloc = b.st[0], nx = b.st[1];
        if (nloc == 0u) { xcd_barrier_complete(bar, b.x, nloc, nx); b.st[0] = nloc; b.st[1] = nx; }
        const unsigned old = xb_add(&bar[XB_XSUB(b.x)], 1u);
        const unsigned gen = old / nloc;
        if (old + 1u == (gen + 1u) * nloc) {
            __builtin_amdgcn_fence(__ATOMIC_RELEASE, "agent");
            asm volatile("s_waitcnt vmcnt(0)" ::: "memory");
            const unsigned og = xb_add(&bar[XB_TOP], 1u);
            const unsigned tg = og / nx;
            if (og + 1u == (tg + 1u) * nx) xb_add(&bar[XB_TOPGEN], 1u);
            else XB_SPIN(xb_ld(&bar[XB_TOPGEN]) == tg, bar);
            __builtin_amdgcn_fence(__ATOMIC_ACQUIRE, "agent");
            xb_add(&bar[XB_XGEN(b.x)], 1u);
            asm volatile("s_waitcnt vmcnt(0)" ::: "memory");
        } else {
            XB_SPIN(xb_ld(&bar[XB_XGEN(b.x)]) == gen, bar);
            __builtin_amdgcn_fence(__ATOMIC_ACQUIRE, "agent");
            asm volatile("s_waitcnt vmcnt(0)" ::: "memory");
        }
    }
    __syncthreads();
}

#define F1_EXTRAS() do { \
                const bf16_t* Wf = (const bf16_t*)(ws + WS_WF) + (size_t)j * 16 * 1024; \
                const int fr = lane & 15, fq = lane >> 4; \
                for (int grp = gw; grp < M / 16; grp += NGW) { \
                    const int row = grp * 16 + fr; \
                    const bf16_t* xp = Xb + (size_t)row * 1024 + fq * 8; const bf16_t* wp = Wf + (size_t)fr * 1024 + fq * 8; \
                    f32x4 acc = {0.f, 0.f, 0.f, 0.f}; \
                    const float r = rinv_row(rpart, row); \
                    const f32x4 bf = *(const f32x4*)(fox_b_f + j * 16 + 4 * fq); \
                    for (int k0 = 0; k0 < 32; k0 += 8) { \
                        bf16x8 xa[8], wa[8]; \
_Pragma("unroll") \
                        for (int ks = 0; ks < 8; ++ks) { xa[ks] = *(const bf16x8*)(xp + (k0 + ks) * 32); wa[ks] = *(const bf16x8*)(wp + (k0 + ks) * 32); } \
                        asm volatile("" : "+v"(xa[0]), "+v"(xa[1]), "+v"(xa[2]), "+v"(xa[3]), "+v"(xa[4]), "+v"(xa[5]), "+v"(xa[6]), "+v"(xa[7]), \
                                          "+v"(wa[0]), "+v"(wa[1]), "+v"(wa[2]), "+v"(wa[3]), "+v"(wa[4]), "+v"(wa[5]), "+v"(wa[6]), "+v"(wa[7])); \
_Pragma("unroll") \
                        for (int ks = 0; ks < 8; ++ks) acc = __builtin_amdgcn_mfma_f32_16x16x32_bf16(wa[ks], xa[ks], acc, 0, 0, 0); \
                    } \
                    f32x4 lf; \
_Pragma("unroll") \
                    for (int e = 0; e < 4; ++e) { const float x = acc[e] * r + bf[e]; lf[e] = fminf(x, 0.f) - log1pf(expf(-fabsf(x))); } \
                    *(f32x4*)(LF + (size_t)row * 16 + 4 * fq) = lf; \
                    float* op = (row < SEQ) ? out + O_PLF + ((size_t)j * SEQ + row) * 16 : out + O_SLF + ((size_t)j * MS + (row - SEQ)) * 16; \
                    *(f32x4*)(op + 4 * fq) = lf; \
                } \
                { \
                    const float* ck = cache_k + (size_t)j * NSB * PAST * 1024; const float* cv = cache_v + (size_t)j * NSB * PAST * 1024; \
                    float kmax = 0.f; \
                    for (int hr0 = gw; hr0 < NSB * PAST * 2; hr0 += 4 * NGW) { \
                        f32x4 kk[4][2], vv[4][2]; \
_Pragma("unroll") \
                        for (int q = 0; q < 4; ++q) { const int hr = hr0 + q * NGW; const int b = hr >> 12, pos = (hr >> 1) & 2047, half = hr & 1; \
                            const size_t so = ((size_t)(b * PAST + pos)) * 1024 + half * 512 + lane * 8; \
                            kk[q][0] = *(const f32x4*)(ck + so); kk[q][1] = *(const f32x4*)(ck + so + 4); vv[q][0] = *(const f32x4*)(cv + so); vv[q][1] = *(const f32x4*)(cv + so + 4); } \
_Pragma("unroll") \
                        for (int q = 0; q < 4; ++q) { const int hr = hr0 + q * NGW; const int b = hr >> 12, pos = (hr >> 1) & 2047, half = hr & 1; \
                            const size_t dofs = ((size_t)(SEQ + b * LSP + pos)) * 1024 + half * 512 + lane * 8; \
                            const f32x4 k0 = kk[q][0], k1 = kk[q][1], v0 = vv[q][0], v1 = vv[q][1]; \
                            u32x4 w; w.x = pk2(k0[0], k0[1]); w.y = pk2(k0[2], k0[3]); w.z = pk2(k1[0], k1[1]); w.w = pk2(k1[2], k1[3]); \
                            *(u32x4*)(Kb + dofs) = w; \
                            w.x = pk2(v0[0], v0[1]); w.y = pk2(v0[2], v0[3]); w.z = pk2(v1[0], v1[1]); w.w = pk2(v1[2], v1[3]); \
                            *(u32x4*)(Vb + dofs) = w; \
                            float s = (k0[0] * k0[0] + k0[1] * k0[1]) + (k0[2] * k0[2] + k0[3] * k0[3]) + (k1[0] * k1[0] + k1[1] * k1[1]) + (k1[2] * k1[2] + k1[3] * k1[3]); \
                            s += __shfl_xor(s, 1); s += __shfl_xor(s, 2); s += __shfl_xor(s, 4); \
                            kmax = fmaxf(kmax, s); } \
                    } \
                    if ((lane & 7) == 0) atomicMax((unsigned*)(ws + WS_QKM) + j * 128 + 64 + (gw & 1) * 8 + (lane >> 3), __float_as_uint(kmax)); \
                    if (gw < NSB * 32) { \
                        const size_t dofs = ((size_t)(SEQ + (gw >> 5) * LSP + PAST + TS + (gw & 31))) * 1024 + lane * 16; \
                        const u32x4 z = {0u, 0u, 0u, 0u}; \
                        *(u32x4*)(Kb + dofs) = z; *(u32x4*)(Kb + dofs + 8) = z; *(u32x4*)(Vb + dofs) = z; *(u32x4*)(Vb + dofs + 8) = z; \
                    } \
                } \
} while (0)

template <bool COOP>
__global__ void __launch_bounds__(512, 2) fwd(Args a) {
    extern __shared__ __attribute__((aligned(16))) unsigned char smem[];
    LAS unsigned char* lds = (LAS unsigned char*)smem;
    const int tid0 = threadIdx.x, wave = __builtin_amdgcn_readfirstlane(tid0 >> 6);
    const int G = gridDim.x, bx = blockIdx.x;
    const int vcu = (G % 8 == 0) ? (bx % 8) * (G / 8) + bx / 8 : bx;
    const int gw = vcu * 8 + wave, NGW = G * 8;
    unsigned char* ws = a.ws;
    float* rpart = (float*)(ws + WS_RPART);
    float* LF = (float*)(ws + WS_LF);
    float* c2p = (float*)(ws + WS_C2P);
    float* c2s = (float*)(ws + WS_C2S);
    float* Xf = (float*)(ws + WS_XF);
    bf16_t* Xb = (bf16_t*)(ws + WS_XB);
    bf16_t* A2 = (bf16_t*)(ws + WS_A2);
    bf16_t* OV = (bf16_t*)(ws + WS_OV);
    bf16_t* Qb = (bf16_t*)(ws + WS_Q);
    bf16_t* Kb = (bf16_t*)(ws + WS_K);
    bf16_t* Vb = (bf16_t*)(ws + WS_V);
    const float* x_prompt = a.in[0]; const float* x_sample = a.in[1]; const float* state_conv = a.in[2];
    const float* cache_k = a.in[3]; const float* cache_v = a.in[4]; const float* cache_lf = a.in[5];
    const float* norm_mix = a.in[6]; const float* norm_mlp = a.in[7]; const float* norm_final = a.in[8];
    const float* conv_w_in = a.in[9]; const float* conv_w = a.in[10]; const float* conv_w_out = a.in[11];
    const float* fox_w_in = a.in[12]; const float* fox_b_f = a.in[13]; const float* fox_w_out = a.in[14];
    const float* mlp_w1 = a.in[15]; const float* mlp_w2 = a.in[16];
    float* out = a.out;
    volatile LAS unsigned* misc = (volatile LAS unsigned*)(lds + LDS_CTL);
    if (tid0 < 4) misc[tid0] = 0u;
    __syncthreads();
    XcdBarrier xbar; xbar.bar = (unsigned*)(ws + WS_BAR); xbar.x = 0; xbar.st = misc;

    for (int step = a.lo; step < a.hi; ++step) {
        if constexpr (COOP) {
            if (step == a.lo + 1) { cg::this_grid().sync(); xbar = xcd_barrier_post((unsigned*)(ws + WS_BAR), misc); }
            else if (step > a.lo + 1) xcd_barrier(xbar);
        }
        int kind;
        int j = 0, layer = 0;
        if (step == 0) kind = 0;
        else if (step == 23) kind = 10;
        else { const int s = step - 1; j = s / 11; const int r = s % 11;
            if (r < 5) { layer = 2 * j; kind = (r < 3) ? 1 + r : 4 + (r - 3); }
            else { layer = 2 * j + 1; const int q = r - 5; kind = (q < 4) ? 6 + q : 4 + (q - 4); } }

        for (int rep = 0; rep < ((kind == REPEAT_KIND) ? 2 : 1); ++rep) {
        int tid = tid0; asm volatile("" : "+v"(tid));
        const int lane = tid & 63;
        if (kind == 1 || kind == 3 || kind == 4 || kind == 5 || kind == 6 || kind == 9) {
            pg8::Gemm g; pg8::EpiG E{};
            E.rpart_in = rpart; E.rpart_out = rpart; E.Xf = Xf; E.Xb = Xb;
            if (kind == 1) { g = pg8::Gemm{Xb, (const bf16_t*)(ws + W_CIN + (size_t)j * 6 * MiB), M, 3072, 1024, 1024, 1024}; E.mode = 0; E.O = OV; E.ldc = 3072; }
            else if (kind == 3) { g = pg8::Gemm{A2, (const bf16_t*)(ws + W_COUT + (size_t)j * 2 * MiB), M, 1024, 1024, 1024, 1024}; E.mode = 2; }
            else if (kind == 4) { g = pg8::Gemm{Xb, (const bf16_t*)(ws + W_1 + (size_t)layer * 8 * MiB), M, 4096, 1024, 1024, 1024}; E.mode = 3; E.O = OV; E.ldc = HLD; }
            else if (kind == 5) { g = pg8::Gemm{OV, (const bf16_t*)(ws + W_2 + (size_t)layer * 9 * MiB), M, 1024, 4096, HLD, HLD}; E.mode = 2; }
            else if (kind == 6) { g = pg8::Gemm{Xb, (const bf16_t*)(ws + W_FIN + (size_t)j * 6 * MiB), M, 3072, 1024, 1024, 1024}; E.mode = 1;
                E.Qb = Qb; E.Kb = Kb; E.Vb = Vb; E.qkm = (unsigned*)(ws + WS_QKM) + j * 128;
                E.outKp = out + O_PK + (size_t)j * SEQ * 1024; E.outVp = out + O_PV + (size_t)j * SEQ * 1024;
                E.outKs = out + O_SK + (size_t)j * MS * 1024; E.outVs = out + O_SV + (size_t)j * MS * 1024; }
            else { g = pg8::Gemm{A2, (const bf16_t*)(ws + W_FO + (size_t)j * 2 * MiB), M, 1024, 1024, 1024, 1024}; E.mode = 2; }
            if (rep == 1 && E.mode == 2) { E.Xf = (float*)(ws + 410 * MiB); E.Xb = (bf16_t*)(ws + 479 * MiB); E.rpart_out = (float*)(ws + 514 * MiB); }
            const bool first_res = (kind == 3 && j == 0);
            E.XinP = first_res ? x_prompt : Xf; const float* xinS = first_res ? x_sample : Xf + (size_t)SEQ * 1024;
            E.rl = (const PG8_LAS float*)(lds + 131072); E.pm0 = -1;
            g.M = SEQ;
            pg8::StaticOrder S; S.init(g.M, g.N, G, bx);
            if (kind == 6 && (bx & 1)) F1_EXTRAS();
            if (E.mode != 2) {
                pg8::Unit u0; S.next(0, u0); E.pm0 = u0.pm;
                const int row = u0.pm * 256 + (tid >> 1); const f32x4* rp = (const f32x4*)(rpart + (size_t)row * 16 + (tid & 1) * 8);
                const f32x4 a_ = rp[0], b_ = rp[1]; float s_ = ((a_[0] + a_[1]) + (a_[2] + a_[3])) + ((b_[0] + b_[1]) + (b_[2] + b_[3]));
                s_ += __shfl_xor(s_, 1);
                if ((tid & 1) == 0) ((LAS float*)(lds + 131072))[tid >> 1] = 1.0f / sqrtf(s_ * (1.0f / 1024.0f) + EPS);
                __syncthreads();
            }
            pg8::gemm_phase<pg8::EpiG, pg8::StaticOrder, true, true>(lds, g, S, E);
            small_gemm(lds, g.A, g.lda, g.Bt, g.ldb, g.N, g.K, E, vcu, G, tid, wave, xinS);
            if (kind == 6 && !(bx & 1)) F1_EXTRAS();
        } else if (kind == 0) {
            LAS float* scr = (LAS float*)(lds + wave * 16384);
            for (int it = gw; it < 24576; it += NGW) {
                if (it < 8192) { const int jj = it >> 12, r = it & 4095;
                    if (r < 1536) transpose_item(conv_w_in + (size_t)jj * 1024 * 3072, 1024, 3072, 3072, norm_mix + (2 * jj) * 1024, (bf16_t*)(ws + W_CIN + (size_t)jj * 6 * MiB), scr, r, lane);
                    else if (r < 2048) transpose_item(conv_w_out + (size_t)jj * 1024 * 1024, 1024, 1024, 1024, nullptr, (bf16_t*)(ws + W_COUT + (size_t)jj * 2 * MiB), scr, r - 1536, lane);
                    else if (r < 3584) transpose_item(fox_w_in + (size_t)jj * 1024 * 3088, 1024, 3072, 3088, norm_mix + (2 * jj + 1) * 1024, (bf16_t*)(ws + W_FIN + (size_t)jj * 6 * MiB), scr, r - 2048, lane);
                    else transpose_item(fox_w_out + (size_t)jj * 1024 * 1024, 1024, 1024, 1024, nullptr, (bf16_t*)(ws + W_FO + (size_t)jj * 2 * MiB), scr, r - 3584, lane);
                } else { const int r0 = it - 8192, i = r0 >> 12, r = r0 & 4095;
                    if (r < 2048) transpose_item(mlp_w1 + (size_t)i * 1024 * 4096, 1024, 4096, 4096, norm_mlp + i * 1024, (bf16_t*)(ws + W_1 + (size_t)i * 8 * MiB), scr, r, lane);
                    else transpose_item(mlp_w2 + (size_t)i * 4096 * 1024, 4096, 1024, 1024, nullptr, (bf16_t*)(ws + W_2 + (size_t)i * 9 * MiB), scr, r - 2048, lane, HLD);
                }
            }
            for (int idx = gw * 64 + lane; idx < 2 * 16 * 1024; idx += NGW * 64) {
                const int jj = idx >> 14, hh = (idx >> 10) & 15, k = idx & 1023;
                const float v = fox_w_in[(size_t)jj * 1024 * 3088 + (size_t)k * 3088 + 3072 + hh] * norm_mix[(2 * jj + 1) * 1024 + k];
                ((bf16_t*)(ws + WS_WF))[idx] = (bf16_t)(pk2(v, 0.f) & 0xffffu);
            }
            for (int m = gw; m < M; m += NGW) {
                const float* xr = (m < SEQ) ? x_prompt + (size_t)m * 1024 : x_sample + (size_t)(m - SEQ) * 1024;
                f32x4 v[4]; float s = 0.f;
#pragma unroll
                for (int q = 0; q < 4; ++q) { v[q] = *(const f32x4*)(xr + q * 256 + lane * 4); s += (v[q][0] * v[q][0] + v[q][1] * v[q][1]) + (v[q][2] * v[q][2] + v[q][3] * v[q][3]); }
                s = wave_sum(s);
#pragma unroll
                for (int q = 0; q < 4; ++q) {
                    u32x2 w; w.x = pk2(v[q][0], v[q][1]); w.y = pk2(v[q][2], v[q][3]); *(u32x2*)(Xb + (size_t)m * 1024 + q * 256 + lane * 4) = w; }
                if (lane < 16) rpart[(size_t)m * 16 + lane] = (lane == 0) ? s : 0.f;
            }
            if (bx == 0) { ((unsigned*)(ws + WS_QKM))[tid] = 0u; for (int i = tid; i < XCD_BAR_WORDS; i += 512) ((unsigned*)(ws + WS_BAR))[i] = 0u; }
        } else if (kind == 2) {
            const bf16_t* BCH = OV; const float* cw = conv_w + (size_t)j * 3 * 1024;
            for (int it = gw; it < 2 * (SEQ / 16) + 2 * (MS / 4); it += NGW) {
                int ch, row0, R;
                if (it < 2 * (SEQ / 16)) { ch = it & 1; row0 = (it >> 1) * 16; R = 16; } else { const int s_ = it - 2 * (SEQ / 16); ch = s_ & 1; row0 = SEQ + (s_ >> 1) * 4; R = 4; }
                const int col = ch * 512 + lane * 8;
                float w0[8], w1[8], w2[8], um2[8], um1[8];
#pragma unroll
                for (int e = 0; e < 8; ++e) { w0[e] = cw[col + e]; w1[e] = cw[1024 + col + e]; w2[e] = cw[2048 + col + e]; }
                const bool samp = row0 >= SEQ; const int t0 = samp ? ((row0 - SEQ) & 31) : row0;
                if (t0 == 0) {
                    if (samp) { const int b = (row0 - SEQ) >> 5; const float* sp = state_conv + ((size_t)(j * NSB + b) * 2) * 1024 + col;
#pragma unroll
                        for (int e = 0; e < 8; ++e) { um2[e] = sp[e]; um1[e] = sp[1024 + e]; } }
                    else {
#pragma unroll
                        for (int e = 0; e < 8; ++e) { um2[e] = 0.f; um1[e] = 0.f; } }
                } else {
#pragma unroll
                    for (int q = 0; q < 2; ++q) { const bf16_t* rp = BCH + (size_t)(row0 - 2 + q) * 3072 + col;
                        const u32x4 c = *(const u32x4*)(rp + 1024), hh = *(const u32x4*)(rp + 2048);
#pragma unroll
                        for (int e = 0; e < 4; ++e) { const float ulo = bf_lo(c[e]) * bf_lo(hh[e]), uhi = bf_hi(c[e]) * bf_hi(hh[e]);
                            if (q == 0) { um2[2 * e] = ulo; um2[2 * e + 1] = uhi; } else { um1[2 * e] = ulo; um1[2 * e + 1] = uhi; } } }
                }
                for (int r4 = 0; r4 < R; r4 += 4) {
                u32x4 bbq[4], cq[4], hq[4];
#pragma unroll
                for (int q = 0; q < 4; ++q) { const bf16_t* rp = BCH + (size_t)(row0 + r4 + q) * 3072 + col; bbq[q] = *(const u32x4*)rp; cq[q] = *(const u32x4*)(rp + 1024); hq[q] = *(const u32x4*)(rp + 2048); }
                asm volatile("" : "+v"(bbq[0]), "+v"(bbq[1]), "+v"(bbq[2]), "+v"(bbq[3]), "+v"(cq[0]), "+v"(cq[1]), "+v"(cq[2]), "+v"(cq[3]), "+v"(hq[0]), "+v"(hq[1]), "+v"(hq[2]), "+v"(hq[3]));
#pragma unroll
                for (int q = 0; q < 4; ++q) {
                    const int r = r4 + q; const int row = row0 + r;
                    const u32x4 bb = bbq[q], c = cq[q], hh = hq[q];
                    float uu[8], vv[8];
#pragma unroll
                    for (int e = 0; e < 4; ++e) { uu[2 * e] = bf_lo(c[e]) * bf_lo(hh[e]); uu[2 * e + 1] = bf_hi(c[e]) * bf_hi(hh[e]); }
#pragma unroll
                    for (int e = 0; e < 4; ++e) {
                        vv[2 * e] = bf_lo(bb[e]) * (w0[2 * e] * um2[2 * e] + w1[2 * e] * um1[2 * e] + w2[2 * e] * uu[2 * e]);
                        vv[2 * e + 1] = bf_hi(bb[e]) * (w0[2 * e + 1] * um2[2 * e + 1] + w1[2 * e + 1] * um1[2 * e + 1] + w2[2 * e + 1] * uu[2 * e + 1]); }
                    u32x4 w; w.x = pk2(vv[0], vv[1]); w.y = pk2(vv[2], vv[3]); w.z = pk2(vv[4], vv[5]); w.w = pk2(vv[6], vv[7]);
                    *(u32x4*)(A2 + (size_t)row * 1024 + col) = w;
                    float* so = nullptr;
                    if (!samp) { if (row >= SEQ - 2) so = out + O_PCONV + ((size_t)j * 2 + (row - (SEQ - 2))) * 1024 + col; }
                    else { const int sr = row - SEQ, tt = sr & 31; if (tt >= 30) so = out + O_SCONV + ((size_t)(j * NSB + (sr >> 5)) * 2 + (tt - 30)) * 1024 + col; }
                    if (so) { *(f32x4*)so = (f32x4){uu[0], uu[1], uu[2], uu[3]}; *(f32x4*)(so + 4) = (f32x4){uu[4], uu[5], uu[6], uu[7]}; }
#pragma unroll
                    for (int e = 0; e < 8; ++e) { um2[e] = um1[e]; um1[e] = uu[e]; }
                }
                }
            }
        } else if (kind == 7) {
            if (bx < 144) {
                LAS float* red = (LAS float*)(lds + 80 * 1024);
                LAS float* sv = (LAS float*)lds;
                const bool pr = bx < 16; const int hh = pr ? bx : ((bx - 16) & 15), b = pr ? 0 : ((bx - 16) >> 4);
                const int n = pr ? SEQ : (PAST + TS), per = pr ? 32 : 5;
                const float* clf = cache_lf + ((size_t)(j * NSB + b) * PAST) * 16 + hh;
                const float* nlf = pr ? LF + hh : LF + (size_t)(SEQ + b * 32) * 16 + hh;
                float* dst = pr ? c2p + (size_t)hh * SEQ : c2s + (size_t)(b * 16 + hh) * LSP;
                if (pr) {
                    float v[32];
#pragma unroll
                    for (int i = 0; i < 32; ++i) v[i] = nlf[(size_t)(i * 512 + tid) * 16];
#pragma unroll
                    for (int i = 0; i < 32; ++i) { const int pos = i * 512 + tid; sv[pos + (pos >> 5)] = v[i]; }
                } else {
                    float v[5];
#pragma unroll
                    for (int i = 0; i < 5; ++i) { const int pos = i * 512 + tid; v[i] = (pos < PAST) ? clf[(size_t)pos * 16] : (pos < n ? nlf[(size_t)(pos - PAST) * 16] : 0.f); }
#pragma unroll
                    for (int i = 0; i < 5; ++i) { const int pos = i * 512 + tid; sv[pos + (pos >> 5)] = v[i]; }
                }
                __syncthreads();
                const int s0 = tid * per; float tot = 0.f;
                for (int i = 0; i < per; ++i) { const int pos = s0 + i; if (pos < n) tot += sv[pos + (pos >> 5)]; }
                float inc = tot;
#pragma unroll
                for (int o = 1; o < 64; o <<= 1) { const float t = __shfl_up(inc, o); if (lane >= o) inc += t; }
                if (lane == 63) red[wave] = inc;
                __syncthreads();
                float run = inc - tot;
                for (int w = 0; w < wave; ++w) run += red[w];
                for (int i = 0; i < per; ++i) { const int pos = s0 + i; if (pos < n) { run += sv[pos + (pos >> 5)]; sv[pos + (pos >> 5)] = run * LOG2E; } }
                __syncthreads();
                for (int pos = tid; pos < n; pos += 512) dst[pos] = sv[pos + (pos >> 5)];
                __syncthreads();
            }
        } else if (kind == 8) {
            const unsigned* qkm = (const unsigned*)(ws + WS_QKM) + j * 128;
            unsigned* qctr = (unsigned*)(ws + WS_QKM) + 256 + j * 64;
            volatile LAS int* aord = (volatile LAS int*)(lds + A_END); volatile LAS float* atot = (volatile LAS float*)(lds + A_END + 64); volatile LAS unsigned* aq = (volatile LAS unsigned*)(lds + A_END + 128);
            volatile LAS float* acs = (volatile LAS float*)(lds + A_END + 192);
            if (tid < 16) { atot[tid] = c2p[(size_t)tid * SEQ + SEQ - 1];
                const float qn2_ = fmaxf(__uint_as_float(qkm[tid * 2]) + __uint_as_float(qkm[tid * 2 + 1]), __uint_as_float(qkm[80 + tid]));
                const float kn2_ = fmaxf(__uint_as_float(qkm[32 + tid * 2]) + __uint_as_float(qkm[32 + tid * 2 + 1]), __uint_as_float(qkm[64 + tid]));
                acs[tid] = QC2 * 1.02f * sqrtf(qn2_ * kn2_); }
            __syncthreads();
            if (tid < 16) { const float me = atot[tid]; int rk = 0; for (int o2 = 0; o2 < 16; ++o2) { const float ot = atot[o2]; rk += (ot > me || (ot == me && o2 < tid)) ? 1 : 0; } aord[rk] = tid; }
            __syncthreads();
            if (tid == 0) aq[0] = atomicAdd(qctr, 1u);
            __syncthreads();
            int q = (int)aq[0];
            while (q < 1024 + 128) {
                unsigned nq = 0u; if (tid == 0) nq = atomicAdd(qctr, 1u);
                int hh, nrows, p0; long qrow0, kvbase; const float* c2seq;
                if (q >= 128) { const int qq = q - 128; hh = aord[qq >> 6]; const int qb = 63 - (qq & 63); qrow0 = 256 * qb; kvbase = 0; p0 = 256 * qb; nrows = 256; c2seq = c2p + (size_t)hh * SEQ; }
                else { const int sI = q, b = sI >> 4;   hh = sI & 15; qrow0 = SEQ + 32 * b; kvbase = SEQ + (long)b * LSP; p0 = PAST; nrows = 32; c2seq = c2s + (size_t)(b * 16 + hh) * LSP; }
                const float CS1 = acs[hh];
                const float TH = 2.0f * CS1 + 152.0f;
                attn_unit(lds, Qb, Kb, Vb, A2, c2seq, qrow0, kvbase, p0, nrows, hh, TH, CS1, lane, wave);
                if (tid == 0) aq[0] = nq;
                __syncthreads();
                q = (int)aq[0];
                __syncthreads();
            }
        } else {
            f32x4 gg[4];
#pragma unroll
            for (int q = 0; q < 4; ++q) gg[q] = *(const f32x4*)(norm_final + q * 256 + lane * 4);
            for (int m = gw; m < M; m += NGW) {
                const f32x4* rp = (const f32x4*)(rpart + (size_t)m * 16);
                f32x4 ra = rp[0], rb = rp[1], rc = rp[2], rd = rp[3], v[4];
#pragma unroll
                for (int q = 0; q < 4; ++q) v[q] = *(const f32x4*)(Xf + (size_t)m * 1024 + q * 256 + lane * 4);
                asm volatile("" : "+v"(ra), "+v"(rb), "+v"(rc), "+v"(rd), "+v"(v[0]), "+v"(v[1]), "+v"(v[2]), "+v"(v[3]));
                const float sN = ((ra[0] + ra[1]) + (ra[2] + ra[3])) + ((rb[0] + rb[1]) + (rb[2] + rb[3])) + ((rc[0] + rc[1]) + (rc[2] + rc[3])) + ((rd[0] + rd[1]) + (rd[2] + rd[3]));
                const float r = 1.0f / sqrtf(sN * (1.0f / 1024.0f) + EPS);
#pragma unroll
                for (int q = 0; q < 4; ++q) *(f32x4*)(out + O_Y + (size_t)m * 1024 + q * 256 + lane * 4) = v[q] * r * gg[q];
            }
        }
        }
    }
}

constexpr int NSTEPS = 24;
extern "C" void kernel_launch(void* const* d_in, const int* in_sizes, int n_in, void* d_out, int out_size, void* d_ws, size_t ws_size, hipStream_t stream) {
    static int grid = 0;
    if (grid == 0) {
        if (n_in != 17 || ws_size < WS_END) { fprintf(stderr, "kernel_launch: unexpected n_in %d or workspace %zu < %zu\n", n_in, ws_size, (size_t)WS_END); grid = -1; return; }
        int dev = 0, cus = 0, per_cu = 0;
        hipGetDevice(&dev); hipDeviceGetAttribute(&cus, hipDeviceAttributeMultiprocessorCount, dev);
        hipFuncSetAttribute((const void*)fwd<true>, hipFuncAttributeMaxDynamicSharedMemorySize, LDS_BYTES);
        hipFuncSetAttribute((const void*)fwd<false>, hipFuncAttributeMaxDynamicSharedMemorySize, LDS_BYTES);
        hipOccupancyMaxActiveBlocksPerMultiprocessor(&per_cu, (const void*)fwd<true>, 512, LDS_BYTES);
        (void)hipGetLastError();
        if (per_cu < 1) per_cu = 1;
        grid = cus * 1;
        fprintf(stderr, "kernel_launch: cus %d per_cu %d grid %d\n", cus, per_cu, grid);
    }
    if (grid < 0) return;
    Args a{};
    for (int i = 0; i < 17; ++i) a.in[i] = (const float*)d_in[i];
    a.out = (float*)d_out; a.ws = (unsigned char*)d_ws;
#if MULTI_LAUNCH
    for (int p = 0; p < NSTEPS; ++p) { a.lo = p; a.hi = p + 1; hipLaunchKernelGGL(fwd<false>, dim3(grid), dim3(512), LDS_BYTES, stream, a); }
#else
    a.lo = 0; a.hi = NSTEPS;
    void* args[] = {&a};
    hipError_t e = hipLaunchCooperativeKernel((const void*)fwd<true>, dim3(grid), dim3(512), args, LDS_BYTES, stream);
    if (e != hipSuccess) fprintf(stderr, "cooperative launch failed: %s (grid %d)\n", hipGetErrorString(e), grid);
#endif
}
```

```cpp
#include <hip/hip_runtime.h>
#include <hip/hip_cooperative_groups.h>
#include <cstdio>
#include <cstdint>
namespace cg = cooperative_groups;
#ifndef REPEAT_KIND
#define REPEAT_KIND -1
#endif
#ifndef MULTI_LAUNCH
#define MULTI_LAUNCH 0
#endif
constexpr int D = 1024, SEQ = 16384, NSB = 8, TS = 32, PAST = 2048, MS = NSB * TS, M = SEQ + MS, FF = 4096, NH = 16;
constexpr int HLD = 4096 + 64;
constexpr int LSP = 2112;
constexpr int KVROWS = SEQ + NSB * LSP;
constexpr float EPS = 1e-5f;
constexpr float LOG2E = 1.4426950408889634f;
constexpr float QC2 = 0.125f * 1.4426950408889634f;
namespace pg8 {
#define PG8_LAS __attribute__((address_space(3)))
typedef unsigned short bf16_t;
typedef short bf16x8 __attribute__((ext_vector_type(8)));
typedef float f32x4 __attribute__((ext_vector_type(4)));
typedef unsigned u32x4 __attribute__((ext_vector_type(4)));
constexpr int BM = 256, BK = 64, HALF = 128, HTB = HALF * BK * 2  , STAGE_BYTES = 8 * HTB, NXCD = 8, WGM = 8;

__host__ __device__ __forceinline__ int lds_byte(int r, int c) { const int st = (r >> 4) * 2 + (c >> 5), rr = r & 15, cc = c & 31, ob = rr * 64 + cc * 2; return st * 1024 + (ob ^ (((ob >> 9) & 1) << 5)); }
__host__ __device__ __forceinline__ void stage_rc(int b, int& R, int& C) { const int st = b / 1024, sb = b % 1024, swz = sb ^ (((sb >> 9) & 1) << 5); R = (st >> 1) * 16 + swz / 64; C = (st & 1) * 32 + (swz % 64) / 2; }
__host__ __device__ __forceinline__ int perm32(int rho) { const int n = rho >> 4, i = rho & 15; return 8 * (i >> 2) + 4 * n + (i & 3); }

struct Unit { int pm, pn; };
struct Gemm { const bf16_t* A; const bf16_t* Bt; int M, N, K, lda, ldb; };

struct StaticOrder {
    int nM, nN, nwg, G, c;
    __host__ __device__ void init(int M, int N, int G_, int c_) { nM = M / BM; nN = N / BM; nwg = nM * nN; G = G_; c = c_; }
    __host__ __device__ bool next(int i, Unit& u) const {
        const long L = (long)i * G + c; if (L >= nwg) return false;
        int wgid = (int)L; { const int q = nwg / NXCD, r = nwg % NXCD, xcd = wgid % NXCD, off = wgid / NXCD; wgid = (xcd < r ? xcd * (q + 1) : r * (q + 1) + (xcd - r) * q) + off; }
        const int nig = WGM * nN, gid = wgid / nig, fm = gid * WGM, gsz = (nM - fm) < WGM ? (nM - fm) : WGM;
        u.pm = fm + ((wgid % nig) % gsz); u.pn = (wgid % nig) / gsz; return true;
    }
    __device__ __forceinline__ void a_ready(const Unit&) const {}
    __device__ __forceinline__ void done(const Unit&) const {}
};
__device__ __forceinline__ unsigned cvt_pk_bf16(float lo, float hi) { unsigned r; asm volatile("v_cvt_pk_bf16_f32 %0, %1, %2" : "=v"(r) : "v"(lo), "v"(hi)); return r; }
typedef float f32x2 __attribute__((ext_vector_type(2)));
struct EpiG {
    static constexpr bool PERM = true, AFTER_DRAIN = false;
    int mode;
    bf16_t* O; int ldc;
    const float* rpart_in;
    float* Xf; bf16_t* Xb; float* rpart_out;
    bf16_t *Qb, *Kb, *Vb; float *outKp, *outVp, *outKs, *outVs; unsigned* qkm;
    const PG8_LAS float* rl; int pm0;
    const float* XinP;
    __device__ __forceinline__ void operator()(const f32x4 (&acc)[2][2][4][2], const Unit& u, int wr, int wc, int fr, int fq) const {
        const int rowb = u.pm * BM + wr * 64 + fr;
        const int colb = u.pn * BM + wc * 32 + 8 * fq;
        if (mode == 2) {
#pragma unroll
            for (int ai = 0; ai < 2; ++ai) {
                u32x4 pre[4][2];
#pragma unroll
                for (int m = 0; m < 4; ++m) { const bf16_t* xi = Xb + (size_t)(rowb + ai * HALF + m * 16) * 1024 + colb;
#pragma unroll
                    for (int bj = 0; bj < 2; ++bj) pre[m][bj] = *(const u32x4*)(xi + bj * HALF); }
                asm volatile("" : "+v"(pre[0][0]), "+v"(pre[0][1]), "+v"(pre[1][0]), "+v"(pre[1][1]), "+v"(pre[2][0]), "+v"(pre[2][1]), "+v"(pre[3][0]), "+v"(pre[3][1]));
#pragma unroll
                for (int m = 0; m < 4; ++m) {
                    const int row = rowb + ai * HALF + m * 16;
                    bf16_t* bp = Xb + (size_t)row * 1024 + colb; float ss = 0.f;
#pragma unroll
                    for (int bj = 0; bj < 2; ++bj) {
                        const u32x4 pw = pre[m][bj];
                        f32x4 x0 = {__uint_as_float(pw.x << 16), __uint_as_float(pw.x & 0xffff0000u), __uint_as_float(pw.y << 16), __uint_as_float(pw.y & 0xffff0000u)};
                        f32x4 x1 = {__uint_as_float(pw.z << 16), __uint_as_float(pw.z & 0xffff0000u), __uint_as_float(pw.w << 16), __uint_as_float(pw.w & 0xffff0000u)};
                        x0 += acc[ai][bj][m][0]; x1 += acc[ai][bj][m][1];
                        if (Xf) { float* xp = Xf + (size_t)row * 1024 + colb; *(f32x4*)(xp + bj * HALF) = x0; *(f32x4*)(xp + bj * HALF + 4) = x1; }
                        ss += (x0[0] * x0[0] + x0[1] * x0[1]) + (x0[2] * x0[2] + x0[3] * x0[3]) + (x1[0] * x1[0] + x1[1] * x1[1]) + (x1[2] * x1[2] + x1[3] * x1[3]);
                        u32x4 w; w.x = cvt_pk_bf16(x0[0], x0[1]); w.y = cvt_pk_bf16(x0[2], x0[3]); w.z = cvt_pk_bf16(x1[0], x1[1]); w.w = cvt_pk_bf16(x1[2], x1[3]);
                        *(u32x4*)(bp + bj * HALF) = w;
                    }
                    ss += __shfl_xor(ss, 16); ss += __shfl_xor(ss, 32);
                    if (fq == 0) rpart_out[(size_t)row * 16 + u.pn * 4 + wc] = ss;
                }
            }
            return;
        }
        float rinv[2][4];
        if (u.pm == pm0) {
#pragma unroll
            for (int ai = 0; ai < 2; ++ai)
#pragma unroll
                for (int m = 0; m < 4; ++m) rinv[ai][m] = rl[wr * 64 + fr + ai * HALF + m * 16];
        } else
#pragma unroll
        for (int ai = 0; ai < 2; ++ai)
#pragma unroll
            for (int m = 0; m < 4; ++m) {
                const f32x4* rp = (const f32x4*)(rpart_in + (size_t)(rowb + ai * HALF + m * 16) * 16);
                const f32x4 a = rp[0], b = rp[1], c = rp[2], d = rp[3];
                const float s = ((a[0] + a[1]) + (a[2] + a[3])) + ((b[0] + b[1]) + (b[2] + b[3])) + ((c[0] + c[1]) + (c[2] + c[3])) + ((d[0] + d[1]) + (d[2] + d[3]));
                rinv[ai][m] = 1.0f / sqrtf(s * (1.0f / 1024.0f) + 1e-5f);
            }
        if (mode == 0 || mode == 3) {
#pragma unroll
            for (int ai = 0; ai < 2; ++ai)
#pragma unroll
                for (int m = 0; m < 4; ++m) {
                    bf16_t* rowp = O + (size_t)(rowb + ai * HALF + m * 16) * ldc + colb; const float r = rinv[ai][m];
#pragma unroll
                    for (int bj = 0; bj < 2; ++bj) {
                        f32x4 v0 = acc[ai][bj][m][0] * r, v1 = acc[ai][bj][m][1] * r;
                        if (mode == 3) {
#pragma unroll
                            for (int e = 0; e < 4; ++e) { const float a0 = fmaxf(v0[e], 0.f), a1 = fmaxf(v1[e], 0.f); v0[e] = a0 * a0; v1[e] = a1 * a1; }
                        }
                        u32x4 w; w.x = cvt_pk_bf16(v0[0], v0[1]); w.y = cvt_pk_bf16(v0[2], v0[3]); w.z = cvt_pk_bf16(v1[0], v1[1]); w.w = cvt_pk_bf16(v1[2], v1[3]);
                        *(u32x4*)(rowp + bj * HALF) = w;
                    }
                }
            return;
        }
        const int t = u.pn >> 2; const int colq = (u.pn & 3) * BM + wc * 32 + 8 * fq;
        const bool samp = (u.pm >= 64);
        float mx[2] = {0.f, 0.f};
#pragma unroll
        for (int ai = 0; ai < 2; ++ai)
#pragma unroll
            for (int m = 0; m < 4; ++m) {
                const int row = rowb + ai * HALF + m * 16; const float r = rinv[ai][m];
                const int sr = row - 16384;
                const size_t kvrow = samp ? (size_t)(16384 + (sr >> 5) * 2112 + 2048 + (sr & 31)) : (size_t)row;
#pragma unroll
                for (int bj = 0; bj < 2; ++bj) {
                    f32x4 v0 = acc[ai][bj][m][0] * r, v1 = acc[ai][bj][m][1] * r;
                    if (t < 2) {
                        float s = (v0[0] * v0[0] + v0[1] * v0[1]) + (v0[2] * v0[2] + v0[3] * v0[3]) + (v1[0] * v1[0] + v1[1] * v1[1]) + (v1[2] * v1[2] + v1[3] * v1[3]);
                        s += __shfl_xor(s, 16); s += __shfl_xor(s, 32); mx[bj] = fmaxf(mx[bj], s);
                    }
                    if (t == 0) {
                        v0 = v0 * 0.18033688011112042f; v1 = v1 * 0.18033688011112042f;
                        u32x4 w; w.x = cvt_pk_bf16(v0[0], v0[1]); w.y = cvt_pk_bf16(v0[2], v0[3]); w.z = cvt_pk_bf16(v1[0], v1[1]); w.w = cvt_pk_bf16(v1[2], v1[3]);
                        *(u32x4*)(Qb + (size_t)row * 1024 + colq + bj * HALF) = w;
                    } else {
                        u32x4 w; w.x = cvt_pk_bf16(v0[0], v0[1]); w.y = cvt_pk_bf16(v0[2], v0[3]); w.z = cvt_pk_bf16(v1[0], v1[1]); w.w = cvt_pk_bf16(v1[2], v1[3]);
                        bf16_t* kb = (t == 1 ? Kb : Vb) + kvrow * 1024 + colq + bj * HALF;
                        *(u32x4*)kb = w;
                        float* ob = samp ? ((t == 1 ? outKs : outVs) + (size_t)sr * 1024) : ((t == 1 ? outKp : outVp) + (size_t)row * 1024);
                        ob += colq + bj * HALF;
                        *(f32x4*)ob = v0; *(f32x4*)(ob + 4) = v1;
                    }
                }
            }
        if (t < 2) {
#pragma unroll
            for (int bj = 0; bj < 2; ++bj) {
                float v = mx[bj];
                v = fmaxf(v, __shfl_xor(v, 1)); v = fmaxf(v, __shfl_xor(v, 2)); v = fmaxf(v, __shfl_xor(v, 4)); v = fmaxf(v, __shfl_xor(v, 8));
                const int head = (u.pn & 3) * 4 + bj * 2 + (wc >> 1);
                if ((threadIdx.x & 63) == 0) atomicMax(qkm + t * 32 + head * 2 + (wc & 1), __float_as_uint(v));
            }
        }
    }
};
template <class Epi, class Sched, bool ALIGN_EPI = false, bool SP2 = false>
__device__ __forceinline__ void gemm_phase(PG8_LAS unsigned char* lds, const Gemm g, const Sched& S, const Epi& E) {
    const int tid = threadIdx.x, wid = __builtin_amdgcn_readfirstlane(tid >> 6), lane = tid & 63, wr = wid >> 2, wc = wid & 3, fr = lane & 15, fq = lane >> 4;
    const int K = g.K, nt = K / BK;
    unsigned voffA[2], voffB[2];
#pragma unroll
    for (int i = 0; i < 2; ++i) { int R, C; stage_rc(tid * 16 + i * 8192, R, C); const int Rb = Epi::PERM ? ((R & ~31) + perm32(R & 31)) : R;
        voffA[i] = (unsigned)(R * g.lda + C) * 2u; voffB[i] = (unsigned)(Rb * g.ldb + C) * 2u; }
    const size_t kstep = (size_t)(BK * 2);
    const size_t hstep = (size_t)HALF * g.ldb * 2;
    const size_t tstep = 2 * hstep;
    const size_t hstepA = (size_t)HALF * g.lda * 2, tstepA = 2 * hstepA;
    const unsigned ldsw = (unsigned)wid * 1024u;
    const int aoff = lds_byte(wr * 64 + fr, fq * 8), boff = lds_byte(wc * 32 + fr, fq * 8);
#define PG8_SA(b, h) (((b) * 2 + (h)) * HTB)
#define PG8_SB(b, h) ((4 + (b) * 2 + (h)) * HTB)
#define PG8_STAGE(bufoff, gbase, voff) do { _Pragma("unroll") for (int _i = 0; _i < 2; ++_i) \
        __builtin_amdgcn_global_load_lds((const unsigned*)((const char*)(gbase) + (voff)[_i]), (PG8_LAS unsigned*)(lds + (bufoff) + ldsw + _i * 8192), 16, 0, 0); } while (0)
#define PG8_LDA(dst, b, h) do { _Pragma("unroll") for (int m = 0; m < 4; ++m) _Pragma("unroll") for (int k = 0; k < 2; ++k) dst[m][k] = *(const PG8_LAS bf16x8*)(lds + PG8_SA(b, h) + aoff + m * 2048 + k * 1024); } while (0)
#define PG8_LDB(dst, b, h) do { _Pragma("unroll") for (int n = 0; n < 2; ++n) _Pragma("unroll") for (int k = 0; k < 2; ++k) dst[n][k] = *(const PG8_LAS bf16x8*)(lds + PG8_SB(b, h) + boff + n * 2048 + k * 1024); } while (0)
#define PG8_MMA(ai, bj, At, Bt) do { __builtin_amdgcn_s_setprio(1); _Pragma("unroll") for (int m = 0; m < 4; ++m) _Pragma("unroll") for (int n = 0; n < 2; ++n) _Pragma("unroll") for (int k = 0; k < 2; ++k) \
        acc[ai][bj][m][n] = __builtin_amdgcn_mfma_f32_16x16x32_bf16(Bt[n][k], At[m][k], acc[ai][bj][m][n], 0, 0, 0); __builtin_amdgcn_s_setprio(0); } while (0)
#define PG8_WAIT_V(n) asm volatile("s_waitcnt vmcnt(" #n ")" ::: "memory")
#define PG8_WAIT_L(n) asm volatile("s_waitcnt lgkmcnt(" #n ")" ::: "memory")
#define PG8_BAR __builtin_amdgcn_s_barrier()
#define PG8_SCHED __builtin_amdgcn_sched_barrier(0)
    Unit cur, nxt; int ui = 0;
    if (!S.next(0, cur)) return;
    f32x4 acc[2][2][4][2];
#pragma unroll
    for (int a = 0; a < 2; ++a)
#pragma unroll
        for (int b = 0; b < 2; ++b)
#pragma unroll
            for (int m = 0; m < 4; ++m)
#pragma unroll
                for (int n = 0; n < 2; ++n) acc[a][b][m][n] = (f32x4){0.f, 0.f, 0.f, 0.f};
    bf16x8 At[4][2], B0[2][2], B1[2][2];
    const char* cA = (const char*)g.A + (size_t)cur.pm * tstepA; const char* cB = (const char*)g.Bt + (size_t)cur.pn * tstep;
    S.a_ready(cur);
    if constexpr (SP2) {
        PG8_STAGE(PG8_SB(0, 0), cB, voffB); PG8_STAGE(PG8_SB(0, 1), cB + hstep, voffB); PG8_STAGE(PG8_SA(0, 0), cA, voffA); PG8_STAGE(PG8_SA(0, 1), cA + hstepA, voffA);
        if (wr == 1) PG8_BAR;
        PG8_WAIT_V(2); PG8_BAR;
        PG8_STAGE(PG8_SB(1, 0), cB + kstep, voffB); PG8_STAGE(PG8_SA(1, 0), cA + kstep, voffA); PG8_STAGE(PG8_SB(1, 1), cB + hstep + kstep, voffB);
        PG8_WAIT_V(6); PG8_BAR;
    } else {
        PG8_STAGE(PG8_SB(0, 0), cB, voffB); PG8_STAGE(PG8_SA(0, 0), cA, voffA); PG8_STAGE(PG8_SB(0, 1), cB + hstep, voffB); PG8_STAGE(PG8_SA(0, 1), cA + hstepA, voffA);
        if (wr == 1) PG8_BAR;
        PG8_WAIT_V(4); PG8_BAR;
        PG8_STAGE(PG8_SB(1, 0), cB + kstep, voffB); PG8_STAGE(PG8_SA(1, 0), cA + kstep, voffA); PG8_STAGE(PG8_SB(1, 1), cB + hstep + kstep, voffB);
        PG8_WAIT_V(6); PG8_BAR;
    }
    for (;;) {
        const bool has_next = S.next(ui + 1, nxt);
        const char* nA = has_next ? (const char*)g.A + (size_t)nxt.pm * tstepA : cA; const char* nB = has_next ? (const char*)g.Bt + (size_t)nxt.pn * tstep : cB;
        for (int t = 0; t < nt; t += 2) {
            const bool last = (t == nt - 2);
            const char* a1 = cA + (size_t)(t + 1) * kstep;
            const char* a2 = last ? nA : cA + (size_t)(t + 2) * kstep; const char* b2 = last ? nB : cB + (size_t)(t + 2) * kstep;
            const char* a3 = a2 + kstep; const char* b3 = b2 + kstep;
            if (last && has_next) S.a_ready(nxt);
            if constexpr (SP2) {
            PG8_LDB(B0, 0, 0); PG8_LDB(B1, 0, 1); PG8_SCHED; PG8_LDA(At, 0, 0); PG8_STAGE(PG8_SA(1, 1), a1 + hstepA, voffA);
            PG8_WAIT_V(8); PG8_WAIT_L(0); PG8_BAR; PG8_MMA(0, 0, At, B0); PG8_MMA(0, 1, At, B1); PG8_BAR; PG8_SCHED;
            PG8_LDA(At, 0, 1); PG8_STAGE(PG8_SB(0, 0), b2, voffB); PG8_STAGE(PG8_SB(0, 1), b2 + hstep, voffB); PG8_STAGE(PG8_SA(0, 0), a2, voffA);
            PG8_WAIT_V(8); PG8_WAIT_L(0); PG8_BAR; PG8_MMA(1, 0, At, B0); PG8_MMA(1, 1, At, B1); PG8_BAR; PG8_SCHED;
            PG8_LDB(B0, 1, 0); PG8_LDB(B1, 1, 1); PG8_SCHED; PG8_LDA(At, 1, 0); PG8_STAGE(PG8_SA(0, 1), a2 + hstepA, voffA);
            PG8_WAIT_V(8); PG8_WAIT_L(0); PG8_BAR; PG8_MMA(0, 0, At, B0); PG8_MMA(0, 1, At, B1); PG8_BAR; PG8_SCHED;
            PG8_LDA(At, 1, 1); PG8_STAGE(PG8_SB(1, 0), b3, voffB); PG8_STAGE(PG8_SB(1, 1), b3 + hstep, voffB); PG8_STAGE(PG8_SA(1, 0), a3, voffA);
            PG8_WAIT_V(8); PG8_WAIT_L(0); PG8_BAR; PG8_MMA(1, 0, At, B0); PG8_MMA(1, 1, At, B1); PG8_BAR; PG8_SCHED;
            } else {
            PG8_LDB(B0, 0, 0); PG8_SCHED; PG8_LDA(At, 0, 0); PG8_STAGE(PG8_SA(1, 1), a1 + hstepA, voffA);
            PG8_WAIT_L(8); PG8_BAR; PG8_WAIT_L(0); PG8_MMA(0, 0, At, B0); PG8_BAR; PG8_SCHED;
            PG8_LDB(B1, 0, 1); PG8_STAGE(PG8_SB(0, 0), b2, voffB);
            PG8_BAR; PG8_WAIT_L(0); PG8_MMA(0, 1, At, B1); PG8_BAR;
            PG8_LDA(At, 0, 1); PG8_STAGE(PG8_SA(0, 0), a2, voffA);
            PG8_BAR; PG8_WAIT_L(0); PG8_MMA(1, 0, At, B0); PG8_BAR; PG8_SCHED;
            PG8_STAGE(PG8_SB(0, 1), b2 + hstep, voffB);
            PG8_WAIT_V(6); PG8_BAR; PG8_MMA(1, 1, At, B1); PG8_BAR;
            PG8_LDB(B0, 1, 0); PG8_SCHED; PG8_LDA(At, 1, 0); PG8_STAGE(PG8_SA(0, 1), a2 + hstepA, voffA);
            PG8_WAIT_L(8); PG8_BAR; PG8_WAIT_L(0); PG8_MMA(0, 0, At, B0); PG8_BAR; PG8_SCHED;
            PG8_LDB(B1, 1, 1); PG8_STAGE(PG8_SB(1, 0), b3, voffB);
            PG8_BAR; PG8_WAIT_L(0); PG8_MMA(0, 1, At, B1); PG8_BAR;
            PG8_LDA(At, 1, 1); PG8_STAGE(PG8_SA(1, 0), a3, voffA);
            PG8_BAR; PG8_WAIT_L(0); PG8_MMA(1, 0, At, B0); PG8_BAR; PG8_SCHED;
            PG8_STAGE(PG8_SB(1, 1), b3 + hstep, voffB);
            PG8_WAIT_V(6); PG8_BAR; PG8_MMA(1, 1, At, B1); PG8_BAR;
            }
        }
        if constexpr (ALIGN_EPI) { if (wr == 0) PG8_BAR; }
        if constexpr (!Epi::AFTER_DRAIN) { E(acc, cur, wr, wc, fr, fq); S.done(cur); }
        if (!has_next) break;
#pragma unroll
        for (int a = 0; a < 2; ++a)
#pragma unroll
            for (int b = 0; b < 2; ++b)
#pragma unroll
                for (int m = 0; m < 4; ++m)
#pragma unroll
                    for (int n = 0; n < 2; ++n) acc[a][b][m][n] = (f32x4){0.f, 0.f, 0.f, 0.f};
        cur = nxt; cA = nA; cB = nB; ++ui;
        if constexpr (ALIGN_EPI) { if (wr == 1) PG8_BAR; }
    }
    PG8_WAIT_V(0);
    if constexpr (!ALIGN_EPI) { if (wr == 0) PG8_BAR; }
    PG8_BAR;
    if constexpr (Epi::AFTER_DRAIN) { E.fused(acc, cur, wr, wc, fr, fq, lds, wid, lane); S.done(cur); }
#undef PG8_SA
#undef PG8_SB
#undef PG8_STAGE
#undef PG8_LDA
#undef PG8_LDB
#undef PG8_MMA
#undef PG8_WAIT_V
#undef PG8_WAIT_L
#undef PG8_BAR
#undef PG8_SCHED
}
}

#define LAS __attribute__((address_space(3)))
typedef unsigned short bf16_t;
typedef short bf16x8 __attribute__((ext_vector_type(8)));
typedef short s16x4 __attribute__((ext_vector_type(4)));
typedef float f32x4 __attribute__((ext_vector_type(4)));
typedef float f32x16 __attribute__((ext_vector_type(16)));
typedef unsigned u32x4 __attribute__((ext_vector_type(4)));
typedef unsigned u32x2 __attribute__((ext_vector_type(2)));
typedef float f32x2_t __attribute__((ext_vector_type(2)));
typedef __bf16 bf16x2_t __attribute__((ext_vector_type(2)));
__device__ __forceinline__ unsigned pk2(float lo, float hi) { f32x2_t v = {lo, hi}; bf16x2_t b = __builtin_convertvector(v, bf16x2_t); return __builtin_bit_cast(unsigned, b); }
__device__ __forceinline__ float bf_lo(unsigned w) { return __uint_as_float(w << 16); }
__device__ __forceinline__ float bf_hi(unsigned w) { return __uint_as_float(w & 0xffff0000u); }
__device__ __forceinline__ float wave_sum(float v) {
#pragma unroll
    for (int o = 1; o < 64; o <<= 1) v += __shfl_xor(v, o);
    return v;
}
__device__ __forceinline__ float rinv_row(const float* rpart, int row) {
    const f32x4* rp = (const f32x4*)(rpart + (size_t)row * 16);
    const f32x4 a = rp[0], b = rp[1], c = rp[2], d = rp[3];
    const float s = ((a[0] + a[1]) + (a[2] + a[3])) + ((b[0] + b[1]) + (b[2] + b[3])) + ((c[0] + c[1]) + (c[2] + c[3])) + ((d[0] + d[1]) + (d[2] + d[3]));
    return 1.0f / sqrtf(s * (1.0f / 1024.0f) + EPS);
}

constexpr size_t MiB = 1u << 20;
constexpr size_t WS_QKM = 0;
constexpr size_t WS_BAR = 65536;
constexpr size_t WS_RPART = 1 * MiB;
constexpr size_t WS_LF = 3 * MiB;
constexpr size_t WS_C2P = 5 * MiB;
constexpr size_t WS_C2S = 7 * MiB;
constexpr size_t WS_WF = 9 * MiB;
constexpr size_t WS_W = 10 * MiB;
constexpr size_t W_CIN = WS_W, W_COUT = WS_W + 12 * MiB, W_FIN = WS_W + 16 * MiB, W_FO = WS_W + 28 * MiB, W_1 = WS_W + 32 * MiB, W_2 = WS_W + 64 * MiB;
constexpr size_t WS_XF = 110 * MiB;
constexpr size_t WS_XB = 175 * MiB;
constexpr size_t WS_A2 = 208 * MiB;
constexpr size_t WS_OV = 241 * MiB;
constexpr size_t WS_Q = WS_OV, WS_K = WS_OV + 33 * MiB, WS_V = WS_OV + 99 * MiB;
constexpr size_t WS_END = WS_OV + 166 * MiB;

constexpr size_t O_Y = 0, O_PCONV = 17039360, O_PK = 17043456, O_PV = 50597888, O_PLF = 84152320, O_SCONV = 84676608, O_SK = 84709376, O_SV = 85233664, O_SLF = 85757952;

constexpr int WLDS = 17408;
constexpr int LDS_CTL = 8 * WLDS;
constexpr int LDS_BYTES = 8 * WLDS + 256;

struct Args { const float* in[17]; float* out; unsigned char* ws; int lo, hi; };

__device__ __forceinline__ int crow(int r, int hi) { return (r & 3) + 8 * (r >> 2) + 4 * hi; }
__device__ __forceinline__ void glds16(const void* gsrc, unsigned lds_dst) { unsigned keep;
    asm volatile("s_mov_b32 %0, m0\n\ts_mov_b32 m0, %2\n\ts_nop 0\n\tglobal_load_lds_dwordx4 %1, off\n\ts_mov_b32 m0, %0" : "=&s"(keep) : "v"(gsrc), "s"(lds_dst) : "memory"); }
__device__ __forceinline__ void glds4(const void* gsrc, unsigned lds_dst) { unsigned keep;
    asm volatile("s_mov_b32 %0, m0\n\ts_mov_b32 m0, %2\n\ts_nop 0\n\tglobal_load_lds_dword %1, off\n\ts_mov_b32 m0, %0" : "=&s"(keep) : "v"(gsrc), "s"(lds_dst) : "memory"); }
#define SBAR() __builtin_amdgcn_sched_barrier(0)
struct VFrag { s16x4 lo[8], hi[8]; };
template <int d0> __device__ __forceinline__ void pv_reads(VFrag& f, int vb) {
#pragma unroll
        for (int ks = 0; ks < 4; ++ks) {
            asm volatile("ds_read_b64_tr_b16 %0,%1 offset:%c2" : "=&v"(f.lo[d0 * 4 + ks]) : "v"(vb), "i"(d0 * 4096 + ks * 1024) : "memory");
            asm volatile("ds_read_b64_tr_b16 %0,%1 offset:%c2" : "=&v"(f.hi[d0 * 4 + ks]) : "v"(vb), "i"(d0 * 4096 + ks * 1024 + 512) : "memory"); }
}
__device__ __forceinline__ void pv_mfma(f32x16* o, VFrag& f, bf16x8 pa0, bf16x8 pa1, bf16x8 pa2, bf16x8 pa3) {
    asm volatile("s_waitcnt lgkmcnt(0)" : "+v"(f.lo[0]), "+v"(f.lo[1]), "+v"(f.lo[2]), "+v"(f.lo[3]), "+v"(f.lo[4]), "+v"(f.lo[5]), "+v"(f.lo[6]), "+v"(f.lo[7]),
                 "+v"(f.hi[0]), "+v"(f.hi[1]), "+v"(f.hi[2]), "+v"(f.hi[3]), "+v"(f.hi[4]), "+v"(f.hi[5]), "+v"(f.hi[6]), "+v"(f.hi[7]) :: "memory");
#define PK(k) (bf16x8){f.lo[k][0], f.lo[k][1], f.lo[k][2], f.lo[k][3], f.hi[k][0], f.hi[k][1], f.hi[k][2], f.hi[k][3]}
    o[0] = __builtin_amdgcn_mfma_f32_32x32x16_bf16(pa0, PK(0), o[0], 0, 0, 0);
    o[1] = __builtin_amdgcn_mfma_f32_32x32x16_bf16(pa0, PK(4), o[1], 0, 0, 0);
    o[0] = __builtin_amdgcn_mfma_f32_32x32x16_bf16(pa1, PK(1), o[0], 0, 0, 0);
    o[1] = __builtin_amdgcn_mfma_f32_32x32x16_bf16(pa1, PK(5), o[1], 0, 0, 0);
    o[0] = __builtin_amdgcn_mfma_f32_32x32x16_bf16(pa2, PK(2), o[0], 0, 0, 0);
    o[1] = __builtin_amdgcn_mfma_f32_32x32x16_bf16(pa2, PK(6), o[1], 0, 0, 0);
    o[0] = __builtin_amdgcn_mfma_f32_32x32x16_bf16(pa3, PK(3), o[0], 0, 0, 0);
    o[1] = __builtin_amdgcn_mfma_f32_32x32x16_bf16(pa3, PK(7), o[1], 0, 0, 0);
#undef PK
}
constexpr int ANS = 4;
constexpr int A_K = 0, A_V = ANS * 8192, A_C = 2 * ANS * 8192, A_WSF = A_C + ANS * 2048, A_OST = A_WSF + 2048, A_END = A_OST + 8 * 4096;
static_assert(A_END <= 8 * WLDS, "attention LDS map");
__device__ __forceinline__ void attn_unit(LAS unsigned char* sh, const bf16_t* Qb, const bf16_t* __restrict__ Kb, const bf16_t* __restrict__ Vb, bf16_t* Ob,
                                          const float* __restrict__ c2seq, long qrow0, long kvbase, int p0, int nrows, int h, float TH, float CS1, int lane, int wave) {
    const int r32 = lane & 31, hi = lane >> 5;
    const unsigned lbase = (unsigned)(uintptr_t)sh;
    const bool active = wave * 32 < nrows;
    const int pw = p0 + 32 * wave;
    bf16x8 qr[4];
    { const bf16_t* Qw = Qb + (qrow0 + (active ? wave * 32 : 0) + r32) * D + h * 64;
#pragma unroll
      for (int d0 = 0; d0 < 4; ++d0) qr[d0] = *(const bf16x8*)(Qw + d0 * 16 + hi * 8); }
    const int plast = p0 + nrows - 1, tl_u = plast >> 6, tl_w = (pw + 31) >> 6;
    float cref = c2seq[p0];
    float crefw = c2seq[active ? pw : p0];
    float cv0; { const int t = tl_u - lane; int idx = 64 * t + 63; idx = idx > plast ? plast : idx; cv0 = c2seq[idx < 0 ? 0 : idx]; }
    asm volatile("" : "+v"(cref), "+v"(crefw), "+v"(cv0), "+v"(qr[0]), "+v"(qr[1]), "+v"(qr[2]), "+v"(qr[3]));
    int tstart = 0;
    for (int tb = tl_u; tb >= 0; tb -= 64) {
        const int t = tb - lane; int idx = 64 * t + 63; idx = idx > plast ? plast : idx;
        const float cv = (tb == tl_u) ? cv0 : ((t >= 0) ? c2seq[idx] : 0.f);
        const bool skip = (t >= 0) && (cref - cv < -TH);
        const unsigned long long bal = __ballot(skip);
        if (bal) { tstart = tb - (__ffsll((long long)bal) - 1) + 1; break; }
    }
    tstart = __builtin_amdgcn_readfirstlane(tstart);
    const int n = tl_u - tstart + 1;
    const bf16_t* ksrc = Kb + (kvbase + lane) * D + h * 64 + wave * 8;
    const bf16_t* vsrc = Vb + (kvbase + 16 * (wave & 3) + (lane >> 2)) * D + h * 64 + (wave >> 2) * 32 + (lane & 3) * 8;
    const float* csrc = c2seq + lane;
#define ISSUE(i_) do { const int t_ = tl_u - (i_), sl_ = (i_) & (ANS - 1); \
    glds16(ksrc + (long)t_ * 64 * D, lbase + A_K + sl_ * 8192 + wave * 1024); \
    glds16(vsrc + (long)t_ * 64 * D, lbase + A_V + sl_ * 8192 + wave * 1024); \
    glds4(csrc + t_ * 64, lbase + A_C + sl_ * 2048 + wave * 256); } while (0)
    float mhat = 0.f, l_reg = 0.f; f32x16 o[2]; o[0] = f32x16{}; o[1] = f32x16{};
    float mmin = -INFINITY;
    bool wdone = false;
    LAS float* wsf = (LAS float*)(sh + A_WSF + wave * 256);
    const int vb0 = (int)(lbase + A_V) + ((lane >> 4) & 1) * 32 + (lane & 3) * 8 + (4 * hi + ((lane & 15) >> 2)) * 64;
    const LAS unsigned char* kb0 = sh + A_K + hi * 1024 + r32 * 16;
    asm volatile("" : "+v"(qr[0]), "+v"(qr[1]), "+v"(qr[2]), "+v"(qr[3]));
    if (0 < n) ISSUE(0);
    if (1 < n) ISSUE(1);
    if (2 < n) ISSUE(2);
    for (int i = 0; i < n; ++i) {
        const int rem = n - 1 - i;
        if (rem >= 2) asm volatile("s_waitcnt vmcnt(6)" ::: "memory"); else if (rem == 1) asm volatile("s_waitcnt vmcnt(3)" ::: "memory"); else asm volatile("s_waitcnt vmcnt(0)" ::: "memory");
        asm volatile("s_waitcnt lgkmcnt(0)\n\ts_barrier" ::: "memory");
        if (i + 3 < n) ISSUE(i + 3);
        const int t = tl_u - i, sl = i & (ANS - 1);
        const LAS unsigned char* cp = sh + A_C + sl * 2048 + wave * 256;
        if (active && t < tl_w && !wdone) { const float cend = *(const LAS float*)(cp + 63 * 4); if (crefw - cend < -TH || (cref - cend) + CS1 - mmin < -152.0f) wdone = true; }
        if (active && t <= tl_w && !wdone) {
            f32x16 p0v, p1v;
            const LAS unsigned char* kbp = kb0 + sl * 8192;
            bf16x8 kf[8];
#pragma unroll
            for (int d0 = 0; d0 < 4; ++d0) { kf[2 * d0] = *(const LAS bf16x8*)(kbp + d0 * 2048); kf[2 * d0 + 1] = *(const LAS bf16x8*)(kbp + d0 * 2048 + 512); }
            { const float X = cref - mhat;
#pragma unroll
              for (int g = 0; g < 4; ++g) {
                  const f32x4 ca = *(const LAS f32x4*)(cp + (8 * g + 4 * hi) * 4), cb = *(const LAS f32x4*)(cp + (32 + 8 * g + 4 * hi) * 4);
#pragma unroll
                  for (int e = 0; e < 4; ++e) { p0v[4 * g + e] = X - ca[e]; p1v[4 * g + e] = X - cb[e]; }
              } }
            asm volatile("" : "+v"(kf[0]), "+v"(kf[1]), "+v"(kf[2]), "+v"(kf[3]), "+v"(kf[4]), "+v"(kf[5]), "+v"(kf[6]), "+v"(kf[7]));
#pragma unroll
            for (int d0 = 0; d0 < 4; ++d0) {
                p0v = __builtin_amdgcn_mfma_f32_32x32x16_bf16(kf[2 * d0], qr[d0], p0v, 0, 0, 0);
                p1v = __builtin_amdgcn_mfma_f32_32x32x16_bf16(kf[2 * d0 + 1], qr[d0], p1v, 0, 0, 0);
            }
            if (t == tl_w) {
                const int qpos = pw + r32, kq = 64 * t + 4 * hi;
#pragma unroll
                for (int r = 0; r < 16; ++r) { const int kv = kq + (r & 3) + 8 * (r >> 2); if (kv > qpos) p0v[r] = -INFINITY; if (kv + 32 > qpos) p1v[r] = -INFINITY; }
            }
            float rm, rm2;
            { float a_ = __builtin_fmaxf(__builtin_fmaxf(p0v[0], p0v[1]), p1v[0]), b_ = __builtin_fmaxf(__builtin_fmaxf(p0v[2], p0v[3]), p1v[1]); a_ = __builtin_fmaxf(__builtin_fmaxf(a_, p1v[2]), p1v[3]);
#pragma unroll
              for (int r = 4; r < 16; r += 4) { a_ = __builtin_fmaxf(__builtin_fmaxf(a_, p0v[r]), p0v[r + 1]); b_ = __builtin_fmaxf(__builtin_fmaxf(b_, p0v[r + 2]), p0v[r + 3]); a_ = __builtin_fmaxf(__builtin_fmaxf(a_, p1v[r]), p1v[r + 1]); b_ = __builtin_fmaxf(__builtin_fmaxf(b_, p1v[r + 2]), p1v[r + 3]); }
              rm = __builtin_fmaxf(a_, b_); rm2 = rm; (void)rm2; }
            { auto rr = __builtin_amdgcn_permlane32_swap(__float_as_uint(rm), __float_as_uint(rm), false, false); rm = fmaxf(__uint_as_float(rr[0]), __uint_as_float(rr[1])); }
            if (t == tl_w) {
                mhat = rm;
                { float mm = mhat; mm = fminf(mm, __shfl_xor(mm, 1)); mm = fminf(mm, __shfl_xor(mm, 2)); mm = fminf(mm, __shfl_xor(mm, 4)); mm = fminf(mm, __shfl_xor(mm, 8)); mm = fminf(mm, __shfl_xor(mm, 16)); mmin = mm; }
#pragma unroll
                for (int r = 0; r < 16; ++r) { p0v[r] -= rm; p1v[r] -= rm; }
            } else if (__any(rm > 4.0f)) {
                const float dl = fmaxf(rm, 0.f); mhat += dl;
                { float mm = mhat; mm = fminf(mm, __shfl_xor(mm, 1)); mm = fminf(mm, __shfl_xor(mm, 2)); mm = fminf(mm, __shfl_xor(mm, 4)); mm = fminf(mm, __shfl_xor(mm, 8)); mm = fminf(mm, __shfl_xor(mm, 16)); mmin = mm; }
#pragma unroll
                for (int r = 0; r < 16; ++r) { p0v[r] -= dl; p1v[r] -= dl; }
                const float f = __builtin_amdgcn_exp2f(-dl); l_reg *= f;
                if (hi == 0) wsf[r32] = f;
                asm volatile("s_waitcnt lgkmcnt(0)" ::: "memory");
#pragma unroll
                for (int r = 0; r < 16; ++r) { const float fr_ = wsf[crow(r, hi)]; o[0][r] *= fr_; o[1][r] *= fr_; }
                asm volatile("s_waitcnt lgkmcnt(0)" ::: "memory");
            }
            float sacc = 0.f;
#pragma unroll
            for (int r = 0; r < 16; ++r) { p0v[r] = __builtin_amdgcn_exp2f(p0v[r]); p1v[r] = __builtin_amdgcn_exp2f(p1v[r]); sacc += p0v[r] + p1v[r]; }
            l_reg += sacc;
            VFrag vf; pv_reads<0>(vf, vb0 + sl * 8192); pv_reads<1>(vf, vb0 + sl * 8192);
            u32x4 pw0, pw1, pw2, pw3;
            pw0 = (u32x4){pk2(p0v[0], p0v[1]), pk2(p0v[2], p0v[3]), pk2(p0v[4], p0v[5]), pk2(p0v[6], p0v[7])};
            pw1 = (u32x4){pk2(p0v[8], p0v[9]), pk2(p0v[10], p0v[11]), pk2(p0v[12], p0v[13]), pk2(p0v[14], p0v[15])};
            pw2 = (u32x4){pk2(p1v[0], p1v[1]), pk2(p1v[2], p1v[3]), pk2(p1v[4], p1v[5]), pk2(p1v[6], p1v[7])};
            pw3 = (u32x4){pk2(p1v[8], p1v[9]), pk2(p1v[10], p1v[11]), pk2(p1v[12], p1v[13]), pk2(p1v[14], p1v[15])};
            pv_mfma(o, vf, __builtin_bit_cast(bf16x8, pw0), __builtin_bit_cast(bf16x8, pw1), __builtin_bit_cast(bf16x8, pw2), __builtin_bit_cast(bf16x8, pw3));
        }
    }
#undef ISSUE
    if (active) {
        { auto rr = __builtin_amdgcn_permlane32_swap(__float_as_uint(l_reg), __float_as_uint(l_reg), false, false); l_reg = __uint_as_float(rr[0]) + __uint_as_float(rr[1]); }
        if (hi == 0) wsf[32 + r32] = l_reg;
        asm volatile("s_waitcnt lgkmcnt(0)" ::: "memory");
        float rli[16];
#pragma unroll
        for (int r = 0; r < 16; ++r) rli[r] = __builtin_amdgcn_rcpf(wsf[32 + crow(r, hi)]);
        LAS bf16_t* stg = (LAS bf16_t*)(sh + A_OST + wave * 4096);
#pragma unroll
        for (int r = 0; r < 16; ++r) { const int orow = crow(r, hi);
#pragma unroll
            for (int d0 = 0; d0 < 2; ++d0) stg[orow * 64 + d0 * 32 + r32] = (bf16_t)(pk2(o[d0][r] * rli[r], 0.f) & 0xffffu); }
        asm volatile("s_waitcnt lgkmcnt(0)" ::: "memory");
        bf16_t* Ow = Ob + (qrow0 + wave * 32) * D + h * 64;
#pragma unroll
        for (int i = 0; i < 4; ++i) { const int row = i * 8 + (lane >> 3), ch = lane & 7; const u32x4 v = *(const LAS u32x4*)(stg + row * 64 + ch * 8); *(u32x4*)(Ow + (long)row * D + ch * 8) = v; }
    }
    asm volatile("s_waitcnt lgkmcnt(0)\n\ts_barrier" ::: "memory");
}

__device__ __forceinline__ void transpose_item(const float* W, int K, int N, int ldw, const float* g, bf16_t* WT, LAS float* scr, int item, int lane, int ldo = 0) {
    if (ldo == 0) ldo = K;
    const int nblk = N / 32, kb = item / nblk, nb = item % nblk, k0 = 64 * kb, n0 = 32 * nb;
    float tv[32];
#pragma unroll
    for (int i = 0; i < 32; ++i) tv[i] = W[(size_t)(k0 + 2 * i + (lane >> 5)) * ldw + n0 + (lane & 31)];
#pragma unroll
    for (int i = 0; i < 32; ++i) scr[(2 * i + (lane >> 5)) * 33 + (lane & 31)] = tv[i];
    asm volatile("s_waitcnt lgkmcnt(0)" ::: "memory");
    const int c = lane & 7;
    float gv[8];
#pragma unroll
    for (int e = 0; e < 8; ++e) gv[e] = g ? g[k0 + 8 * c + e] : 1.0f;
#pragma unroll
    for (int j = 0; j < 4; ++j) { const int n = (lane >> 3) + 8 * j; const LAS float* s = scr + (8 * c) * 33 + n;
        u32x4 o; o.x = pk2(s[0 * 33] * gv[0], s[1 * 33] * gv[1]); o.y = pk2(s[2 * 33] * gv[2], s[3 * 33] * gv[3]); o.z = pk2(s[4 * 33] * gv[4], s[5 * 33] * gv[5]); o.w = pk2(s[6 * 33] * gv[6], s[7 * 33] * gv[7]);
        *(u32x4*)(WT + (size_t)(n0 + n) * ldo + k0 + 8 * c) = o; }
    asm volatile("s_waitcnt lgkmcnt(0)" ::: "memory");
}


__device__ __forceinline__ void epi_small(const pg8::EpiG& E, int row, int col, f32x4 v, int lane, float r, const float* xinS) {
    if (E.mode == 2) {
        const u32x2 pw = *(const u32x2*)(E.Xb + (size_t)row * 1024 + col);
        f32x4 x = {__uint_as_float(pw.x << 16), __uint_as_float(pw.x & 0xffff0000u), __uint_as_float(pw.y << 16), __uint_as_float(pw.y & 0xffff0000u)};
        x += v; if (E.Xf) *(f32x4*)(E.Xf + (size_t)row * 1024 + col) = x;
        u32x2 w; w.x = pk2(x[0], x[1]); w.y = pk2(x[2], x[3]); *(u32x2*)(E.Xb + (size_t)row * 1024 + col) = w;
        float ss = (x[0] * x[0] + x[1] * x[1]) + (x[2] * x[2] + x[3] * x[3]);
        ss += __shfl_xor(ss, 1); ss += __shfl_xor(ss, 2); ss += __shfl_xor(ss, 4); ss += __shfl_xor(ss, 8);
        if ((lane & 15) == 0) E.rpart_out[(size_t)row * 16 + (col >> 6)] = ss;
        return;
    }
    v = v * r;
    if (E.mode == 0 || E.mode == 3) {
        if (E.mode == 3) {
#pragma unroll
            for (int e = 0; e < 4; ++e) { const float a0 = fmaxf(v[e], 0.f); v[e] = a0 * a0; } }
        u32x2 w; w.x = pk2(v[0], v[1]); w.y = pk2(v[2], v[3]); *(u32x2*)(E.O + (size_t)row * E.ldc + col) = w;
        return;
    }
    const int t = col >> 10, cq = col & 1023, sr = row - SEQ;
    if (t < 2) {
        float s = (v[0] * v[0] + v[1] * v[1]) + (v[2] * v[2] + v[3] * v[3]);
        s += __shfl_xor(s, 1); s += __shfl_xor(s, 2); s += __shfl_xor(s, 4); s += __shfl_xor(s, 8);
        if ((lane & 15) == 0) atomicMax(E.qkm + (t == 0 ? 80 : 64) + (cq >> 6), __float_as_uint(s));
    }
    if (t == 0) { v = v * QC2; u32x2 w; w.x = pk2(v[0], v[1]); w.y = pk2(v[2], v[3]); *(u32x2*)(E.Qb + (size_t)row * 1024 + cq) = w; }
    else {
        const size_t kvrow = (size_t)(SEQ + (sr >> 5) * LSP + PAST + (sr & 31));
        u32x2 w; w.x = pk2(v[0], v[1]); w.y = pk2(v[2], v[3]); *(u32x2*)((t == 1 ? E.Kb : E.Vb) + kvrow * 1024 + cq) = w;
        *(f32x4*)((t == 1 ? E.outKs : E.outVs) + (size_t)sr * 1024 + cq) = v;
    }
}
__device__ __forceinline__ void small_gemm(LAS unsigned char* lds, const bf16_t* A, int lda, const bf16_t* Bt, int ldb, int N, int K, const pg8::EpiG& E, int vcu, int G, int tid, int wave, const float* xinS) {
    const int lane = tid & 63, r32 = lane & 31, hi = lane >> 5, lrow = lane >> 3, lpc = lane & 7;
    LAS float* red = (LAS float*)lds;
    LAS unsigned char* stg = lds + wave * 13824;
    const int ntile = 8 * (N >> 6), kw = K >> 3;
    for (int tile = vcu; tile < ntile; tile += G) {
        const int rb = tile & 7, cb = tile >> 3;
        const bf16_t* ag = A + (size_t)(SEQ + rb * 32 + lrow) * lda + wave * kw + lpc * 8;
        const bf16_t* bg = Bt + (size_t)(cb * 64 + lrow) * ldb + wave * kw + lpc * 8;
        f32x16 c0 = f32x16{}, c1 = f32x16{};
        const float rrow = (E.mode == 2) ? 1.0f : rinv_row(E.rpart_in, SEQ + rb * 32 + (tid >> 4));
        for (int k0 = 0; k0 < kw; k0 += 128) {
            u32x4 ra[2][4], rv[2][8];
#pragma unroll
            for (int sb = 0; sb < 2; ++sb) {
#pragma unroll
                for (int i = 0; i < 4; ++i) ra[sb][i] = *(const u32x4*)(ag + (size_t)(8 * i) * lda + k0 + sb * 64);
#pragma unroll
                for (int i = 0; i < 8; ++i) rv[sb][i] = *(const u32x4*)(bg + (size_t)(8 * i) * ldb + k0 + sb * 64);
            }
            asm volatile("" : "+v"(ra[0][0]), "+v"(ra[0][1]), "+v"(ra[0][2]), "+v"(ra[0][3]), "+v"(ra[1][0]), "+v"(ra[1][1]), "+v"(ra[1][2]), "+v"(ra[1][3]),
                              "+v"(rv[0][0]), "+v"(rv[0][1]), "+v"(rv[0][2]), "+v"(rv[0][3]), "+v"(rv[0][4]), "+v"(rv[0][5]), "+v"(rv[0][6]), "+v"(rv[0][7]),
                              "+v"(rv[1][0]), "+v"(rv[1][1]), "+v"(rv[1][2]), "+v"(rv[1][3]), "+v"(rv[1][4]), "+v"(rv[1][5]), "+v"(rv[1][6]), "+v"(rv[1][7]));
#pragma unroll
            for (int sb = 0; sb < 2; ++sb) {
#pragma unroll
                for (int i = 0; i < 4; ++i) *(LAS u32x4*)(stg + (8 * i + lrow) * 144 + lpc * 16) = ra[sb][i];
#pragma unroll
                for (int i = 0; i < 8; ++i) *(LAS u32x4*)(stg + 4608 + (8 * i + lrow) * 144 + lpc * 16) = rv[sb][i];
                bf16x8 fa[4], fb0[4], fb1[4];
#pragma unroll
                for (int ks = 0; ks < 4; ++ks) { fa[ks] = *(const LAS bf16x8*)(stg + r32 * 144 + (2 * ks + hi) * 16);
                    fb0[ks] = *(const LAS bf16x8*)(stg + 4608 + r32 * 144 + (2 * ks + hi) * 16); fb1[ks] = *(const LAS bf16x8*)(stg + 4608 + (32 + r32) * 144 + (2 * ks + hi) * 16); }
#pragma unroll
                for (int ks = 0; ks < 4; ++ks) {
                    c0 = __builtin_amdgcn_mfma_f32_32x32x16_bf16(fb0[ks], fa[ks], c0, 0, 0, 0);
                    c1 = __builtin_amdgcn_mfma_f32_32x32x16_bf16(fb1[ks], fa[ks], c1, 0, 0, 0);
                }
            }
        }
        __syncthreads();
        LAS float* wr_ = red + wave * (32 * 68) + r32 * 68 + 4 * hi;
#pragma unroll
        for (int g = 0; g < 4; ++g) {
            *(LAS f32x4*)(wr_ + 8 * g) = (f32x4){c0[4 * g], c0[4 * g + 1], c0[4 * g + 2], c0[4 * g + 3]};
            *(LAS f32x4*)(wr_ + 32 + 8 * g) = (f32x4){c1[4 * g], c1[4 * g + 1], c1[4 * g + 2], c1[4 * g + 3]};
        }
        __syncthreads();
        const int m = tid >> 4, c4 = (tid & 15) * 4;
        f32x4 v = *(const LAS f32x4*)(red + m * 68 + c4);
#pragma unroll
        for (int w = 1; w < 8; ++w) v += *(const LAS f32x4*)(red + w * (32 * 68) + m * 68 + c4);
        epi_small(E, SEQ + rb * 32 + m, cb * 64 + c4, v, lane, rrow, xinS);
        __syncthreads();
    }
}

#define XB_TMO      128
#define XB_XCNT(j)  (256  + 64 * (j))
#define XB_XSUB(j)  (1280 + 64 * (j))
#define XB_XGEN(j)  (2304 + 64 * (j))
#define XB_TOP      3328
#define XB_TOPGEN   3392
#define XCD_BAR_WORDS 3456
#define XB_SPIN_CAP (1u << 18)

__device__ __forceinline__ unsigned xb_ld(unsigned* p)              { return __hip_atomic_load(p, __ATOMIC_RELAXED, __HIP_MEMORY_SCOPE_AGENT); }
__device__ __forceinline__ unsigned xb_add(unsigned* p, unsigned v) { return __hip_atomic_fetch_add(p, v, __ATOMIC_RELAXED, __HIP_MEMORY_SCOPE_AGENT); }
__device__ __forceinline__ unsigned xb_xcc_id() { return (unsigned)__builtin_amdgcn_s_getreg((3 << 11) | 20) & 0xFu; }
#define XB_SPIN(cond, bar) do { unsigned _sp = 0; while (cond) { __builtin_amdgcn_s_sleep(1); \
    if ((++_sp & 255u) == 0u) { if (xb_ld(&(bar)[XB_TMO])) break; if (_sp > XB_SPIN_CAP) { atomicAdd(&(bar)[XB_TMO], 1u); break; } } } } while (0)

struct XcdBarrier {
    unsigned* bar; unsigned x;
    volatile LAS unsigned* st;
};

__device__ __forceinline__ XcdBarrier xcd_barrier_post(unsigned* bar, volatile LAS unsigned* st) {
    XcdBarrier b; b.bar = bar; b.x = xb_xcc_id(); b.st = st;
    if (threadIdx.x == 0) (void)xb_add(&bar[XB_XCNT(b.x)], 1u);
    return b;
}
__device__ __forceinline__ void xcd_barrier_complete(unsigned* bar, unsigned x, unsigned& nloc, unsigned& nx) {
    const unsigned G = gridDim.x * gridDim.y * gridDim.z;
    unsigned sum, cnt, mine, sp = 0u;
    for (;;) {
        sum = 0u; cnt = 0u; mine = 0u;
#pragma unroll
        for (unsigned j = 0; j < 16; ++j) { const unsigned c = xb_ld(&bar[XB_XCNT(j)]); sum += c; cnt += (c > 0u) ? 1u : 0u; mine = (j == x) ? c : mine; }
        if (sum == G) break;
        __builtin_amdgcn_s_sleep(1);
        if ((++sp & 255u) == 0u) { if (xb_ld(&bar[XB_TMO])) break; if (sp > XB_SPIN_CAP) { atomicAdd(&bar[XB_TMO], 1u); break; } }
    }
    nloc = mine > 0u ? mine : 1u; nx = cnt > 0u ? cnt : 1u;
}

__device__ __forceinline__ void xcd_barrier(const XcdBarrier& b) {
    asm volatile("s_waitcnt vmcnt(0)" ::: "memory");
    __syncthreads();
    if (threadIdx.x == 0) {
        unsigned* bar = b.bar;
        __builtin_amdgcn_s_waitcnt(0);
        unsigned nloc = b.st[0], nx = b.st[1];
        if (nloc == 0u) { xcd_barrier_complete(bar, b.x, nloc, nx); b.st[0] = nloc; b.st[1] = nx; }
        const unsigned old = xb_add(&bar[XB_XSUB(b.x)], 1u);
        const unsigned gen = old / nloc;
        if (old + 1u == (gen + 1u) * nloc) {
            __builtin_amdgcn_fence(__ATOMIC_RELEASE, "agent");
            asm volatile("s_waitcnt vmcnt(0)" ::: "memory");
            const unsigned og = xb_add(&bar[XB_TOP], 1u);
            const unsigned tg = og / nx;
            if (og + 1u == (tg + 1u) * nx) xb_add(&bar[XB_TOPGEN], 1u);
            else XB_SPIN(xb_ld(&bar[XB_TOPGEN]) == tg, bar);
            __builtin_amdgcn_fence(__ATOMIC_ACQUIRE, "agent");
            xb_add(&bar[XB_XGEN(b.x)], 1u);
            asm volatile("s_waitcnt vmcnt(0)" ::: "memory");
        } else {
            XB_SPIN(xb_ld(&bar[XB_XGEN(b.x)]) == gen, bar);
            __builtin_amdgcn_fence(__ATOMIC_ACQUIRE, "agent");
            asm volatile("s_waitcnt vmcnt(0)" ::: "memory");
        }
    }
    __syncthreads();
}

#define F1_EXTRAS() do { \
                const bf16_t* Wf = (const bf16_t*)(ws + WS_WF) + (size_t)j * 16 * 1024; \
                const int fr = lane & 15, fq = lane >> 4; \
                for (int grp = gw; grp < M / 16; grp += NGW) { \
                    const int row = grp * 16 + fr; \
                    const bf16_t* xp = Xb + (size_t)row * 1024 + fq * 8; const bf16_t* wp = Wf + (size_t)fr * 1024 + fq * 8; \
                    f32x4 acc = {0.f, 0.f, 0.f, 0.f}; \
                    const float r = rinv_row(rpart, row); \
                    const f32x4 bf = *(const f32x4*)(fox_b_f + j * 16 + 4 * fq); \
                    for (int k0 = 0; k0 < 32; k0 += 8) { \
                        bf16x8 xa[8], wa[8]; \
_Pragma("unroll") \
                        for (int ks = 0; ks < 8; ++ks) { xa[ks] = *(const bf16x8*)(xp + (k0 + ks) * 32); wa[ks] = *(const bf16x8*)(wp + (k0 + ks) * 32); } \
                        asm volatile("" : "+v"(xa[0]), "+v"(xa[1]), "+v"(xa[2]), "+v"(xa[3]), "+v"(xa[4]), "+v"(xa[5]), "+v"(xa[6]), "+v"(xa[7]), \
                                          "+v"(wa[0]), "+v"(wa[1]), "+v"(wa[2]), "+v"(wa[3]), "+v"(wa[4]), "+v"(wa[5]), "+v"(wa[6]), "+v"(wa[7])); \
_Pragma("unroll") \
                        for (int ks = 0; ks < 8; ++ks) acc = __builtin_amdgcn_mfma_f32_16x16x32_bf16(wa[ks], xa[ks], acc, 0, 0, 0); \
                    } \
                    f32x4 lf; \
_Pragma("unroll") \
                    for (int e = 0; e < 4; ++e) { const float x = acc[e] * r + bf[e]; lf[e] = fminf(x, 0.f) - log1pf(expf(-fabsf(x))); } \
                    *(f32x4*)(LF + (size_t)row * 16 + 4 * fq) = lf; \
                    float* op = (row < SEQ) ? out + O_PLF + ((size_t)j * SEQ + row) * 16 : out + O_SLF + ((size_t)j * MS + (row - SEQ)) * 16; \
                    *(f32x4*)(op + 4 * fq) = lf; \
                } \
                { \
                    const float* ck = cache_k + (size_t)j * NSB * PAST * 1024; const float* cv = cache_v + (size_t)j * NSB * PAST * 1024; \
                    float kmax = 0.f; \
                    for (int hr0 = gw; hr0 < NSB * PAST * 2; hr0 += 4 * NGW) { \
                        f32x4 kk[4][2], vv[4][2]; \
_Pragma("unroll") \
                        for (int q = 0; q < 4; ++q) { const int hr = hr0 + q * NGW; const int b = hr >> 12, pos = (hr >> 1) & 2047, half = hr & 1; \
                            const size_t so = ((size_t)(b * PAST + pos)) * 1024 + half * 512 + lane * 8; \
                            kk[q][0] = *(const f32x4*)(ck + so); kk[q][1] = *(const f32x4*)(ck + so + 4); vv[q][0] = *(const f32x4*)(cv + so); vv[q][1] = *(const f32x4*)(cv + so + 4); } \
_Pragma("unroll") \
                        for (int q = 0; q < 4; ++q) { const int hr = hr0 + q * NGW; const int b = hr >> 12, pos = (hr >> 1) & 2047, half = hr & 1; \
                            const size_t dofs = ((size_t)(SEQ + b * LSP + pos)) * 1024 + half * 512 + lane * 8; \
                            const f32x4 k0 = kk[q][0], k1 = kk[q][1], v0 = vv[q][0], v1 = vv[q][1]; \
                            u32x4 w; w.x = pk2(k0[0], k0[1]); w.y = pk2(k0[2], k0[3]); w.z = pk2(k1[0], k1[1]); w.w = pk2(k1[2], k1[3]); \
                            *(u32x4*)(Kb + dofs) = w; \
                            w.x = pk2(v0[0], v0[1]); w.y = pk2(v0[2], v0[3]); w.z = pk2(v1[0], v1[1]); w.w = pk2(v1[2], v1[3]); \
                            *(u32x4*)(Vb + dofs) = w; \
                            float s = (k0[0] * k0[0] + k0[1] * k0[1]) + (k0[2] * k0[2] + k0[3] * k0[3]) + (k1[0] * k1[0] + k1[1] * k1[1]) + (k1[2] * k1[2] + k1[3] * k1[3]); \
                            s += __shfl_xor(s, 1); s += __shfl_xor(s, 2); s += __shfl_xor(s, 4); \
                            kmax = fmaxf(kmax, s); } \
                    } \
                    if ((lane & 7) == 0) atomicMax((unsigned*)(ws + WS_QKM) + j * 128 + 64 + (gw & 1) * 8 + (lane >> 3), __float_as_uint(kmax)); \
                    if (gw < NSB * 32) { \
                        const size_t dofs = ((size_t)(SEQ + (gw >> 5) * LSP + PAST + TS + (gw & 31))) * 1024 + lane * 16; \
                        const u32x4 z = {0u, 0u, 0u, 0u}; \
                        *(u32x4*)(Kb + dofs) = z; *(u32x4*)(Kb + dofs + 8) = z; *(u32x4*)(Vb + dofs) = z; *(u32x4*)(Vb + dofs + 8) = z; \
                    } \
                } \
} while (0)

template <bool COOP>
__global__ void __launch_bounds__(512, 2) fwd(Args a) {
    extern __shared__ __attribute__((aligned(16))) unsigned char smem[];
    LAS unsigned char* lds = (LAS unsigned char*)smem;
    const int tid0 = threadIdx.x, wave = __builtin_amdgcn_readfirstlane(tid0 >> 6);
    const int G = gridDim.x, bx = blockIdx.x;
    const int vcu = (G % 8 == 0) ? (bx % 8) * (G / 8) + bx / 8 : bx;
    const int gw = vcu * 8 + wave, NGW = G * 8;
    unsigned char* ws = a.ws;
    float* rpart = (float*)(ws + WS_RPART);
    float* LF = (float*)(ws + WS_LF);
    float* c2p = (float*)(ws + WS_C2P);
    float* c2s = (float*)(ws + WS_C2S);
    float* Xf = (float*)(ws + WS_XF);
    bf16_t* Xb = (bf16_t*)(ws + WS_XB);
    bf16_t* A2 = (bf16_t*)(ws + WS_A2);
    bf16_t* OV = (bf16_t*)(ws + WS_OV);
    bf16_t* Qb = (bf16_t*)(ws + WS_Q);
    bf16_t* Kb = (bf16_t*)(ws + WS_K);
    bf16_t* Vb = (bf16_t*)(ws + WS_V);
    const float* x_prompt = a.in[0]; const float* x_sample = a.in[1]; const float* state_conv = a.in[2];
    const float* cache_k = a.in[3]; const float* cache_v = a.in[4]; const float* cache_lf = a.in[5];
    const float* norm_mix = a.in[6]; const float* norm_mlp = a.in[7]; const float* norm_final = a.in[8];
    const float* conv_w_in = a.in[9]; const float* conv_w = a.in[10]; const float* conv_w_out = a.in[11];
    const float* fox_w_in = a.in[12]; const float* fox_b_f = a.in[13]; const float* fox_w_out = a.in[14];
    const float* mlp_w1 = a.in[15]; const float* mlp_w2 = a.in[16];
    float* out = a.out;
    volatile LAS unsigned* misc = (volatile LAS unsigned*)(lds + LDS_CTL);
    if (tid0 < 4) misc[tid0] = 0u;
    __syncthreads();
    XcdBarrier xbar; xbar.bar = (unsigned*)(ws + WS_BAR); xbar.x = 0; xbar.st = misc;

    for (int step = a.lo; step < a.hi; ++step) {
        if constexpr (COOP) {
            if (step == a.lo + 1) { cg::this_grid().sync(); xbar = xcd_barrier_post((unsigned*)(ws + WS_BAR), misc); }
            else if (step > a.lo + 1) xcd_barrier(xbar);
        }
        int kind;
        int j = 0, layer = 0;
        if (step == 0) kind = 0;
        else if (step == 23) kind = 10;
        else { const int s = step - 1; j = s / 11; const int r = s % 11;
            if (r < 5) { layer = 2 * j; kind = (r < 3) ? 1 + r : 4 + (r - 3); }
            else { layer = 2 * j + 1; const int q = r - 5; kind = (q < 4) ? 6 + q : 4 + (q - 4); } }

        for (int rep = 0; rep < ((kind == REPEAT_KIND) ? 2 : 1); ++rep) {
        int tid = tid0; asm volatile("" : "+v"(tid));
        const int lane = tid & 63;
        if (kind == 1 || kind == 3 || kind == 4 || kind == 5 || kind == 6 || kind == 9) {
            pg8::Gemm g; pg8::EpiG E{};
            E.rpart_in = rpart; E.rpart_out = rpart; E.Xf = nullptr; E.Xb = Xb;
            if (kind == 1) { g = pg8::Gemm{Xb, (const bf16_t*)(ws + W_CIN + (size_t)j * 6 * MiB), M, 3072, 1024, 1024, 1024}; E.mode = 0; E.O = OV; E.ldc = 3072; }
            else if (kind == 3) { g = pg8::Gemm{A2, (const bf16_t*)(ws + W_COUT + (size_t)j * 2 * MiB), M, 1024, 1024, 1024, 1024}; E.mode = 2; }
            else if (kind == 4) { g = pg8::Gemm{Xb, (const bf16_t*)(ws + W_1 + (size_t)layer * 8 * MiB), M, 4096, 1024, 1024, 1024}; E.mode = 3; E.O = OV; E.ldc = HLD; }
            else if (kind == 5) { g = pg8::Gemm{OV, (const bf16_t*)(ws + W_2 + (size_t)layer * 9 * MiB), M, 1024, 4096, HLD, HLD}; E.mode = 2; if (layer == 3) E.Xf = Xf;   }
            else if (kind == 6) { g = pg8::Gemm{Xb, (const bf16_t*)(ws + W_FIN + (size_t)j * 6 * MiB), M, 3072, 1024, 1024, 1024}; E.mode = 1;
                E.Qb = Qb; E.Kb = Kb; E.Vb = Vb; E.qkm = (unsigned*)(ws + WS_QKM) + j * 128;
                E.outKp = out + O_PK + (size_t)j * SEQ * 1024; E.outVp = out + O_PV + (size_t)j * SEQ * 1024;
                E.outKs = out + O_SK + (size_t)j * MS * 1024; E.outVs = out + O_SV + (size_t)j * MS * 1024; }
            else { g = pg8::Gemm{A2, (const bf16_t*)(ws + W_FO + (size_t)j * 2 * MiB), M, 1024, 1024, 1024, 1024}; E.mode = 2; }
            if (rep == 1 && E.mode == 2) { E.Xf = (float*)(ws + 410 * MiB); E.Xb = (bf16_t*)(ws + 479 * MiB); E.rpart_out = (float*)(ws + 514 * MiB); }
            const bool first_res = (kind == 3 && j == 0);
            E.XinP = first_res ? x_prompt : Xf; const float* xinS = first_res ? x_sample : Xf + (size_t)SEQ * 1024;
            E.rl = (const PG8_LAS float*)(lds + 131072); E.pm0 = -1;
            g.M = SEQ;
            pg8::StaticOrder S; S.init(g.M, g.N, G, bx);
            if (kind == 6 && (bx & 1)) F1_EXTRAS();
            if (E.mode != 2) {
                pg8::Unit u0; S.next(0, u0); E.pm0 = u0.pm;
                const int row = u0.pm * 256 + (tid >> 1); const f32x4* rp = (const f32x4*)(rpart + (size_t)row * 16 + (tid & 1) * 8);
                const f32x4 a_ = rp[0], b_ = rp[1]; float s_ = ((a_[0] + a_[1]) + (a_[2] + a_[3])) + ((b_[0] + b_[1]) + (b_[2] + b_[3]));
                s_ += __shfl_xor(s_, 1);
                if ((tid & 1) == 0) ((LAS float*)(lds + 131072))[tid >> 1] = 1.0f / sqrtf(s_ * (1.0f / 1024.0f) + EPS);
                __syncthreads();
            }
            pg8::gemm_phase<pg8::EpiG, pg8::StaticOrder, true, true>(lds, g, S, E);
            small_gemm(lds, g.A, g.lda, g.Bt, g.ldb, g.N, g.K, E, vcu, G, tid, wave, xinS);
            if (kind == 6 && !(bx & 1)) F1_EXTRAS();
        } else if (kind == 0) {
            LAS float* scr = (LAS float*)(lds + wave * 16384);
            for (int it = gw; it < 24576; it += NGW) {
                if (it < 8192) { const int jj = it >> 12, r = it & 4095;
                    if (r < 1536) transpose_item(conv_w_in + (size_t)jj * 1024 * 3072, 1024, 3072, 3072, norm_mix + (2 * jj) * 1024, (bf16_t*)(ws + W_CIN + (size_t)jj * 6 * MiB), scr, r, lane);
                    else if (r < 2048) transpose_item(conv_w_out + (size_t)jj * 1024 * 1024, 1024, 1024, 1024, nullptr, (bf16_t*)(ws + W_COUT + (size_t)jj * 2 * MiB), scr, r - 1536, lane);
                    else if (r < 3584) transpose_item(fox_w_in + (size_t)jj * 1024 * 3088, 1024, 3072, 3088, norm_mix + (2 * jj + 1) * 1024, (bf16_t*)(ws + W_FIN + (size_t)jj * 6 * MiB), scr, r - 2048, lane);
                    else transpose_item(fox_w_out + (size_t)jj * 1024 * 1024, 1024, 1024, 1024, nullptr, (bf16_t*)(ws + W_FO + (size_t)jj * 2 * MiB), scr, r - 3584, lane);
                } else { const int r0 = it - 8192, i = r0 >> 12, r = r0 & 4095;
                    if (r < 2048) transpose_item(mlp_w1 + (size_t)i * 1024 * 4096, 1024, 4096, 4096, norm_mlp + i * 1024, (bf16_t*)(ws + W_1 + (size_t)i * 8 * MiB), scr, r, lane);
                    else transpose_item(mlp_w2 + (size_t)i * 4096 * 1024, 4096, 1024, 1024, nullptr, (bf16_t*)(ws + W_2 + (size_t)i * 9 * MiB), scr, r - 2048, lane, HLD);
                }
            }
            for (int idx = gw * 64 + lane; idx < 2 * 16 * 1024; idx += NGW * 64) {
                const int jj = idx >> 14, hh = (idx >> 10) & 15, k = idx & 1023;
                const float v = fox_w_in[(size_t)jj * 1024 * 3088 + (size_t)k * 3088 + 3072 + hh] * norm_mix[(2 * jj + 1) * 1024 + k];
                ((bf16_t*)(ws + WS_WF))[idx] = (bf16_t)(pk2(v, 0.f) & 0xffffu);
            }
            for (int m = gw; m < M; m += NGW) {
                const float* xr = (m < SEQ) ? x_prompt + (size_t)m * 1024 : x_sample + (size_t)(m - SEQ) * 1024;
                f32x4 v[4]; float s = 0.f;
#pragma unroll
                for (int q = 0; q < 4; ++q) { v[q] = *(const f32x4*)(xr + q * 256 + lane * 4); s += (v[q][0] * v[q][0] + v[q][1] * v[q][1]) + (v[q][2] * v[q][2] + v[q][3] * v[q][3]); }
                s = wave_sum(s);
#pragma unroll
                for (int q = 0; q < 4; ++q) {
                    u32x2 w; w.x = pk2(v[q][0], v[q][1]); w.y = pk2(v[q][2], v[q][3]); *(u32x2*)(Xb + (size_t)m * 1024 + q * 256 + lane * 4) = w; }
                if (lane < 16) rpart[(size_t)m * 16 + lane] = (lane == 0) ? s : 0.f;
            }
            if (bx == 0) { ((unsigned*)(ws + WS_QKM))[tid] = 0u; for (int i = tid; i < XCD_BAR_WORDS; i += 512) ((unsigned*)(ws + WS_BAR))[i] = 0u; }
        } else if (kind == 2) {
            const bf16_t* BCH = OV; const float* cw = conv_w + (size_t)j * 3 * 1024;
            for (int it = gw; it < 2 * (M / 16); it += NGW) {
                const int ch = it & 1, row0 = (it >> 1) * 16, col = ch * 512 + lane * 8;
                float w0[8], w1[8], w2[8], um2[8], um1[8];
#pragma unroll
                for (int e = 0; e < 8; ++e) { w0[e] = cw[col + e]; w1[e] = cw[1024 + col + e]; w2[e] = cw[2048 + col + e]; }
                const bool samp = row0 >= SEQ; const int t0 = samp ? ((row0 - SEQ) & 31) : row0;
                if (t0 == 0) {
                    if (samp) { const int b = (row0 - SEQ) >> 5; const float* sp = state_conv + ((size_t)(j * NSB + b) * 2) * 1024 + col;
#pragma unroll
                        for (int e = 0; e < 8; ++e) { um2[e] = sp[e]; um1[e] = sp[1024 + e]; } }
                    else {
#pragma unroll
                        for (int e = 0; e < 8; ++e) { um2[e] = 0.f; um1[e] = 0.f; } }
                } else {
#pragma unroll
                    for (int q = 0; q < 2; ++q) { const bf16_t* rp = BCH + (size_t)(row0 - 2 + q) * 3072 + col;
                        const u32x4 c = *(const u32x4*)(rp + 1024), hh = *(const u32x4*)(rp + 2048);
#pragma unroll
                        for (int e = 0; e < 4; ++e) { const float ulo = bf_lo(c[e]) * bf_lo(hh[e]), uhi = bf_hi(c[e]) * bf_hi(hh[e]);
                            if (q == 0) { um2[2 * e] = ulo; um2[2 * e + 1] = uhi; } else { um1[2 * e] = ulo; um1[2 * e + 1] = uhi; } } }
                }
                for (int r4 = 0; r4 < 16; r4 += 4) {
                u32x4 bbq[4], cq[4], hq[4];
#pragma unroll
                for (int q = 0; q < 4; ++q) { const bf16_t* rp = BCH + (size_t)(row0 + r4 + q) * 3072 + col; bbq[q] = *(const u32x4*)rp; cq[q] = *(const u32x4*)(rp + 1024); hq[q] = *(const u32x4*)(rp + 2048); }
                asm volatile("" : "+v"(bbq[0]), "+v"(bbq[1]), "+v"(bbq[2]), "+v"(bbq[3]), "+v"(cq[0]), "+v"(cq[1]), "+v"(cq[2]), "+v"(cq[3]), "+v"(hq[0]), "+v"(hq[1]), "+v"(hq[2]), "+v"(hq[3]));
#pragma unroll
                for (int q = 0; q < 4; ++q) {
                    const int r = r4 + q; const int row = row0 + r;
                    const u32x4 bb = bbq[q], c = cq[q], hh = hq[q];
                    float uu[8], vv[8];
#pragma unroll
                    for (int e = 0; e < 4; ++e) { uu[2 * e] = bf_lo(c[e]) * bf_lo(hh[e]); uu[2 * e + 1] = bf_hi(c[e]) * bf_hi(hh[e]); }
#pragma unroll
                    for (int e = 0; e < 4; ++e) {
                        vv[2 * e] = bf_lo(bb[e]) * (w0[2 * e] * um2[2 * e] + w1[2 * e] * um1[2 * e] + w2[2 * e] * uu[2 * e]);
                        vv[2 * e + 1] = bf_hi(bb[e]) * (w0[2 * e + 1] * um2[2 * e + 1] + w1[2 * e + 1] * um1[2 * e + 1] + w2[2 * e + 1] * uu[2 * e + 1]); }
                    u32x4 w; w.x = pk2(vv[0], vv[1]); w.y = pk2(vv[2], vv[3]); w.z = pk2(vv[4], vv[5]); w.w = pk2(vv[6], vv[7]);
                    *(u32x4*)(A2 + (size_t)row * 1024 + col) = w;
                    float* so = nullptr;
                    if (!samp) { if (row >= SEQ - 2) so = out + O_PCONV + ((size_t)j * 2 + (row - (SEQ - 2))) * 1024 + col; }
                    else { const int sr = row - SEQ, tt = sr & 31; if (tt >= 30) so = out + O_SCONV + ((size_t)(j * NSB + (sr >> 5)) * 2 + (tt - 30)) * 1024 + col; }
                    if (so) { *(f32x4*)so = (f32x4){uu[0], uu[1], uu[2], uu[3]}; *(f32x4*)(so + 4) = (f32x4){uu[4], uu[5], uu[6], uu[7]}; }
#pragma unroll
                    for (int e = 0; e < 8; ++e) { um2[e] = um1[e]; um1[e] = uu[e]; }
                }
                }
            }
        } else if (kind == 7) {
            if (bx < 144) {
                LAS float* red = (LAS float*)(lds + 80 * 1024);
                LAS float* sv = (LAS float*)lds;
                const bool pr = bx < 16; const int hh = pr ? bx : ((bx - 16) & 15), b = pr ? 0 : ((bx - 16) >> 4);
                const int n = pr ? SEQ : (PAST + TS), per = pr ? 32 : 5;
                const float* clf = cache_lf + ((size_t)(j * NSB + b) * PAST) * 16 + hh;
                const float* nlf = pr ? LF + hh : LF + (size_t)(SEQ + b * 32) * 16 + hh;
                float* dst = pr ? c2p + (size_t)hh * SEQ : c2s + (size_t)(b * 16 + hh) * LSP;
                if (pr) {
                    float v[32];
#pragma unroll
                    for (int i = 0; i < 32; ++i) v[i] = nlf[(size_t)(i * 512 + tid) * 16];
#pragma unroll
                    for (int i = 0; i < 32; ++i) { const int pos = i * 512 + tid; sv[pos + (pos >> 5)] = v[i]; }
                } else {
                    float v[5];
#pragma unroll
                    for (int i = 0; i < 5; ++i) { const int pos = i * 512 + tid; v[i] = (pos < PAST) ? clf[(size_t)pos * 16] : (pos < n ? nlf[(size_t)(pos - PAST) * 16] : 0.f); }
#pragma unroll
                    for (int i = 0; i < 5; ++i) { const int pos = i * 512 + tid; sv[pos + (pos >> 5)] = v[i]; }
                }
                __syncthreads();
                const int s0 = tid * per; float tot = 0.f;
                for (int i = 0; i < per; ++i) { const int pos = s0 + i; if (pos < n) tot += sv[pos + (pos >> 5)]; }
                float inc = tot;
#pragma unroll
                for (int o = 1; o < 64; o <<= 1) { const float t = __shfl_up(inc, o); if (lane >= o) inc += t; }
                if (lane == 63) red[wave] = inc;
                __syncthreads();
                float run = inc - tot;
                for (int w = 0; w < wave; ++w) run += red[w];
                for (int i = 0; i < per; ++i) { const int pos = s0 + i; if (pos < n) { run += sv[pos + (pos >> 5)]; sv[pos + (pos >> 5)] = run * LOG2E; } }
                __syncthreads();
                for (int pos = tid; pos < n; pos += 512) dst[pos] = sv[pos + (pos >> 5)];
                __syncthreads();
            }
        } else if (kind == 8) {
            const unsigned* qkm = (const unsigned*)(ws + WS_QKM) + j * 128;
            unsigned* qctr = (unsigned*)(ws + WS_QKM) + 256 + j * 64;
            volatile LAS int* aord = (volatile LAS int*)(lds + A_END); volatile LAS float* atot = (volatile LAS float*)(lds + A_END + 64); volatile LAS unsigned* aq = (volatile LAS unsigned*)(lds + A_END + 128);
            volatile LAS float* acs = (volatile LAS float*)(lds + A_END + 192);
            if (tid < 16) { atot[tid] = c2p[(size_t)tid * SEQ + SEQ - 1];
                const float qn2_ = fmaxf(__uint_as_float(qkm[tid * 2]) + __uint_as_float(qkm[tid * 2 + 1]), __uint_as_float(qkm[80 + tid]));
                const float kn2_ = fmaxf(__uint_as_float(qkm[32 + tid * 2]) + __uint_as_float(qkm[32 + tid * 2 + 1]), __uint_as_float(qkm[64 + tid]));
                acs[tid] = QC2 * 1.02f * sqrtf(qn2_ * kn2_); }
            __syncthreads();
            if (tid < 16) { const float me = atot[tid]; int rk = 0; for (int o2 = 0; o2 < 16; ++o2) { const float ot = atot[o2]; rk += (ot > me || (ot == me && o2 < tid)) ? 1 : 0; } aord[rk] = tid; }
            __syncthreads();
            if (tid == 0) aq[0] = atomicAdd(qctr, 1u);
            __syncthreads();
            int q = (int)aq[0];
            while (q < 1024 + 128) {
                unsigned nq = 0u; if (tid == 0) nq = atomicAdd(qctr, 1u);
                int hh, nrows, p0; long qrow0, kvbase; const float* c2seq;
                if (q >= 128) { const int qq = q - 128; hh = aord[qq >> 6]; const int qb = 63 - (qq & 63); qrow0 = 256 * qb; kvbase = 0; p0 = 256 * qb; nrows = 256; c2seq = c2p + (size_t)hh * SEQ; }
                else { const int sI = q, b = sI >> 4;   hh = sI & 15; qrow0 = SEQ + 32 * b; kvbase = SEQ + (long)b * LSP; p0 = PAST; nrows = 32; c2seq = c2s + (size_t)(b * 16 + hh) * LSP; }
                const float CS1 = acs[hh];
                const float TH = 2.0f * CS1 + 152.0f;
                attn_unit(lds, Qb, Kb, Vb, A2, c2seq, qrow0, kvbase, p0, nrows, hh, TH, CS1, lane, wave);
                if (tid == 0) aq[0] = nq;
                __syncthreads();
                q = (int)aq[0];
                __syncthreads();
            }
        } else {
            f32x4 gg[4];
#pragma unroll
            for (int q = 0; q < 4; ++q) gg[q] = *(const f32x4*)(norm_final + q * 256 + lane * 4);
            for (int m = gw; m < M; m += NGW) {
                const f32x4* rp = (const f32x4*)(rpart + (size_t)m * 16);
                f32x4 ra = rp[0], rb = rp[1], rc = rp[2], rd = rp[3], v[4];
#pragma unroll
                for (int q = 0; q < 4; ++q) v[q] = *(const f32x4*)(Xf + (size_t)m * 1024 + q * 256 + lane * 4);
                asm volatile("" : "+v"(ra), "+v"(rb), "+v"(rc), "+v"(rd), "+v"(v[0]), "+v"(v[1]), "+v"(v[2]), "+v"(v[3]));
                const float sN = ((ra[0] + ra[1]) + (ra[2] + ra[3])) + ((rb[0] + rb[1]) + (rb[2] + rb[3])) + ((rc[0] + rc[1]) + (rc[2] + rc[3])) + ((rd[0] + rd[1]) + (rd[2] + rd[3]));
                const float r = 1.0f / sqrtf(sN * (1.0f / 1024.0f) + EPS);
#pragma unroll
                for (int q = 0; q < 4; ++q) *(f32x4*)(out + O_Y + (size_t)m * 1024 + q * 256 + lane * 4) = v[q] * r * gg[q];
            }
        }
        }
    }
}

constexpr int NSTEPS = 24;
extern "C" void kernel_launch(void* const* d_in, const int* in_sizes, int n_in, void* d_out, int out_size, void* d_ws, size_t ws_size, hipStream_t stream) {
    static int grid = 0;
    if (grid == 0) {
        if (n_in != 17 || ws_size < WS_END) { fprintf(stderr, "kernel_launch: unexpected n_in %d or workspace %zu < %zu\n", n_in, ws_size, (size_t)WS_END); grid = -1; return; }
        int dev = 0, cus = 0, per_cu = 0;
        hipGetDevice(&dev); hipDeviceGetAttribute(&cus, hipDeviceAttributeMultiprocessorCount, dev);
        hipFuncSetAttribute((const void*)fwd<true>, hipFuncAttributeMaxDynamicSharedMemorySize, LDS_BYTES);
        hipFuncSetAttribute((const void*)fwd<false>, hipFuncAttributeMaxDynamicSharedMemorySize, LDS_BYTES);
        hipOccupancyMaxActiveBlocksPerMultiprocessor(&per_cu, (const void*)fwd<true>, 512, LDS_BYTES);
        (void)hipGetLastError();
        if (per_cu < 1) per_cu = 1;
        grid = cus * 1;
        fprintf(stderr, "kernel_launch: cus %d per_cu %d grid %d\n", cus, per_cu, grid);
    }
    if (grid < 0) return;
    Args a{};
    for (int i = 0; i < 17; ++i) a.in[i] = (const float*)d_in[i];
    a.out = (float*)d_out; a.ws = (unsigned char*)d_ws;
#if MULTI_LAUNCH
    for (int p = 0; p < NSTEPS; ++p) { a.lo = p; a.hi = p + 1; hipLaunchKernelGGL(fwd<false>, dim3(grid), dim3(512), LDS_BYTES, stream, a); }
#else
    a.lo = 0; a.hi = NSTEPS;
    void* args[] = {&a};
    hipError_t e = hipLaunchCooperativeKernel((const void*)fwd<true>, dim3(grid), dim3(512), args, LDS_BYTES, stream);
    if (e != hipSuccess) fprintf(stderr, "cooperative launch failed: %s (grid %d)\n", hipGetErrorString(e), grid);
#endif
}
```

```cpp
#include <hip/hip_runtime.h>
#include <hip/hip_cooperative_groups.h>
#include <cstdio>
#include <cstdint>
namespace cg = cooperative_groups;
#ifndef REPEAT_KIND
#define REPEAT_KIND -1
#endif
#ifndef MULTI_LAUNCH
#define MULTI_LAUNCH 0
#endif
constexpr int D = 1024, SEQ = 16384, NSB = 8, TS = 32, PAST = 2048, MS = NSB * TS, M = SEQ + MS, FF = 4096, NH = 16;
constexpr int HLD = 4096 + 64;
constexpr int LSP = 2112;
constexpr int KVROWS = SEQ + NSB * LSP;
constexpr float EPS = 1e-5f;
constexpr float LOG2E = 1.4426950408889634f;
constexpr float QC2 = 0.125f * 1.4426950408889634f;
namespace pg8 {
#define PG8_LAS __attribute__((address_space(3)))
typedef unsigned short bf16_t;
typedef short bf16x8 __attribute__((ext_vector_type(8)));
typedef float f32x4 __attribute__((ext_vector_type(4)));
typedef unsigned u32x4 __attribute__((ext_vector_type(4)));
constexpr int BM = 256, BK = 64, HALF = 128, HTB = HALF * BK * 2  , STAGE_BYTES = 8 * HTB, NXCD = 8, WGM = 8;

__host__ __device__ __forceinline__ int lds_byte(int r, int c) { const int st = (r >> 4) * 2 + (c >> 5), rr = r & 15, cc = c & 31, ob = rr * 64 + cc * 2; return st * 1024 + (ob ^ (((ob >> 9) & 1) << 5)); }
__host__ __device__ __forceinline__ void stage_rc(int b, int& R, int& C) { const int st = b / 1024, sb = b % 1024, swz = sb ^ (((sb >> 9) & 1) << 5); R = (st >> 1) * 16 + swz / 64; C = (st & 1) * 32 + (swz % 64) / 2; }
__host__ __device__ __forceinline__ int perm32(int rho) { const int n = rho >> 4, i = rho & 15; return 8 * (i >> 2) + 4 * n + (i & 3); }

struct Unit { int pm, pn; };
struct Gemm { const bf16_t* A; const bf16_t* Bt; int M, N, K, lda, ldb; };

struct StaticOrder {
    int nM, nN, nwg, G, c;
    __host__ __device__ void init(int M, int N, int G_, int c_) { nM = M / BM; nN = N / BM; nwg = nM * nN; G = G_; c = c_; }
    __host__ __device__ bool next(int i, Unit& u) const {
        const long L = (long)i * G + c; if (L >= nwg) return false;
        int wgid = (int)L; { const int q = nwg / NXCD, r = nwg % NXCD, xcd = wgid % NXCD, off = wgid / NXCD; wgid = (xcd < r ? xcd * (q + 1) : r * (q + 1) + (xcd - r) * q) + off; }
        const int nig = WGM * nN, gid = wgid / nig, fm = gid * WGM, gsz = (nM - fm) < WGM ? (nM - fm) : WGM;
        u.pm = fm + ((wgid % nig) % gsz); u.pn = (wgid % nig) / gsz; return true;
    }
    __device__ __forceinline__ void a_ready(const Unit&) const {}
    __device__ __forceinline__ void done(const Unit&) const {}
};
__device__ __forceinline__ unsigned cvt_pk_bf16(float lo, float hi) { unsigned r; asm volatile("v_cvt_pk_bf16_f32 %0, %1, %2" : "=v"(r) : "v"(lo), "v"(hi)); return r; }
typedef float f32x2 __attribute__((ext_vector_type(2)));
struct EpiG {
    static constexpr bool PERM = true, AFTER_DRAIN = false;
    int mode;
    bf16_t* O; int ldc;
    const float* rpart_in;
    float* Xf; bf16_t* Xb; float* rpart_out;
    bf16_t *Qb, *Kb, *Vb; float *outKp, *outVp, *outKs, *outVs; unsigned* qkm;
    const PG8_LAS float* rl; int pm0;
    const float* XinP;
    __device__ __forceinline__ void operator()(const f32x4 (&acc)[2][2][4][2], const Unit& u, int wr, int wc, int fr, int fq) const {
        const int rowb = u.pm * BM + wr * 64 + fr;
        const int colb = u.pn * BM + wc * 32 + 8 * fq;
        if (mode == 2) {
#pragma unroll
            for (int ai = 0; ai < 2; ++ai) {
                u32x4 pre[4][2];
#pragma unroll
                for (int m = 0; m < 4; ++m) { const bf16_t* xi = Xb + (size_t)(rowb + ai * HALF + m * 16) * 1024 + colb;
#pragma unroll
                    for (int bj = 0; bj < 2; ++bj) pre[m][bj] = *(const u32x4*)(xi + bj * HALF); }
                asm volatile("" : "+v"(pre[0][0]), "+v"(pre[0][1]), "+v"(pre[1][0]), "+v"(pre[1][1]), "+v"(pre[2][0]), "+v"(pre[2][1]), "+v"(pre[3][0]), "+v"(pre[3][1]));
#pragma unroll
                for (int m = 0; m < 4; ++m) {
                    const int row = rowb + ai * HALF + m * 16;
                    bf16_t* bp = Xb + (size_t)row * 1024 + colb; float ss = 0.f;
#pragma unroll
                    for (int bj = 0; bj < 2; ++bj) {
                        const u32x4 pw = pre[m][bj];
                        f32x4 x0 = {__uint_as_float(pw.x << 16), __uint_as_float(pw.x & 0xffff0000u), __uint_as_float(pw.y << 16), __uint_as_float(pw.y & 0xffff0000u)};
                        f32x4 x1 = {__uint_as_float(pw.z << 16), __uint_as_float(pw.z & 0xffff0000u), __uint_as_float(pw.w << 16), __uint_as_float(pw.w & 0xffff0000u)};
                        x0 += acc[ai][bj][m][0]; x1 += acc[ai][bj][m][1];
                        if (Xf) { float* xp = Xf + (size_t)row * 1024 + colb; *(f32x4*)(xp + bj * HALF) = x0; *(f32x4*)(xp + bj * HALF + 4) = x1; }
                        ss += (x0[0] * x0[0] + x0[1] * x0[1]) + (x0[2] * x0[2] + x0[3] * x0[3]) + (x1[0] * x1[0] + x1[1] * x1[1]) + (x1[2] * x1[2] + x1[3] * x1[3]);
                        u32x4 w; w.x = cvt_pk_bf16(x0[0], x0[1]); w.y = cvt_pk_bf16(x0[2], x0[3]); w.z = cvt_pk_bf16(x1[0], x1[1]); w.w = cvt_pk_bf16(x1[2], x1[3]);
                        *(u32x4*)(bp + bj * HALF) = w;
                    }
                    ss += __shfl_xor(ss, 16); ss += __shfl_xor(ss, 32);
                    if (fq == 0) rpart_out[(size_t)row * 16 + u.pn * 4 + wc] = ss;
                }
            }
            return;
        }
        float rinv[2][4];
        if (u.pm == pm0) {
#pragma unroll
            for (int ai = 0; ai < 2; ++ai)
#pragma unroll
                for (int m = 0; m < 4; ++m) rinv[ai][m] = rl[wr * 64 + fr + ai * HALF + m * 16];
        } else
#pragma unroll
        for (int ai = 0; ai < 2; ++ai)
#pragma unroll
            for (int m = 0; m < 4; ++m) {
                const f32x4* rp = (const f32x4*)(rpart_in + (size_t)(rowb + ai * HALF + m * 16) * 16);
                const f32x4 a = rp[0], b = rp[1], c = rp[2], d = rp[3];
                const float s = ((a[0] + a[1]) + (a[2] + a[3])) + ((b[0] + b[1]) + (b[2] + b[3])) + ((c[0] + c[1]) + (c[2] + c[3])) + ((d[0] + d[1]) + (d[2] + d[3]));
                rinv[ai][m] = 1.0f / sqrtf(s * (1.0f / 1024.0f) + 1e-5f);
            }
        if (mode == 0 || mode == 3) {
#pragma unroll
            for (int ai = 0; ai < 2; ++ai)
#pragma unroll
                for (int m = 0; m < 4; ++m) {
                    bf16_t* rowp = O + (size_t)(rowb + ai * HALF + m * 16) * ldc + colb; const float r = rinv[ai][m];
#pragma unroll
                    for (int bj = 0; bj < 2; ++bj) {
                        f32x4 v0 = acc[ai][bj][m][0] * r, v1 = acc[ai][bj][m][1] * r;
                        if (mode == 3) {
#pragma unroll
                            for (int e = 0; e < 4; ++e) { const float a0 = fmaxf(v0[e], 0.f), a1 = fmaxf(v1[e], 0.f); v0[e] = a0 * a0; v1[e] = a1 * a1; }
                        }
                        u32x4 w; w.x = cvt_pk_bf16(v0[0], v0[1]); w.y = cvt_pk_bf16(v0[2], v0[3]); w.z = cvt_pk_bf16(v1[0], v1[1]); w.w = cvt_pk_bf16(v1[2], v1[3]);
                        *(u32x4*)(rowp + bj * HALF) = w;
                    }
                }
            return;
        }
        const int t = u.pn >> 2; const int colq = (u.pn & 3) * BM + wc * 32 + 8 * fq;
        const bool samp = (u.pm >= 64);
        float mx[2] = {0.f, 0.f};
#pragma unroll
        for (int ai = 0; ai < 2; ++ai)
#pragma unroll
            for (int m = 0; m < 4; ++m) {
                const int row = rowb + ai * HALF + m * 16; const float r = rinv[ai][m];
                const int sr = row - 16384;
                const size_t kvrow = samp ? (size_t)(16384 + (sr >> 5) * 2112 + 2048 + (sr & 31)) : (size_t)row;
#pragma unroll
                for (int bj = 0; bj < 2; ++bj) {
                    f32x4 v0 = acc[ai][bj][m][0] * r, v1 = acc[ai][bj][m][1] * r;
                    if (t < 2) {
                        float s = (v0[0] * v0[0] + v0[1] * v0[1]) + (v0[2] * v0[2] + v0[3] * v0[3]) + (v1[0] * v1[0] + v1[1] * v1[1]) + (v1[2] * v1[2] + v1[3] * v1[3]);
                        s += __shfl_xor(s, 16); s += __shfl_xor(s, 32); mx[bj] = fmaxf(mx[bj], s);
                    }
                    if (t == 0) {
                        v0 = v0 * 0.18033688011112042f; v1 = v1 * 0.18033688011112042f;
                        u32x4 w; w.x = cvt_pk_bf16(v0[0], v0[1]); w.y = cvt_pk_bf16(v0[2], v0[3]); w.z = cvt_pk_bf16(v1[0], v1[1]); w.w = cvt_pk_bf16(v1[2], v1[3]);
                        *(u32x4*)(Qb + (size_t)row * 1024 + colq + bj * HALF) = w;
                    } else {
                        u32x4 w; w.x = cvt_pk_bf16(v0[0], v0[1]); w.y = cvt_pk_bf16(v0[2], v0[3]); w.z = cvt_pk_bf16(v1[0], v1[1]); w.w = cvt_pk_bf16(v1[2], v1[3]);
                        bf16_t* kb = (t == 1 ? Kb : Vb) + kvrow * 1024 + colq + bj * HALF;
                        *(u32x4*)kb = w;
                        float* ob = samp ? ((t == 1 ? outKs : outVs) + (size_t)sr * 1024) : ((t == 1 ? outKp : outVp) + (size_t)row * 1024);
                        ob += colq + bj * HALF;
                        *(f32x4*)ob = v0; *(f32x4*)(ob + 4) = v1;
                    }
                }
            }
        if (t < 2) {
#pragma unroll
            for (int bj = 0; bj < 2; ++bj) {
                float v = mx[bj];
                v = fmaxf(v, __shfl_xor(v, 1)); v = fmaxf(v, __shfl_xor(v, 2)); v = fmaxf(v, __shfl_xor(v, 4)); v = fmaxf(v, __shfl_xor(v, 8));
                const int head = (u.pn & 3) * 4 + bj * 2 + (wc >> 1);
                if ((threadIdx.x & 63) == 0) atomicMax(qkm + t * 32 + head * 2 + (wc & 1), __float_as_uint(v));
            }
        }
    }
};
template <class Epi, class Sched, bool ALIGN_EPI = false, bool SP2 = false>
__device__ __forceinline__ void gemm_phase(PG8_LAS unsigned char* lds, const Gemm g, const Sched& S, const Epi& E) {
    const int tid = threadIdx.x, wid = __builtin_amdgcn_readfirstlane(tid >> 6), lane = tid & 63, wr = wid >> 2, wc = wid & 3, fr = lane & 15, fq = lane >> 4;
    const int K = g.K, nt = K / BK;
    unsigned voffA[2], voffB[2];
#pragma unroll
    for (int i = 0; i < 2; ++i) { int R, C; stage_rc(tid * 16 + i * 8192, R, C); const int Rb = Epi::PERM ? ((R & ~31) + perm32(R & 31)) : R;
        voffA[i] = (unsigned)(R * g.lda + C) * 2u; voffB[i] = (unsigned)(Rb * g.ldb + C) * 2u; }
    const size_t kstep = (size_t)(BK * 2);
    const size_t hstep = (size_t)HALF * g.ldb * 2;
    const size_t tstep = 2 * hstep;
    const size_t hstepA = (size_t)HALF * g.lda * 2, tstepA = 2 * hstepA;
    const unsigned ldsw = (unsigned)wid * 1024u;
    const int aoff = lds_byte(wr * 64 + fr, fq * 8), boff = lds_byte(wc * 32 + fr, fq * 8);
#define PG8_SA(b, h) (((b) * 2 + (h)) * HTB)
#define PG8_SB(b, h) ((4 + (b) * 2 + (h)) * HTB)
#define PG8_STAGE(bufoff, gbase, voff) do { _Pragma("unroll") for (int _i = 0; _i < 2; ++_i) \
        __builtin_amdgcn_global_load_lds((const unsigned*)((const char*)(gbase) + (voff)[_i]), (PG8_LAS unsigned*)(lds + (bufoff) + ldsw + _i * 8192), 16, 0, 0); } while (0)
#define PG8_LDA(dst, b, h) do { _Pragma("unroll") for (int m = 0; m < 4; ++m) _Pragma("unroll") for (int k = 0; k < 2; ++k) dst[m][k] = *(const PG8_LAS bf16x8*)(lds + PG8_SA(b, h) + aoff + m * 2048 + k * 1024); } while (0)
#define PG8_LDB(dst, b, h) do { _Pragma("unroll") for (int n = 0; n < 2; ++n) _Pragma("unroll") for (int k = 0; k < 2; ++k) dst[n][k] = *(const PG8_LAS bf16x8*)(lds + PG8_SB(b, h) + boff + n * 2048 + k * 1024); } while (0)
#define PG8_MMA(ai, bj, At, Bt) do { __builtin_amdgcn_s_setprio(1); _Pragma("unroll") for (int m = 0; m < 4; ++m) _Pragma("unroll") for (int n = 0; n < 2; ++n) _Pragma("unroll") for (int k = 0; k < 2; ++k) \
        acc[ai][bj][m][n] = __builtin_amdgcn_mfma_f32_16x16x32_bf16(Bt[n][k], At[m][k], acc[ai][bj][m][n], 0, 0, 0); __builtin_amdgcn_s_setprio(0); } while (0)
#define PG8_WAIT_V(n) asm volatile("s_waitcnt vmcnt(" #n ")" ::: "memory")
#define PG8_WAIT_L(n) asm volatile("s_waitcnt lgkmcnt(" #n ")" ::: "memory")
#define PG8_BAR __builtin_amdgcn_s_barrier()
#define PG8_SCHED __builtin_amdgcn_sched_barrier(0)
    Unit cur, nxt; int ui = 0;
    if (!S.next(0, cur)) return;
    f32x4 acc[2][2][4][2];
#pragma unroll
    for (int a = 0; a < 2; ++a)
#pragma unroll
        for (int b = 0; b < 2; ++b)
#pragma unroll
            for (int m = 0; m < 4; ++m)
#pragma unroll
                for (int n = 0; n < 2; ++n) acc[a][b][m][n] = (f32x4){0.f, 0.f, 0.f, 0.f};
    bf16x8 At[4][2], B0[2][2], B1[2][2];
    const char* cA = (const char*)g.A + (size_t)cur.pm * tstepA; const char* cB = (const char*)g.Bt + (size_t)cur.pn * tstep;
    S.a_ready(cur);
    if constexpr (SP2) {
        PG8_STAGE(PG8_SB(0, 0), cB, voffB); PG8_STAGE(PG8_SB(0, 1), cB + hstep, voffB); PG8_STAGE(PG8_SA(0, 0), cA, voffA); PG8_STAGE(PG8_SA(0, 1), cA + hstepA, voffA);
        if (wr == 1) PG8_BAR;
        PG8_WAIT_V(2); PG8_BAR;
        PG8_STAGE(PG8_SB(1, 0), cB + kstep, voffB); PG8_STAGE(PG8_SA(1, 0), cA + kstep, voffA); PG8_STAGE(PG8_SB(1, 1), cB + hstep + kstep, voffB);
        PG8_WAIT_V(6); PG8_BAR;
    } else {
        PG8_STAGE(PG8_SB(0, 0), cB, voffB); PG8_STAGE(PG8_SA(0, 0), cA, voffA); PG8_STAGE(PG8_SB(0, 1), cB + hstep, voffB); PG8_STAGE(PG8_SA(0, 1), cA + hstepA, voffA);
        if (wr == 1) PG8_BAR;
        PG8_WAIT_V(4); PG8_BAR;
        PG8_STAGE(PG8_SB(1, 0), cB + kstep, voffB); PG8_STAGE(PG8_SA(1, 0), cA + kstep, voffA); PG8_STAGE(PG8_SB(1, 1), cB + hstep + kstep, voffB);
        PG8_WAIT_V(6); PG8_BAR;
    }
    for (;;) {
        const bool has_next = S.next(ui + 1, nxt);
        const char* nA = has_next ? (const char*)g.A + (size_t)nxt.pm * tstepA : cA; const char* nB = has_next ? (const char*)g.Bt + (size_t)nxt.pn * tstep : cB;
        for (int t = 0; t < nt; t += 2) {
            const bool last = (t == nt - 2);
            const char* a1 = cA + (size_t)(t + 1) * kstep;
            const char* a2 = last ? nA : cA + (size_t)(t + 2) * kstep; const char* b2 = last ? nB : cB + (size_t)(t + 2) * kstep;
            const char* a3 = a2 + kstep; const char* b3 = b2 + kstep;
            if (last && has_next) S.a_ready(nxt);
            if constexpr (SP2) {
            PG8_LDB(B0, 0, 0); PG8_LDB(B1, 0, 1); PG8_SCHED; PG8_LDA(At, 0, 0); PG8_STAGE(PG8_SA(1, 1), a1 + hstepA, voffA);
            PG8_WAIT_V(8); PG8_WAIT_L(0); PG8_BAR; PG8_MMA(0, 0, At, B0); PG8_MMA(0, 1, At, B1); PG8_BAR; PG8_SCHED;
            PG8_LDA(At, 0, 1); PG8_STAGE(PG8_SB(0, 0), b2, voffB); PG8_STAGE(PG8_SB(0, 1), b2 + hstep, voffB); PG8_STAGE(PG8_SA(0, 0), a2, voffA);
            PG8_WAIT_V(8); PG8_WAIT_L(0); PG8_BAR; PG8_MMA(1, 0, At, B0); PG8_MMA(1, 1, At, B1); PG8_BAR; PG8_SCHED;
            PG8_LDB(B0, 1, 0); PG8_LDB(B1, 1, 1); PG8_SCHED; PG8_LDA(At, 1, 0); PG8_STAGE(PG8_SA(0, 1), a2 + hstepA, voffA);
            PG8_WAIT_V(8); PG8_WAIT_L(0); PG8_BAR; PG8_MMA(0, 0, At, B0); PG8_MMA(0, 1, At, B1); PG8_BAR; PG8_SCHED;
            PG8_LDA(At, 1, 1); PG8_STAGE(PG8_SB(1, 0), b3, voffB); PG8_STAGE(PG8_SB(1, 1), b3 + hstep, voffB); PG8_STAGE(PG8_SA(1, 0), a3, voffA);
            PG8_WAIT_V(8); PG8_WAIT_L(0); PG8_BAR; PG8_MMA(1, 0, At, B0); PG8_MMA(1, 1, At, B1); PG8_BAR; PG8_SCHED;
            } else {
            PG8_LDB(B0, 0, 0); PG8_SCHED; PG8_LDA(At, 0, 0); PG8_STAGE(PG8_SA(1, 1), a1 + hstepA, voffA);
            PG8_WAIT_L(8); PG8_BAR; PG8_WAIT_L(0); PG8_MMA(0, 0, At, B0); PG8_BAR; PG8_SCHED;
            PG8_LDB(B1, 0, 1); PG8_STAGE(PG8_SB(0, 0), b2, voffB);
            PG8_BAR; PG8_WAIT_L(0); PG8_MMA(0, 1, At, B1); PG8_BAR;
            PG8_LDA(At, 0, 1); PG8_STAGE(PG8_SA(0, 0), a2, voffA);
            PG8_BAR; PG8_WAIT_L(0); PG8_MMA(1, 0, At, B0); PG8_BAR; PG8_SCHED;
            PG8_STAGE(PG8_SB(0, 1), b2 + hstep, voffB);
            PG8_WAIT_V(6); PG8_BAR; PG8_MMA(1, 1, At, B1); PG8_BAR;
            PG8_LDB(B0, 1, 0); PG8_SCHED; PG8_LDA(At, 1, 0); PG8_STAGE(PG8_SA(0, 1), a2 + hstepA, voffA);
            PG8_WAIT_L(8); PG8_BAR; PG8_WAIT_L(0); PG8_MMA(0, 0, At, B0); PG8_BAR; PG8_SCHED;
            PG8_LDB(B1, 1, 1); PG8_STAGE(PG8_SB(1, 0), b3, voffB);
            PG8_BAR; PG8_WAIT_L(0); PG8_MMA(0, 1, At, B1); PG8_BAR;
            PG8_LDA(At, 1, 1); PG8_STAGE(PG8_SA(1, 0), a3, voffA);
            PG8_BAR; PG8_WAIT_L(0); PG8_MMA(1, 0, At, B0); PG8_BAR; PG8_SCHED;
            PG8_STAGE(PG8_SB(1, 1), b3 + hstep, voffB);
            PG8_WAIT_V(6); PG8_BAR; PG8_MMA(1, 1, At, B1); PG8_BAR;
            }
        }
        if constexpr (ALIGN_EPI) { if (wr == 0) PG8_BAR; }
        if constexpr (!Epi::AFTER_DRAIN) { E(acc, cur, wr, wc, fr, fq); S.done(cur); }
        if (!has_next) break;
#pragma unroll
        for (int a = 0; a < 2; ++a)
#pragma unroll
            for (int b = 0; b < 2; ++b)
#pragma unroll
                for (int m = 0; m < 4; ++m)
#pragma unroll
                    for (int n = 0; n < 2; ++n) acc[a][b][m][n] = (f32x4){0.f, 0.f, 0.f, 0.f};
        cur = nxt; cA = nA; cB = nB; ++ui;
        if constexpr (ALIGN_EPI) { if (wr == 1) PG8_BAR; }
    }
    PG8_WAIT_V(0);
    if constexpr (!ALIGN_EPI) { if (wr == 0) PG8_BAR; }
    PG8_BAR;
    if constexpr (Epi::AFTER_DRAIN) { E.fused(acc, cur, wr, wc, fr, fq, lds, wid, lane); S.done(cur); }
#undef PG8_SA
#undef PG8_SB
#undef PG8_STAGE
#undef PG8_LDA
#undef PG8_LDB
#undef PG8_MMA
#undef PG8_WAIT_V
#undef PG8_WAIT_L
#undef PG8_BAR
#undef PG8_SCHED
}
}

#define LAS __attribute__((address_space(3)))
typedef unsigned short bf16_t;
typedef short bf16x8 __attribute__((ext_vector_type(8)));
typedef short s16x4 __attribute__((ext_vector_type(4)));
typedef float f32x4 __attribute__((ext_vector_type(4)));
typedef float f32x16 __attribute__((ext_vector_type(16)));
typedef unsigned u32x4 __attribute__((ext_vector_type(4)));
typedef unsigned u32x2 __attribute__((ext_vector_type(2)));
typedef float f32x2_t __attribute__((ext_vector_type(2)));
typedef __bf16 bf16x2_t __attribute__((ext_vector_type(2)));
__device__ __forceinline__ unsigned pk2(float lo, float hi) { f32x2_t v = {lo, hi}; bf16x2_t b = __builtin_convertvector(v, bf16x2_t); return __builtin_bit_cast(unsigned, b); }
__device__ __forceinline__ float bf_lo(unsigned w) { return __uint_as_float(w << 16); }
__device__ __forceinline__ float bf_hi(unsigned w) { return __uint_as_float(w & 0xffff0000u); }
__device__ __forceinline__ float wave_sum(float v) {
#pragma unroll
    for (int o = 1; o < 64; o <<= 1) v += __shfl_xor(v, o);
    return v;
}
__device__ __forceinline__ float rinv_row(const float* rpart, int row) {
    const f32x4* rp = (const f32x4*)(rpart + (size_t)row * 16);
    const f32x4 a = rp[0], b = rp[1], c = rp[2], d = rp[3];
    const float s = ((a[0] + a[1]) + (a[2] + a[3])) + ((b[0] + b[1]) + (b[2] + b[3])) + ((c[0] + c[1]) + (c[2] + c[3])) + ((d[0] + d[1]) + (d[2] + d[3]));
    return 1.0f / sqrtf(s * (1.0f / 1024.0f) + EPS);
}

constexpr size_t MiB = 1u << 20;
constexpr size_t WS_QKM = 0;
constexpr size_t WS_BAR = 65536;
constexpr size_t WS_RPART = 1 * MiB;
constexpr size_t WS_LF = 3 * MiB;
constexpr size_t WS_C2P = 5 * MiB;
constexpr size_t WS_C2S = 7 * MiB;
constexpr size_t WS_WF = 9 * MiB;
constexpr size_t WS_W = 10 * MiB;
constexpr size_t W_CIN = WS_W, W_COUT = WS_W + 12 * MiB, W_FIN = WS_W + 16 * MiB, W_FO = WS_W + 28 * MiB, W_1 = WS_W + 32 * MiB, W_2 = WS_W + 64 * MiB;
constexpr size_t WS_XF = 110 * MiB;
constexpr size_t WS_XB = 175 * MiB;
constexpr size_t WS_A2 = 208 * MiB;
constexpr size_t WS_OV = 241 * MiB;
constexpr size_t WS_Q = WS_OV, WS_K = WS_OV + 33 * MiB, WS_V = WS_OV + 99 * MiB;
constexpr size_t WS_END = WS_OV + 166 * MiB;

constexpr size_t O_Y = 0, O_PCONV = 17039360, O_PK = 17043456, O_PV = 50597888, O_PLF = 84152320, O_SCONV = 84676608, O_SK = 84709376, O_SV = 85233664, O_SLF = 85757952;

constexpr int WLDS = 17408;
constexpr int LDS_CTL = 8 * WLDS;
constexpr int LDS_BYTES = 8 * WLDS + 256;

struct Args { const float* in[17]; float* out; unsigned char* ws; int lo, hi; };

__device__ __forceinline__ int crow(int r, int hi) { return (r & 3) + 8 * (r >> 2) + 4 * hi; }
__device__ __forceinline__ void glds16(const void* gsrc, unsigned lds_dst) { unsigned keep;
    asm volatile("s_mov_b32 %0, m0\n\ts_mov_b32 m0, %2\n\ts_nop 0\n\tglobal_load_lds_dwordx4 %1, off\n\ts_mov_b32 m0, %0" : "=&s"(keep) : "v"(gsrc), "s"(lds_dst) : "memory"); }
__device__ __forceinline__ void glds4(const void* gsrc, unsigned lds_dst) { unsigned keep;
    asm volatile("s_mov_b32 %0, m0\n\ts_mov_b32 m0, %2\n\ts_nop 0\n\tglobal_load_lds_dword %1, off\n\ts_mov_b32 m0, %0" : "=&s"(keep) : "v"(gsrc), "s"(lds_dst) : "memory"); }
#define SBAR() __builtin_amdgcn_sched_barrier(0)
struct VFrag { s16x4 lo[8], hi[8]; };
template <int d0> __device__ __forceinline__ void pv_reads(VFrag& f, int vb) {
#pragma unroll
        for (int ks = 0; ks < 4; ++ks) {
            asm volatile("ds_read_b64_tr_b16 %0,%1 offset:%c2" : "=&v"(f.lo[d0 * 4 + ks]) : "v"(vb), "i"(d0 * 4096 + ks * 1024) : "memory");
            asm volatile("ds_read_b64_tr_b16 %0,%1 offset:%c2" : "=&v"(f.hi[d0 * 4 + ks]) : "v"(vb), "i"(d0 * 4096 + ks * 1024 + 512) : "memory"); }
}
__device__ __forceinline__ void pv_mfma(f32x16* o, VFrag& f, bf16x8 pa0, bf16x8 pa1, bf16x8 pa2, bf16x8 pa3) {
    asm volatile("s_waitcnt lgkmcnt(0)" : "+v"(f.lo[0]), "+v"(f.lo[1]), "+v"(f.lo[2]), "+v"(f.lo[3]), "+v"(f.lo[4]), "+v"(f.lo[5]), "+v"(f.lo[6]), "+v"(f.lo[7]),
                 "+v"(f.hi[0]), "+v"(f.hi[1]), "+v"(f.hi[2]), "+v"(f.hi[3]), "+v"(f.hi[4]), "+v"(f.hi[5]), "+v"(f.hi[6]), "+v"(f.hi[7]) :: "memory");
#define PK(k) (bf16x8){f.lo[k][0], f.lo[k][1], f.lo[k][2], f.lo[k][3], f.hi[k][0], f.hi[k][1], f.hi[k][2], f.hi[k][3]}
    o[0] = __builtin_amdgcn_mfma_f32_32x32x16_bf16(pa0, PK(0), o[0], 0, 0, 0);
    o[1] = __builtin_amdgcn_mfma_f32_32x32x16_bf16(pa0, PK(4), o[1], 0, 0, 0);
    o[0] = __builtin_amdgcn_mfma_f32_32x32x16_bf16(pa1, PK(1), o[0], 0, 0, 0);
    o[1] = __builtin_amdgcn_mfma_f32_32x32x16_bf16(pa1, PK(5), o[1], 0, 0, 0);
    o[0] = __builtin_amdgcn_mfma_f32_32x32x16_bf16(pa2, PK(2), o[0], 0, 0, 0);
    o[1] = __builtin_amdgcn_mfma_f32_32x32x16_bf16(pa2, PK(6), o[1], 0, 0, 0);
    o[0] = __builtin_amdgcn_mfma_f32_32x32x16_bf16(pa3, PK(3), o[0], 0, 0, 0);
    o[1] = __builtin_amdgcn_mfma_f32_32x32x16_bf16(pa3, PK(7), o[1], 0, 0, 0);
#undef PK
}
constexpr int ANS = 4;
constexpr int A_K = 0, A_V = ANS * 8192, A_C = 2 * ANS * 8192, A_WSF = A_C + ANS * 2048, A_OST = A_WSF + 2048, A_END = A_OST + 8 * 4096;
static_assert(A_END <= 8 * WLDS, "attention LDS map");
__device__ __forceinline__ void attn_unit(LAS unsigned char* sh, const bf16_t* Qb, const bf16_t* __restrict__ Kb, const bf16_t* __restrict__ Vb, bf16_t* Ob,
                                          const float* __restrict__ c2seq, long qrow0, long kvbase, int p0, int nrows, int h, float TH, float CS1, int lane, int wave) {
    const int r32 = lane & 31, hi = lane >> 5;
    const unsigned lbase = (unsigned)(uintptr_t)sh;
    const bool active = wave * 32 < nrows;
    const int pw = p0 + 32 * wave;
    bf16x8 qr[4];
    { const bf16_t* Qw = Qb + (qrow0 + (active ? wave * 32 : 0) + r32) * D + h * 64;
#pragma unroll
      for (int d0 = 0; d0 < 4; ++d0) qr[d0] = *(const bf16x8*)(Qw + d0 * 16 + hi * 8); }
    const int plast = p0 + nrows - 1, tl_u = plast >> 6, tl_w = (pw + 31) >> 6;
    float cref = c2seq[p0];
    float crefw = c2seq[active ? pw : p0];
    float cv0; { const int t = tl_u - lane; int idx = 64 * t + 63; idx = idx > plast ? plast : idx; cv0 = c2seq[idx < 0 ? 0 : idx]; }
    asm volatile("" : "+v"(cref), "+v"(crefw), "+v"(cv0), "+v"(qr[0]), "+v"(qr[1]), "+v"(qr[2]), "+v"(qr[3]));
    int tstart = 0;
    for (int tb = tl_u; tb >= 0; tb -= 64) {
        const int t = tb - lane; int idx = 64 * t + 63; idx = idx > plast ? plast : idx;
        const float cv = (tb == tl_u) ? cv0 : ((t >= 0) ? c2seq[idx] : 0.f);
        const bool skip = (t >= 0) && (cref - cv < -TH);
        const unsigned long long bal = __ballot(skip);
        if (bal) { tstart = tb - (__ffsll((long long)bal) - 1) + 1; break; }
    }
    tstart = __builtin_amdgcn_readfirstlane(tstart);
    const int n = tl_u - tstart + 1;
    const bf16_t* ksrc = Kb + (kvbase + lane) * D + h * 64 + wave * 8;
    const bf16_t* vsrc = Vb + (kvbase + 16 * (wave & 3) + (lane >> 2)) * D + h * 64 + (wave >> 2) * 32 + (lane & 3) * 8;
    const float* csrc = c2seq + lane;
#define ISSUE(i_) do { const int t_ = tl_u - (i_), sl_ = (i_) & (ANS - 1); \
    glds16(ksrc + (long)t_ * 64 * D, lbase + A_K + sl_ * 8192 + wave * 1024); \
    glds16(vsrc + (long)t_ * 64 * D, lbase + A_V + sl_ * 8192 + wave * 1024); \
    glds4(csrc + t_ * 64, lbase + A_C + sl_ * 2048 + wave * 256); } while (0)
    float mhat = 0.f, l_reg = 0.f; f32x16 o[2]; o[0] = f32x16{}; o[1] = f32x16{};
    float mmin = -INFINITY;
    bool wdone = false;
    LAS float* wsf = (LAS float*)(sh + A_WSF + wave * 256);
    const int vb0 = (int)(lbase + A_V) + ((lane >> 4) & 1) * 32 + (lane & 3) * 8 + (4 * hi + ((lane & 15) >> 2)) * 64;
    const LAS unsigned char* kb0 = sh + A_K + hi * 1024 + r32 * 16;
    asm volatile("" : "+v"(qr[0]), "+v"(qr[1]), "+v"(qr[2]), "+v"(qr[3]));
    if (0 < n) ISSUE(0);
    if (1 < n) ISSUE(1);
    if (2 < n) ISSUE(2);
    for (int i = 0; i < n; ++i) {
        const int rem = n - 1 - i;
        if (rem >= 2) asm volatile("s_waitcnt vmcnt(6)" ::: "memory"); else if (rem == 1) asm volatile("s_waitcnt vmcnt(3)" ::: "memory"); else asm volatile("s_waitcnt vmcnt(0)" ::: "memory");
        asm volatile("s_waitcnt lgkmcnt(0)\n\ts_barrier" ::: "memory");
        if (i + 3 < n) ISSUE(i + 3);
        const int t = tl_u - i, sl = i & (ANS - 1);
        const LAS unsigned char* cp = sh + A_C + sl * 2048 + wave * 256;
        if (active && t < tl_w && !wdone) { const float cend = *(const LAS float*)(cp + 63 * 4); if (crefw - cend < -TH || (cref - cend) + CS1 - mmin < -152.0f) wdone = true; }
        if (active && t <= tl_w && !wdone) {
            f32x16 p0v, p1v;
            const LAS unsigned char* kbp = kb0 + sl * 8192;
            bf16x8 kf[8];
#pragma unroll
            for (int d0 = 0; d0 < 4; ++d0) { kf[2 * d0] = *(const LAS bf16x8*)(kbp + d0 * 2048); kf[2 * d0 + 1] = *(const LAS bf16x8*)(kbp + d0 * 2048 + 512); }
            { const float X = cref - mhat;
#pragma unroll
              for (int g = 0; g < 4; ++g) {
                  const f32x4 ca = *(const LAS f32x4*)(cp + (8 * g + 4 * hi) * 4), cb = *(const LAS f32x4*)(cp + (32 + 8 * g + 4 * hi) * 4);
#pragma unroll
                  for (int e = 0; e < 4; ++e) { p0v[4 * g + e] = X - ca[e]; p1v[4 * g + e] = X - cb[e]; }
              } }
            asm volatile("" : "+v"(kf[0]), "+v"(kf[1]), "+v"(kf[2]), "+v"(kf[3]), "+v"(kf[4]), "+v"(kf[5]), "+v"(kf[6]), "+v"(kf[7]));
#pragma unroll
            for (int d0 = 0; d0 < 4; ++d0) {
                p0v = __builtin_amdgcn_mfma_f32_32x32x16_bf16(kf[2 * d0], qr[d0], p0v, 0, 0, 0);
                p1v = __builtin_amdgcn_mfma_f32_32x32x16_bf16(kf[2 * d0 + 1], qr[d0], p1v, 0, 0, 0);
            }
            if (t == tl_w) {
                const int qpos = pw + r32, kq = 64 * t + 4 * hi;
#pragma unroll
                for (int r = 0; r < 16; ++r) { const int kv = kq + (r & 3) + 8 * (r >> 2); if (kv > qpos) p0v[r] = -INFINITY; if (kv + 32 > qpos) p1v[r] = -INFINITY; }
            }
            float rm, rm2;
            { float a_ = __builtin_fmaxf(__builtin_fmaxf(p0v[0], p0v[1]), p1v[0]), b_ = __builtin_fmaxf(__builtin_fmaxf(p0v[2], p0v[3]), p1v[1]); a_ = __builtin_fmaxf(__builtin_fmaxf(a_, p1v[2]), p1v[3]);
#pragma unroll
              for (int r = 4; r < 16; r += 4) { a_ = __builtin_fmaxf(__builtin_fmaxf(a_, p0v[r]), p0v[r + 1]); b_ = __builtin_fmaxf(__builtin_fmaxf(b_, p0v[r + 2]), p0v[r + 3]); a_ = __builtin_fmaxf(__builtin_fmaxf(a_, p1v[r]), p1v[r + 1]); b_ = __builtin_fmaxf(__builtin_fmaxf(b_, p1v[r + 2]), p1v[r + 3]); }
              rm = __builtin_fmaxf(a_, b_); rm2 = rm; (void)rm2; }
            { auto rr = __builtin_amdgcn_permlane32_swap(__float_as_uint(rm), __float_as_uint(rm), false, false); rm = fmaxf(__uint_as_float(rr[0]), __uint_as_float(rr[1])); }
            if (t == tl_w) {
                mhat = rm;
                { float mm = mhat; mm = fminf(mm, __shfl_xor(mm, 1)); mm = fminf(mm, __shfl_xor(mm, 2)); mm = fminf(mm, __shfl_xor(mm, 4)); mm = fminf(mm, __shfl_xor(mm, 8)); mm = fminf(mm, __shfl_xor(mm, 16)); mmin = mm; }
#pragma unroll
                for (int r = 0; r < 16; ++r) { p0v[r] -= rm; p1v[r] -= rm; }
            } else if (__any(rm > 4.0f)) {
                const float dl = fmaxf(rm, 0.f); mhat += dl;
                { float mm = mhat; mm = fminf(mm, __shfl_xor(mm, 1)); mm = fminf(mm, __shfl_xor(mm, 2)); mm = fminf(mm, __shfl_xor(mm, 4)); mm = fminf(mm, __shfl_xor(mm, 8)); mm = fminf(mm, __shfl_xor(mm, 16)); mmin = mm; }
#pragma unroll
                for (int r = 0; r < 16; ++r) { p0v[r] -= dl; p1v[r] -= dl; }
                const float f = __builtin_amdgcn_exp2f(-dl); l_reg *= f;
                if (hi == 0) wsf[r32] = f;
                asm volatile("s_waitcnt lgkmcnt(0)" ::: "memory");
#pragma unroll
                for (int r = 0; r < 16; ++r) { const float fr_ = wsf[crow(r, hi)]; o[0][r] *= fr_; o[1][r] *= fr_; }
                asm volatile("s_waitcnt lgkmcnt(0)" ::: "memory");
            }
            float sacc = 0.f;
#pragma unroll
            for (int r = 0; r < 16; ++r) { p0v[r] = __builtin_amdgcn_exp2f(p0v[r]); p1v[r] = __builtin_amdgcn_exp2f(p1v[r]); sacc += p0v[r] + p1v[r]; }
            l_reg += sacc;
            VFrag vf; pv_reads<0>(vf, vb0 + sl * 8192); pv_reads<1>(vf, vb0 + sl * 8192);
            u32x4 pw0, pw1, pw2, pw3;
            pw0 = (u32x4){pk2(p0v[0], p0v[1]), pk2(p0v[2], p0v[3]), pk2(p0v[4], p0v[5]), pk2(p0v[6], p0v[7])};
            pw1 = (u32x4){pk2(p0v[8], p0v[9]), pk2(p0v[10], p0v[11]), pk2(p0v[12], p0v[13]), pk2(p0v[14], p0v[15])};
            pw2 = (u32x4){pk2(p1v[0], p1v[1]), pk2(p1v[2], p1v[3]), pk2(p1v[4], p1v[5]), pk2(p1v[6], p1v[7])};
            pw3 = (u32x4){pk2(p1v[8], p1v[9]), pk2(p1v[10], p1v[11]), pk2(p1v[12], p1v[13]), pk2(p1v[14], p1v[15])};
            pv_mfma(o, vf, __builtin_bit_cast(bf16x8, pw0), __builtin_bit_cast(bf16x8, pw1), __builtin_bit_cast(bf16x8, pw2), __builtin_bit_cast(bf16x8, pw3));
        }
    }
#undef ISSUE
    if (active) {
        { auto rr = __builtin_amdgcn_permlane32_swap(__float_as_uint(l_reg), __float_as_uint(l_reg), false, false); l_reg = __uint_as_float(rr[0]) + __uint_as_float(rr[1]); }
        if (hi == 0) wsf[32 + r32] = l_reg;
        asm volatile("s_waitcnt lgkmcnt(0)" ::: "memory");
        float rli[16];
#pragma unroll
        for (int r = 0; r < 16; ++r) rli[r] = __builtin_amdgcn_rcpf(wsf[32 + crow(r, hi)]);
        LAS bf16_t* stg = (LAS bf16_t*)(sh + A_OST + wave * 4096);
#pragma unroll
        for (int r = 0; r < 16; ++r) { const int orow = crow(r, hi);
#pragma unroll
            for (int d0 = 0; d0 < 2; ++d0) stg[orow * 64 + d0 * 32 + r32] = (bf16_t)(pk2(o[d0][r] * rli[r], 0.f) & 0xffffu); }
        asm volatile("s_waitcnt lgkmcnt(0)" ::: "memory");
        bf16_t* Ow = Ob + (qrow0 + wave * 32) * D + h * 64;
#pragma unroll
        for (int i = 0; i < 4; ++i) { const int row = i * 8 + (lane >> 3), ch = lane & 7; const u32x4 v = *(const LAS u32x4*)(stg + row * 64 + ch * 8); *(u32x4*)(Ow + (long)row * D + ch * 8) = v; }
    }
    asm volatile("s_waitcnt lgkmcnt(0)\n\ts_barrier" ::: "memory");
}

__device__ __forceinline__ void transpose_item(const float* W, int K, int N, int ldw, const float* g, bf16_t* WT, LAS float* scr, int item, int lane, int ldo = 0) {
    if (ldo == 0) ldo = K;
    const int nblk = N / 32, kb = item / nblk, nb = item % nblk, k0 = 64 * kb, n0 = 32 * nb;
    float tv[32];
#pragma unroll
    for (int i = 0; i < 32; ++i) tv[i] = W[(size_t)(k0 + 2 * i + (lane >> 5)) * ldw + n0 + (lane & 31)];
#pragma unroll
    for (int i = 0; i < 32; ++i) scr[(2 * i + (lane >> 5)) * 33 + (lane & 31)] = tv[i];
    asm volatile("s_waitcnt lgkmcnt(0)" ::: "memory");
    const int c = lane & 7;
    float gv[8];
#pragma unroll
    for (int e = 0; e < 8; ++e) gv[e] = g ? g[k0 + 8 * c + e] : 1.0f;
#pragma unroll
    for (int j = 0; j < 4; ++j) { const int n = (lane >> 3) + 8 * j; const LAS float* s = scr + (8 * c) * 33 + n;
        u32x4 o; o.x = pk2(s[0 * 33] * gv[0], s[1 * 33] * gv[1]); o.y = pk2(s[2 * 33] * gv[2], s[3 * 33] * gv[3]); o.z = pk2(s[4 * 33] * gv[4], s[5 * 33] * gv[5]); o.w = pk2(s[6 * 33] * gv[6], s[7 * 33] * gv[7]);
        *(u32x4*)(WT + (size_t)(n0 + n) * ldo + k0 + 8 * c) = o; }
    asm volatile("s_waitcnt lgkmcnt(0)" ::: "memory");
}


__device__ __forceinline__ void epi_small(const pg8::EpiG& E, int row, int col, f32x4 v, int lane, float r, const float* xinS) {
    if (E.mode == 2) {
        const u32x2 pw = *(const u32x2*)(E.Xb + (size_t)row * 1024 + col);
        f32x4 x = {__uint_as_float(pw.x << 16), __uint_as_float(pw.x & 0xffff0000u), __uint_as_float(pw.y << 16), __uint_as_float(pw.y & 0xffff0000u)};
        x += v; if (E.Xf) *(f32x4*)(E.Xf + (size_t)row * 1024 + col) = x;
        u32x2 w; w.x = pk2(x[0], x[1]); w.y = pk2(x[2], x[3]); *(u32x2*)(E.Xb + (size_t)row * 1024 + col) = w;
        float ss = (x[0] * x[0] + x[1] * x[1]) + (x[2] * x[2] + x[3] * x[3]);
        ss += __shfl_xor(ss, 1); ss += __shfl_xor(ss, 2); ss += __shfl_xor(ss, 4); ss += __shfl_xor(ss, 8);
        if ((lane & 15) == 0) E.rpart_out[(size_t)row * 16 + (col >> 6)] = ss;
        return;
    }
    v = v * r;
    if (E.mode == 0 || E.mode == 3) {
        if (E.mode == 3) {
#pragma unroll
            for (int e = 0; e < 4; ++e) { const float a0 = fmaxf(v[e], 0.f); v[e] = a0 * a0; } }
        u32x2 w; w.x = pk2(v[0], v[1]); w.y = pk2(v[2], v[3]); *(u32x2*)(E.O + (size_t)row * E.ldc + col) = w;
        return;
    }
    const int t = col >> 10, cq = col & 1023, sr = row - SEQ;
    if (t < 2) {
        float s = (v[0] * v[0] + v[1] * v[1]) + (v[2] * v[2] + v[3] * v[3]);
        s += __shfl_xor(s, 1); s += __shfl_xor(s, 2); s += __shfl_xor(s, 4); s += __shfl_xor(s, 8);
        if ((lane & 15) == 0) atomicMax(E.qkm + (t == 0 ? 80 : 64) + (cq >> 6), __float_as_uint(s));
    }
    if (t == 0) { v = v * QC2; u32x2 w; w.x = pk2(v[0], v[1]); w.y = pk2(v[2], v[3]); *(u32x2*)(E.Qb + (size_t)row * 1024 + cq) = w; }
    else {
        const size_t kvrow = (size_t)(SEQ + (sr >> 5) * LSP + PAST + (sr & 31));
        u32x2 w; w.x = pk2(v[0], v[1]); w.y = pk2(v[2], v[3]); *(u32x2*)((t == 1 ? E.Kb : E.Vb) + kvrow * 1024 + cq) = w;
        *(f32x4*)((t == 1 ? E.outKs : E.outVs) + (size_t)sr * 1024 + cq) = v;
    }
}
__device__ __forceinline__ void small_gemm(LAS unsigned char* lds, const bf16_t* A, int lda, const bf16_t* Bt, int ldb, int N, int K, const pg8::EpiG& E, int vcu, int G, int tid, int wave, const float* xinS) {
    const int lane = tid & 63, r32 = lane & 31, hi = lane >> 5, lrow = lane >> 3, lpc = lane & 7;
    LAS float* red = (LAS float*)lds;
    LAS unsigned char* stg = lds + wave * 13824;
    const int ntile = 8 * (N >> 6), kw = K >> 3;
    for (int tile = vcu; tile < ntile; tile += G) {
        const int rb = tile & 7, cb = tile >> 3;
        const bf16_t* ag = A + (size_t)(SEQ + rb * 32 + lrow) * lda + wave * kw + lpc * 8;
        const bf16_t* bg = Bt + (size_t)(cb * 64 + lrow) * ldb + wave * kw + lpc * 8;
        f32x16 c0 = f32x16{}, c1 = f32x16{};
        const float rrow = (E.mode == 2) ? 1.0f : rinv_row(E.rpart_in, SEQ + rb * 32 + (tid >> 4));
        for (int k0 = 0; k0 < kw; k0 += 128) {
            u32x4 ra[2][4], rv[2][8];
#pragma unroll
            for (int sb = 0; sb < 2; ++sb) {
#pragma unroll
                for (int i = 0; i < 4; ++i) ra[sb][i] = *(const u32x4*)(ag + (size_t)(8 * i) * lda + k0 + sb * 64);
#pragma unroll
                for (int i = 0; i < 8; ++i) rv[sb][i] = *(const u32x4*)(bg + (size_t)(8 * i) * ldb + k0 + sb * 64);
            }
            asm volatile("" : "+v"(ra[0][0]), "+v"(ra[0][1]), "+v"(ra[0][2]), "+v"(ra[0][3]), "+v"(ra[1][0]), "+v"(ra[1][1]), "+v"(ra[1][2]), "+v"(ra[1][3]),
                              "+v"(rv[0][0]), "+v"(rv[0][1]), "+v"(rv[0][2]), "+v"(rv[0][3]), "+v"(rv[0][4]), "+v"(rv[0][5]), "+v"(rv[0][6]), "+v"(rv[0][7]),
                              "+v"(rv[1][0]), "+v"(rv[1][1]), "+v"(rv[1][2]), "+v"(rv[1][3]), "+v"(rv[1][4]), "+v"(rv[1][5]), "+v"(rv[1][6]), "+v"(rv[1][7]));
#pragma unroll
            for (int sb = 0; sb < 2; ++sb) {
#pragma unroll
                for (int i = 0; i < 4; ++i) *(LAS u32x4*)(stg + (8 * i + lrow) * 144 + lpc * 16) = ra[sb][i];
#pragma unroll
                for (int i = 0; i < 8; ++i) *(LAS u32x4*)(stg + 4608 + (8 * i + lrow) * 144 + lpc * 16) = rv[sb][i];
                bf16x8 fa[4], fb0[4], fb1[4];
#pragma unroll
                for (int ks = 0; ks < 4; ++ks) { fa[ks] = *(const LAS bf16x8*)(stg + r32 * 144 + (2 * ks + hi) * 16);
                    fb0[ks] = *(const LAS bf16x8*)(stg + 4608 + r32 * 144 + (2 * ks + hi) * 16); fb1[ks] = *(const LAS bf16x8*)(stg + 4608 + (32 + r32) * 144 + (2 * ks + hi) * 16); }
#pragma unroll
                for (int ks = 0; ks < 4; ++ks) {
                    c0 = __builtin_amdgcn_mfma_f32_32x32x16_bf16(fb0[ks], fa[ks], c0, 0, 0, 0);
                    c1 = __builtin_amdgcn_mfma_f32_32x32x16_bf16(fb1[ks], fa[ks], c1, 0, 0, 0);
                }
            }
        }
        __syncthreads();
        LAS float* wr_ = red + wave * (32 * 68) + r32 * 68 + 4 * hi;
#pragma unroll
        for (int g = 0; g < 4; ++g) {
            *(LAS f32x4*)(wr_ + 8 * g) = (f32x4){c0[4 * g], c0[4 * g + 1], c0[4 * g + 2], c0[4 * g + 3]};
            *(LAS f32x4*)(wr_ + 32 + 8 * g) = (f32x4){c1[4 * g], c1[4 * g + 1], c1[4 * g + 2], c1[4 * g + 3]};
        }
        __syncthreads();
        const int m = tid >> 4, c4 = (tid & 15) * 4;
        f32x4 v = *(const LAS f32x4*)(red + m * 68 + c4);
#pragma unroll
        for (int w = 1; w < 8; ++w) v += *(const LAS f32x4*)(red + w * (32 * 68) + m * 68 + c4);
        epi_small(E, SEQ + rb * 32 + m, cb * 64 + c4, v, lane, rrow, xinS);
        __syncthreads();
    }
}

#define XB_TMO      128
#define XB_XCNT(j)  (256  + 64 * (j))
#define XB_XSUB(j)  (1280 + 64 * (j))
#define XB_XGEN(j)  (2304 + 64 * (j))
#define XB_TOP      3328
#define XB_TOPGEN   3392
#define XCD_BAR_WORDS 3456
#define XB_SPIN_CAP (1u << 18)

__device__ __forceinline__ unsigned xb_ld(unsigned* p)              { return __hip_atomic_load(p, __ATOMIC_RELAXED, __HIP_MEMORY_SCOPE_AGENT); }
__device__ __forceinline__ unsigned xb_add(unsigned* p, unsigned v) { return __hip_atomic_fetch_add(p, v, __ATOMIC_RELAXED, __HIP_MEMORY_SCOPE_AGENT); }
__device__ __forceinline__ unsigned xb_xcc_id() { return (unsigned)__builtin_amdgcn_s_getreg((3 << 11) | 20) & 0xFu; }
#define XB_SPIN(cond, bar) do { unsigned _sp = 0; while (cond) { __builtin_amdgcn_s_sleep(1); \
    if ((++_sp & 255u) == 0u) { if (xb_ld(&(bar)[XB_TMO])) break; if (_sp > XB_SPIN_CAP) { atomicAdd(&(bar)[XB_TMO], 1u); break; } } } } while (0)

struct XcdBarrier {
    unsigned* bar; unsigned x;
    volatile LAS unsigned* st;
};

__device__ __forceinline__ XcdBarrier xcd_barrier_post(unsigned* bar, volatile LAS unsigned* st) {
    XcdBarrier b; b.bar = bar; b.x = xb_xcc_id(); b.st = st;
    if (threadIdx.x == 0) (void)xb_add(&bar[XB_XCNT(b.x)], 1u);
    return b;
}
__device__ __forceinline__ void xcd_barrier_complete(unsigned* bar, unsigned x, unsigned& nloc, unsigned& nx) {
    const unsigned G = gridDim.x * gridDim.y * gridDim.z;
    unsigned sum, cnt, mine, sp = 0u;
    for (;;) {
        sum = 0u; cnt = 0u; mine = 0u;
#pragma unroll
        for (unsigned j = 0; j < 16; ++j) { const unsigned c = xb_ld(&bar[XB_XCNT(j)]); sum += c; cnt += (c > 0u) ? 1u : 0u; mine = (j == x) ? c : mine; }
        if (sum == G) break;
        __builtin_amdgcn_s_sleep(1);
        if ((++sp & 255u) == 0u) { if (xb_ld(&bar[XB_TMO])) break; if (sp > XB_SPIN_CAP) { atomicAdd(&bar[XB_TMO], 1u); break; } }
    }
    nloc = mine > 0u ? mine : 1u; nx = cnt > 0u ? cnt : 1u;
}

__device__ __forceinline__ void xcd_barrier(const XcdBarrier& b) {
    asm volatile("s_waitcnt vmcnt(0)" ::: "memory");
    __syncthreads();
    if (threadIdx.x == 0) {
        unsigned* bar = b.bar;
        __builtin_amdgcn_s_waitcnt(0);
        unsigned nloc = b.st[0], nx = b.st[1];
        if (nloc == 0u) { xcd_barrier_complete(bar, b.x, nloc, nx); b.st[0] = nloc; b.st[1] = nx; }
        const unsigned old = xb_add(&bar[XB_XSUB(b.x)], 1u);
        const unsigned gen = old / nloc;
        if (old + 1u == (gen + 1u) * nloc) {
            __builtin_amdgcn_fence(__ATOMIC_RELEASE, "agent");
            asm volatile("s_waitcnt vmcnt(0)" ::: "memory");
            const unsigned og = xb_add(&bar[XB_TOP], 1u);
            const unsigned tg = og / nx;
            if (og + 1u == (tg + 1u) * nx) xb_add(&bar[XB_TOPGEN], 1u);
            else XB_SPIN(xb_ld(&bar[XB_TOPGEN]) == tg, bar);
            __builtin_amdgcn_fence(__ATOMIC_ACQUIRE, "agent");
            xb_add(&bar[XB_XGEN(b.x)], 1u);
            asm volatile("s_waitcnt vmcnt(0)" ::: "memory");
        } else {
            XB_SPIN(xb_ld(&bar[XB_XGEN(b.x)]) == gen, bar);
            __builtin_amdgcn_fence(__ATOMIC_ACQUIRE, "agent");
            asm volatile("s_waitcnt vmcnt(0)" ::: "memory");
        }
    }
    __syncthreads();
}

#define F1_EXTRAS() do { \
                const bf16_t* Wf = (const bf16_t*)(ws + WS_WF) + (size_t)j * 16 * 1024; \
                const int fr = lane & 15, fq = lane >> 4; \
                for (int grp = gw; grp < M / 16; grp += NGW) { \
                    const int row = grp * 16 + fr; \
                    const bf16_t* xp = Xb + (size_t)row * 1024 + fq * 8; const bf16_t* wp = Wf + (size_t)fr * 1024 + fq * 8; \
                    f32x4 acc = {0.f, 0.f, 0.f, 0.f}; \
                    const float r = rinv_row(rpart, row); \
                    const f32x4 bf = *(const f32x4*)(fox_b_f + j * 16 + 4 * fq); \
                    for (int k0 = 0; k0 < 32; k0 += 8) { \
                        bf16x8 xa[8], wa[8]; \
_Pragma("unroll") \
                        for (int ks = 0; ks < 8; ++ks) { xa[ks] = *(const bf16x8*)(xp + (k0 + ks) * 32); wa[ks] = *(const bf16x8*)(wp + (k0 + ks) * 32); } \
                        asm volatile("" : "+v"(xa[0]), "+v"(xa[1]), "+v"(xa[2]), "+v"(xa[3]), "+v"(xa[4]), "+v"(xa[5]), "+v"(xa[6]), "+v"(xa[7]), \
                                          "+v"(wa[0]), "+v"(wa[1]), "+v"(wa[2]), "+v"(wa[3]), "+v"(wa[4]), "+v"(wa[5]), "+v"(wa[6]), "+v"(wa[7])); \
_Pragma("unroll") \
                        for (int ks = 0; ks < 8; ++ks) acc = __builtin_amdgcn_mfma_f32_16x16x32_bf16(wa[ks], xa[ks], acc, 0, 0, 0); \
                    } \
                    f32x4 lf; \
_Pragma("unroll") \
                    for (int e = 0; e < 4; ++e) { const float x = acc[e] * r + bf[e]; lf[e] = fminf(x, 0.f) - log1pf(expf(-fabsf(x))); } \
                    *(f32x4*)(LF + (size_t)row * 16 + 4 * fq) = lf; \
                    float* op = (row < SEQ) ? out + O_PLF + ((size_t)j * SEQ + row) * 16 : out + O_SLF + ((size_t)j * MS + (row - SEQ)) * 16; \
                    *(f32x4*)(op + 4 * fq) = lf; \
                } \
                { \
                    const float* ck = cache_k + (size_t)j * NSB * PAST * 1024; const float* cv = cache_v + (size_t)j * NSB * PAST * 1024; \
                    float kmax = 0.f; \
                    for (int hr0 = gw; hr0 < NSB * PAST * 2; hr0 += 4 * NGW) { \
                        f32x4 kk[4][2], vv[4][2]; \
_Pragma("unroll") \
                        for (int q = 0; q < 4; ++q) { const int hr = hr0 + q * NGW; const int b = hr >> 12, pos = (hr >> 1) & 2047, half = hr & 1; \
                            const size_t so = ((size_t)(b * PAST + pos)) * 1024 + half * 512 + lane * 8; \
                            kk[q][0] = *(const f32x4*)(ck + so); kk[q][1] = *(const f32x4*)(ck + so + 4); vv[q][0] = *(const f32x4*)(cv + so); vv[q][1] = *(const f32x4*)(cv + so + 4); } \
_Pragma("unroll") \
                        for (int q = 0; q < 4; ++q) { const int hr = hr0 + q * NGW; const int b = hr >> 12, pos = (hr >> 1) & 2047, half = hr & 1; \
                            const size_t dofs = ((size_t)(SEQ + b * LSP + pos)) * 1024 + half * 512 + lane * 8; \
                            const f32x4 k0 = kk[q][0], k1 = kk[q][1], v0 = vv[q][0], v1 = vv[q][1]; \
                            u32x4 w; w.x = pk2(k0[0], k0[1]); w.y = pk2(k0[2], k0[3]); w.z = pk2(k1[0], k1[1]); w.w = pk2(k1[2], k1[3]); \
                            *(u32x4*)(Kb + dofs) = w; \
                            w.x = pk2(v0[0], v0[1]); w.y = pk2(v0[2], v0[3]); w.z = pk2(v1[0], v1[1]); w.w = pk2(v1[2], v1[3]); \
                            *(u32x4*)(Vb + dofs) = w; \
                            float s = (k0[0] * k0[0] + k0[1] * k0[1]) + (k0[2] * k0[2] + k0[3] * k0[3]) + (k1[0] * k1[0] + k1[1] * k1[1]) + (k1[2] * k1[2] + k1[3] * k1[3]); \
                            s += __shfl_xor(s, 1); s += __shfl_xor(s, 2); s += __shfl_xor(s, 4); \
                            kmax = fmaxf(kmax, s); } \
                    } \
                    if ((lane & 7) == 0) atomicMax((unsigned*)(ws + WS_QKM) + j * 128 + 64 + (gw & 1) * 8 + (lane >> 3), __float_as_uint(kmax)); \
                    if (gw < NSB * 32) { \
                        const size_t dofs = ((size_t)(SEQ + (gw >> 5) * LSP + PAST + TS + (gw & 31))) * 1024 + lane * 16; \
                        const u32x4 z = {0u, 0u, 0u, 0u}; \
                        *(u32x4*)(Kb + dofs) = z; *(u32x4*)(Kb + dofs + 8) = z; *(u32x4*)(Vb + dofs) = z; *(u32x4*)(Vb + dofs + 8) = z; \
                    } \
                } \
} while (0)

template <bool COOP>
__global__ void __launch_bounds__(512, 2) fwd(Args a) {
    extern __shared__ __attribute__((aligned(16))) unsigned char smem[];
    LAS unsigned char* lds = (LAS unsigned char*)smem;
    const int tid0 = threadIdx.x, wave = __builtin_amdgcn_readfirstlane(tid0 >> 6);
    const int G = gridDim.x, bx = blockIdx.x;
    const int vcu = (G % 8 == 0) ? (bx % 8) * (G / 8) + bx / 8 : bx;
    const int gw = vcu * 8 + wave, NGW = G * 8;
    unsigned char* ws = a.ws;
    float* rpart = (float*)(ws + WS_RPART);
    float* LF = (float*)(ws + WS_LF);
    float* c2p = (float*)(ws + WS_C2P);
    float* c2s = (float*)(ws + WS_C2S);
    float* Xf = (float*)(ws + WS_XF);
    bf16_t* Xb = (bf16_t*)(ws + WS_XB);
    bf16_t* A2 = (bf16_t*)(ws + WS_A2);
    bf16_t* OV = (bf16_t*)(ws + WS_OV);
    bf16_t* Qb = (bf16_t*)(ws + WS_Q);
    bf16_t* Kb = (bf16_t*)(ws + WS_K);
    bf16_t* Vb = (bf16_t*)(ws + WS_V);
    const float* x_prompt = a.in[0]; const float* x_sample = a.in[1]; const float* state_conv = a.in[2];
    const float* cache_k = a.in[3]; const float* cache_v = a.in[4]; const float* cache_lf = a.in[5];
    const float* norm_mix = a.in[6]; const float* norm_mlp = a.in[7]; const float* norm_final = a.in[8];
    const float* conv_w_in = a.in[9]; const float* conv_w = a.in[10]; const float* conv_w_out = a.in[11];
    const float* fox_w_in = a.in[12]; const float* fox_b_f = a.in[13]; const float* fox_w_out = a.in[14];
    const float* mlp_w1 = a.in[15]; const float* mlp_w2 = a.in[16];
    float* out = a.out;
    volatile LAS unsigned* misc = (volatile LAS unsigned*)(lds + LDS_CTL);
    if (tid0 < 4) misc[tid0] = 0u;
    __syncthreads();
    XcdBarrier xbar; xbar.bar = (unsigned*)(ws + WS_BAR); xbar.x = 0; xbar.st = misc;

    for (int step = a.lo; step < a.hi; ++step) {
        if constexpr (COOP) {
            if (step == a.lo + 1) { cg::this_grid().sync(); xbar = xcd_barrier_post((unsigned*)(ws + WS_BAR), misc); }
            else if (step > a.lo + 1) xcd_barrier(xbar);
        }
        int kind;
        int j = 0, layer = 0;
        if (step == 0) kind = 0;
        else if (step == 23) kind = 10;
        else { const int s = step - 1; j = s / 11; const int r = s % 11;
            if (r < 5) { layer = 2 * j; kind = (r < 3) ? 1 + r : 4 + (r - 3); }
            else { layer = 2 * j + 1; const int q = r - 5; kind = (q < 4) ? 6 + q : 4 + (q - 4); } }

        for (int rep = 0; rep < ((kind == REPEAT_KIND) ? 2 : 1); ++rep) {
        int tid = tid0; asm volatile("" : "+v"(tid));
        const int lane = tid & 63;
        if (kind == 1 || kind == 3 || kind == 4 || kind == 5 || kind == 6 || kind == 9) {
            pg8::Gemm g; pg8::EpiG E{};
            E.rpart_in = rpart; E.rpart_out = rpart; E.Xf = nullptr; E.Xb = Xb;
            if (kind == 1) { g = pg8::Gemm{Xb, (const bf16_t*)(ws + W_CIN + (size_t)j * 6 * MiB), M, 3072, 1024, 1024, 1024}; E.mode = 0; E.O = OV; E.ldc = 3072; }
            else if (kind == 3) { g = pg8::Gemm{A2, (const bf16_t*)(ws + W_COUT + (size_t)j * 2 * MiB), M, 1024, 1024, 1024, 1024}; E.mode = 2; }
            else if (kind == 4) { g = pg8::Gemm{Xb, (const bf16_t*)(ws + W_1 + (size_t)layer * 8 * MiB), M, 4096, 1024, 1024, 1024}; E.mode = 3; E.O = OV; E.ldc = HLD; }
            else if (kind == 5) { g = pg8::Gemm{OV, (const bf16_t*)(ws + W_2 + (size_t)layer * 9 * MiB), M, 1024, 4096, HLD, HLD}; E.mode = 2; }
            else if (kind == 6) { g = pg8::Gemm{Xb, (const bf16_t*)(ws + W_FIN + (size_t)j * 6 * MiB), M, 3072, 1024, 1024, 1024}; E.mode = 1;
                E.Qb = Qb; E.Kb = Kb; E.Vb = Vb; E.qkm = (unsigned*)(ws + WS_QKM) + j * 128;
                E.outKp = out + O_PK + (size_t)j * SEQ * 1024; E.outVp = out + O_PV + (size_t)j * SEQ * 1024;
                E.outKs = out + O_SK + (size_t)j * MS * 1024; E.outVs = out + O_SV + (size_t)j * MS * 1024; }
            else { g = pg8::Gemm{A2, (const bf16_t*)(ws + W_FO + (size_t)j * 2 * MiB), M, 1024, 1024, 1024, 1024}; E.mode = 2; }
            if (rep == 1 && E.mode == 2) { E.Xf = (float*)(ws + 410 * MiB); E.Xb = (bf16_t*)(ws + 479 * MiB); E.rpart_out = (float*)(ws + 514 * MiB); }
            const bool first_res = (kind == 3 && j == 0);
            E.XinP = first_res ? x_prompt : Xf; const float* xinS = first_res ? x_sample : Xf + (size_t)SEQ * 1024;
            E.rl = (const PG8_LAS float*)(lds + 131072); E.pm0 = -1;
            g.M = SEQ;
            pg8::StaticOrder S; S.init(g.M, g.N, G, bx);
            if (kind == 6 && (bx & 1)) F1_EXTRAS();
            if (E.mode != 2) {
                pg8::Unit u0; S.next(0, u0); E.pm0 = u0.pm;
                const int row = u0.pm * 256 + (tid >> 1); const f32x4* rp = (const f32x4*)(rpart + (size_t)row * 16 + (tid & 1) * 8);
                const f32x4 a_ = rp[0], b_ = rp[1]; float s_ = ((a_[0] + a_[1]) + (a_[2] + a_[3])) + ((b_[0] + b_[1]) + (b_[2] + b_[3]));
                s_ += __shfl_xor(s_, 1);
                if ((tid & 1) == 0) ((LAS float*)(lds + 131072))[tid >> 1] = 1.0f / sqrtf(s_ * (1.0f / 1024.0f) + EPS);
                __syncthreads();
            }
            pg8::gemm_phase<pg8::EpiG, pg8::StaticOrder, true, true>(lds, g, S, E);
            small_gemm(lds, g.A, g.lda, g.Bt, g.ldb, g.N, g.K, E, vcu, G, tid, wave, xinS);
            if (kind == 6 && !(bx & 1)) F1_EXTRAS();
        } else if (kind == 0) {
            LAS float* scr = (LAS float*)(lds + wave * 16384);
            for (int it = gw; it < 24576; it += NGW) {
                if (it < 8192) { const int jj = it >> 12, r = it & 4095;
                    if (r < 1536) transpose_item(conv_w_in + (size_t)jj * 1024 * 3072, 1024, 3072, 3072, norm_mix + (2 * jj) * 1024, (bf16_t*)(ws + W_CIN + (size_t)jj * 6 * MiB), scr, r, lane);
                    else if (r < 2048) transpose_item(conv_w_out + (size_t)jj * 1024 * 1024, 1024, 1024, 1024, nullptr, (bf16_t*)(ws + W_COUT + (size_t)jj * 2 * MiB), scr, r - 1536, lane);
                    else if (r < 3584) transpose_item(fox_w_in + (size_t)jj * 1024 * 3088, 1024, 3072, 3088, norm_mix + (2 * jj + 1) * 1024, (bf16_t*)(ws + W_FIN + (size_t)jj * 6 * MiB), scr, r - 2048, lane);
                    else transpose_item(fox_w_out + (size_t)jj * 1024 * 1024, 1024, 1024, 1024, nullptr, (bf16_t*)(ws + W_FO + (size_t)jj * 2 * MiB), scr, r - 3584, lane);
                } else { const int r0 = it - 8192, i = r0 >> 12, r = r0 & 4095;
                    if (r < 2048) transpose_item(mlp_w1 + (size_t)i * 1024 * 4096, 1024, 4096, 4096, norm_mlp + i * 1024, (bf16_t*)(ws + W_1 + (size_t)i * 8 * MiB), scr, r, lane);
                    else transpose_item(mlp_w2 + (size_t)i * 4096 * 1024, 4096, 1024, 1024, nullptr, (bf16_t*)(ws + W_2 + (size_t)i * 9 * MiB), scr, r - 2048, lane, HLD);
                }
            }
            for (int idx = gw * 64 + lane; idx < 2 * 16 * 1024; idx += NGW * 64) {
                const int jj = idx >> 14, hh = (idx >> 10) & 15, k = idx & 1023;
                const float v = fox_w_in[(size_t)jj * 1024 * 3088 + (size_t)k * 3088 + 3072 + hh] * norm_mix[(2 * jj + 1) * 1024 + k];
                ((bf16_t*)(ws + WS_WF))[idx] = (bf16_t)(pk2(v, 0.f) & 0xffffu);
            }
            for (int m = gw; m < M; m += NGW) {
                const float* xr = (m < SEQ) ? x_prompt + (size_t)m * 1024 : x_sample + (size_t)(m - SEQ) * 1024;
                f32x4 v[4]; float s = 0.f;
#pragma unroll
                for (int q = 0; q < 4; ++q) { v[q] = *(const f32x4*)(xr + q * 256 + lane * 4); s += (v[q][0] * v[q][0] + v[q][1] * v[q][1]) + (v[q][2] * v[q][2] + v[q][3] * v[q][3]); }
                s = wave_sum(s);
#pragma unroll
                for (int q = 0; q < 4; ++q) {
                    u32x2 w; w.x = pk2(v[q][0], v[q][1]); w.y = pk2(v[q][2], v[q][3]); *(u32x2*)(Xb + (size_t)m * 1024 + q * 256 + lane * 4) = w; }
                if (lane < 16) rpart[(size_t)m * 16 + lane] = (lane == 0) ? s : 0.f;
            }
            if (bx == 0) { ((unsigned*)(ws + WS_QKM))[tid] = 0u; for (int i = tid; i < XCD_BAR_WORDS; i += 512) ((unsigned*)(ws + WS_BAR))[i] = 0u; }
        } else if (kind == 2) {
            const bf16_t* BCH = OV; const float* cw = conv_w + (size_t)j * 3 * 1024;
            for (int it = gw; it < 2 * (M / 16); it += NGW) {
                const int ch = it & 1, row0 = (it >> 1) * 16, col = ch * 512 + lane * 8;
                float w0[8], w1[8], w2[8], um2[8], um1[8];
#pragma unroll
                for (int e = 0; e < 8; ++e) { w0[e] = cw[col + e]; w1[e] = cw[1024 + col + e]; w2[e] = cw[2048 + col + e]; }
                const bool samp = row0 >= SEQ; const int t0 = samp ? ((row0 - SEQ) & 31) : row0;
                if (t0 == 0) {
                    if (samp) { const int b = (row0 - SEQ) >> 5; const float* sp = state_conv + ((size_t)(j * NSB + b) * 2) * 1024 + col;
#pragma unroll
                        for (int e = 0; e < 8; ++e) { um2[e] = sp[e]; um1[e] = sp[1024 + e]; } }
                    else {
#pragma unroll
                        for (int e = 0; e < 8; ++e) { um2[e] = 0.f; um1[e] = 0.f; } }
                } else {
#pragma unroll
                    for (int q = 0; q < 2; ++q) { const bf16_t* rp = BCH + (size_t)(row0 - 2 + q) * 3072 + col;
                        const u32x4 c = *(const u32x4*)(rp + 1024), hh = *(const u32x4*)(rp + 2048);
#pragma unroll
                        for (int e = 0; e < 4; ++e) { const float ulo = bf_lo(c[e]) * bf_lo(hh[e]), uhi = bf_hi(c[e]) * bf_hi(hh[e]);
                            if (q == 0) { um2[2 * e] = ulo; um2[2 * e + 1] = uhi; } else { um1[2 * e] = ulo; um1[2 * e + 1] = uhi; } } }
                }
                for (int r4 = 0; r4 < 16; r4 += 4) {
                u32x4 bbq[4], cq[4], hq[4];
#pragma unroll
                for (int q = 0; q < 4; ++q) { const bf16_t* rp = BCH + (size_t)(row0 + r4 + q) * 3072 + col; bbq[q] = *(const u32x4*)rp; cq[q] = *(const u32x4*)(rp + 1024); hq[q] = *(const u32x4*)(rp + 2048); }
                asm volatile("" : "+v"(bbq[0]), "+v"(bbq[1]), "+v"(bbq[2]), "+v"(bbq[3]), "+v"(cq[0]), "+v"(cq[1]), "+v"(cq[2]), "+v"(cq[3]), "+v"(hq[0]), "+v"(hq[1]), "+v"(hq[2]), "+v"(hq[3]));
#pragma unroll
                for (int q = 0; q < 4; ++q) {
                    const int r = r4 + q; const int row = row0 + r;
                    const u32x4 bb = bbq[q], c = cq[q], hh = hq[q];
                    float uu[8], vv[8];
#pragma unroll
                    for (int e = 0; e < 4; ++e) { uu[2 * e] = bf_lo(c[e]) * bf_lo(hh[e]); uu[2 * e + 1] = bf_hi(c[e]) * bf_hi(hh[e]); }
#pragma unroll
                    for (int e = 0; e < 4; ++e) {
                        vv[2 * e] = bf_lo(bb[e]) * (w0[2 * e] * um2[2 * e] + w1[2 * e] * um1[2 * e] + w2[2 * e] * uu[2 * e]);
                        vv[2 * e + 1] = bf_hi(bb[e]) * (w0[2 * e + 1] * um2[2 * e + 1] + w1[2 * e + 1] * um1[2 * e + 1] + w2[2 * e + 1] * uu[2 * e + 1]); }
                    u32x4 w; w.x = pk2(vv[0], vv[1]); w.y = pk2(vv[2], vv[3]); w.z = pk2(vv[4], vv[5]); w.w = pk2(vv[6], vv[7]);
                    *(u32x4*)(A2 + (size_t)row * 1024 + col) = w;
                    float* so = nullptr;
                    if (!samp) { if (row >= SEQ - 2) so = out + O_PCONV + ((size_t)j * 2 + (row - (SEQ - 2))) * 1024 + col; }
                    else { const int sr = row - SEQ, tt = sr & 31; if (tt >= 30) so = out + O_SCONV + ((size_t)(j * NSB + (sr >> 5)) * 2 + (tt - 30)) * 1024 + col; }
                    if (so) { *(f32x4*)so = (f32x4){uu[0], uu[1], uu[2], uu[3]}; *(f32x4*)(so + 4) = (f32x4){uu[4], uu[5], uu[6], uu[7]}; }
#pragma unroll
                    for (int e = 0; e < 8; ++e) { um2[e] = um1[e]; um1[e] = uu[e]; }
                }
                }
            }
        } else if (kind == 7) {
            if (bx < 144) {
                LAS float* red = (LAS float*)(lds + 80 * 1024);
                LAS float* sv = (LAS float*)lds;
                const bool pr = bx < 16; const int hh = pr ? bx : ((bx - 16) & 15), b = pr ? 0 : ((bx - 16) >> 4);
                const int n = pr ? SEQ : (PAST + TS), per = pr ? 32 : 5;
                const float* clf = cache_lf + ((size_t)(j * NSB + b) * PAST) * 16 + hh;
                const float* nlf = pr ? LF + hh : LF + (size_t)(SEQ + b * 32) * 16 + hh;
                float* dst = pr ? c2p + (size_t)hh * SEQ : c2s + (size_t)(b * 16 + hh) * LSP;
                if (pr) {
                    float v[32];
#pragma unroll
                    for (int i = 0; i < 32; ++i) v[i] = nlf[(size_t)(i * 512 + tid) * 16];
#pragma unroll
                    for (int i = 0; i < 32; ++i) { const int pos = i * 512 + tid; sv[pos + (pos >> 5)] = v[i]; }
                } else {
                    float v[5];
#pragma unroll
                    for (int i = 0; i < 5; ++i) { const int pos = i * 512 + tid; v[i] = (pos < PAST) ? clf[(size_t)pos * 16] : (pos < n ? nlf[(size_t)(pos - PAST) * 16] : 0.f); }
#pragma unroll
                    for (int i = 0; i < 5; ++i) { const int pos = i * 512 + tid; sv[pos + (pos >> 5)] = v[i]; }
                }
                __syncthreads();
                const int s0 = tid * per; float tot = 0.f;
                for (int i = 0; i < per; ++i) { const int pos = s0 + i; if (pos < n) tot += sv[pos + (pos >> 5)]; }
                float inc = tot;
#pragma unroll
                for (int o = 1; o < 64; o <<= 1) { const float t = __shfl_up(inc, o); if (lane >= o) inc += t; }
                if (lane == 63) red[wave] = inc;
                __syncthreads();
                float run = inc - tot;
                for (int w = 0; w < wave; ++w) run += red[w];
                for (int i = 0; i < per; ++i) { const int pos = s0 + i; if (pos < n) { run += sv[pos + (pos >> 5)]; sv[pos + (pos >> 5)] = run * LOG2E; } }
                __syncthreads();
                for (int pos = tid; pos < n; pos += 512) dst[pos] = sv[pos + (pos >> 5)];
                __syncthreads();
            }
        } else if (kind == 8) {
            const unsigned* qkm = (const unsigned*)(ws + WS_QKM) + j * 128;
            unsigned* qctr = (unsigned*)(ws + WS_QKM) + 256 + j * 64;
            volatile LAS int* aord = (volatile LAS int*)(lds + A_END); volatile LAS float* atot = (volatile LAS float*)(lds + A_END + 64); volatile LAS unsigned* aq = (volatile LAS unsigned*)(lds + A_END + 128);
            volatile LAS float* acs = (volatile LAS float*)(lds + A_END + 192);
            if (tid < 16) { atot[tid] = c2p[(size_t)tid * SEQ + SEQ - 1];
                const float qn2_ = fmaxf(__uint_as_float(qkm[tid * 2]) + __uint_as_float(qkm[tid * 2 + 1]), __uint_as_float(qkm[80 + tid]));
                const float kn2_ = fmaxf(__uint_as_float(qkm[32 + tid * 2]) + __uint_as_float(qkm[32 + tid * 2 + 1]), __uint_as_float(qkm[64 + tid]));
                acs[tid] = QC2 * 1.02f * sqrtf(qn2_ * kn2_); }
            __syncthreads();
            if (tid < 16) { const float me = atot[tid]; int rk = 0; for (int o2 = 0; o2 < 16; ++o2) { const float ot = atot[o2]; rk += (ot > me || (ot == me && o2 < tid)) ? 1 : 0; } aord[rk] = tid; }
            __syncthreads();
            if (tid == 0) aq[0] = atomicAdd(qctr, 1u);
            __syncthreads();
            int q = (int)aq[0];
            while (q < 1024 + 128) {
                unsigned nq = 0u; if (tid == 0) nq = atomicAdd(qctr, 1u);
                int hh, nrows, p0; long qrow0, kvbase; const float* c2seq;
                if (q >= 128) { const int qq = q - 128; hh = aord[qq >> 6]; const int qb = 63 - (qq & 63); qrow0 = 256 * qb; kvbase = 0; p0 = 256 * qb; nrows = 256; c2seq = c2p + (size_t)hh * SEQ; }
                else { const int sI = q, b = sI >> 4;   hh = sI & 15; qrow0 = SEQ + 32 * b; kvbase = SEQ + (long)b * LSP; p0 = PAST; nrows = 32; c2seq = c2s + (size_t)(b * 16 + hh) * LSP; }
                const float CS1 = acs[hh];
                const float TH = 2.0f * CS1 + 152.0f;
                attn_unit(lds, Qb, Kb, Vb, A2, c2seq, qrow0, kvbase, p0, nrows, hh, TH, CS1, lane, wave);
                if (tid == 0) aq[0] = nq;
                __syncthreads();
                q = (int)aq[0];
                __syncthreads();
            }
        } else {
            f32x4 gg[4];
#pragma unroll
            for (int q = 0; q < 4; ++q) gg[q] = *(const f32x4*)(norm_final + q * 256 + lane * 4);
            for (int m = gw; m < M; m += NGW) {
                const f32x4* rp = (const f32x4*)(rpart + (size_t)m * 16);
                f32x4 ra = rp[0], rb = rp[1], rc = rp[2], rd = rp[3], v[4];
                u32x2 xw[4];
#pragma unroll
                for (int q = 0; q < 4; ++q) xw[q] = *(const u32x2*)(Xb + (size_t)m * 1024 + q * 256 + lane * 4);
                asm volatile("" : "+v"(ra), "+v"(rb), "+v"(rc), "+v"(rd), "+v"(xw[0]), "+v"(xw[1]), "+v"(xw[2]), "+v"(xw[3]));
#pragma unroll
                for (int q = 0; q < 4; ++q) v[q] = (f32x4){__uint_as_float(xw[q].x << 16), __uint_as_float(xw[q].x & 0xffff0000u), __uint_as_float(xw[q].y << 16), __uint_as_float(xw[q].y & 0xffff0000u)};
                const float sN = ((ra[0] + ra[1]) + (ra[2] + ra[3])) + ((rb[0] + rb[1]) + (rb[2] + rb[3])) + ((rc[0] + rc[1]) + (rc[2] + rc[3])) + ((rd[0] + rd[1]) + (rd[2] + rd[3]));
                const float r = 1.0f / sqrtf(sN * (1.0f / 1024.0f) + EPS);
#pragma unroll
                for (int q = 0; q < 4; ++q) *(f32x4*)(out + O_Y + (size_t)m * 1024 + q * 256 + lane * 4) = v[q] * r * gg[q];
            }
        }
        }
    }
}

constexpr int NSTEPS = 24;
extern "C" void kernel_launch(void* const* d_in, const int* in_sizes, int n_in, void* d_out, int out_size, void* d_ws, size_t ws_size, hipStream_t stream) {
    static int grid = 0;
    if (grid == 0) {
        if (n_in != 17 || ws_size < WS_END) { fprintf(stderr, "kernel_launch: unexpected n_in %d or workspace %zu < %zu\n", n_in, ws_size, (size_t)WS_END); grid = -1; return; }
        int dev = 0, cus = 0, per_cu = 0;
        hipGetDevice(&dev); hipDeviceGetAttribute(&cus, hipDeviceAttributeMultiprocessorCount, dev);
        hipFuncSetAttribute((const void*)fwd<true>, hipFuncAttributeMaxDynamicSharedMemorySize, LDS_BYTES);
        hipFuncSetAttribute((const void*)fwd<false>, hipFuncAttributeMaxDynamicSharedMemorySize, LDS_BYTES);
        hipOccupancyMaxActiveBlocksPerMultiprocessor(&per_cu, (const void*)fwd<true>, 512, LDS_BYTES);
        (void)hipGetLastError();
        if (per_cu < 1) per_cu = 1;
        grid = cus * 1;
        fprintf(stderr, "kernel_launch: cus %d per_cu %d grid %d\n", cus, per_cu, grid);
    }
    if (grid < 0) return;
    Args a{};
    for (int i = 0; i < 17; ++i) a.in[i] = (const float*)d_in[i];
    a.out = (float*)d_out; a.ws = (unsigned char*)d_ws;
#if MULTI_LAUNCH
    for (int p = 0; p < NSTEPS; ++p) { a.lo = p; a.hi = p + 1; hipLaunchKernelGGL(fwd<false>, dim3(grid), dim3(512), LDS_BYTES, stream, a); }
#else
    a.lo = 0; a.hi = NSTEPS;
    void* args[] = {&a};
    hipError_t e = hipLaunchCooperativeKernel((const void*)fwd<true>, dim3(grid), dim3(512), args, LDS_BYTES, stream);
    if (e != hipSuccess) fprintf(stderr, "cooperative launch failed: %s (grid %d)\n", hipGetErrorString(e), grid);
#endif
}
```

```cpp
#include <hip/hip_runtime.h>
#include <hip/hip_cooperative_groups.h>
#include <cstdio>
#include <cstdint>
namespace cg = cooperative_groups;
#ifndef REPEAT_KIND
#define REPEAT_KIND -1
#endif
#ifndef MULTI_LAUNCH
#define MULTI_LAUNCH 0
#endif
constexpr int D = 1024, SEQ = 16384, NSB = 8, TS = 32, PAST = 2048, MS = NSB * TS, M = SEQ + MS, FF = 4096, NH = 16;
constexpr int HLD = 4096 + 64;
constexpr int LSP = 2112;
constexpr int KVROWS = SEQ + NSB * LSP;
constexpr float EPS = 1e-5f;
constexpr float LOG2E = 1.4426950408889634f;
constexpr float QC2 = 0.125f * 1.4426950408889634f;
namespace pg8 {
#define PG8_LAS __attribute__((address_space(3)))
typedef unsigned short bf16_t;
typedef short bf16x8 __attribute__((ext_vector_type(8)));
typedef float f32x4 __attribute__((ext_vector_type(4)));
typedef unsigned u32x4 __attribute__((ext_vector_type(4)));
constexpr int BM = 256, BK = 64, HALF = 128, HTB = HALF * BK * 2  , STAGE_BYTES = 8 * HTB, NXCD = 8, WGM = 8;

__host__ __device__ __forceinline__ int lds_byte(int r, int c) { const int st = (r >> 4) * 2 + (c >> 5), rr = r & 15, cc = c & 31, ob = rr * 64 + cc * 2; return st * 1024 + (ob ^ (((ob >> 9) & 1) << 5)); }
__host__ __device__ __forceinline__ void stage_rc(int b, int& R, int& C) { const int st = b / 1024, sb = b % 1024, swz = sb ^ (((sb >> 9) & 1) << 5); R = (st >> 1) * 16 + swz / 64; C = (st & 1) * 32 + (swz % 64) / 2; }
__host__ __device__ __forceinline__ int perm32(int rho) { const int n = rho >> 4, i = rho & 15; return 8 * (i >> 2) + 4 * n + (i & 3); }

struct Unit { int pm, pn; };
struct Gemm { const bf16_t* A; const bf16_t* Bt; int M, N, K, lda, ldb; };

struct StaticOrder {
    int nM, nN, nwg, G, c;
    __host__ __device__ void init(int M, int N, int G_, int c_) { nM = M / BM; nN = N / BM; nwg = nM * nN; G = G_; c = c_; }
    __host__ __device__ bool next(int i, Unit& u) const {
        const long L = (long)i * G + c; if (L >= nwg) return false;
        int wgid = (int)L; { const int q = nwg / NXCD, r = nwg % NXCD, xcd = wgid % NXCD, off = wgid / NXCD; wgid = (xcd < r ? xcd * (q + 1) : r * (q + 1) + (xcd - r) * q) + off; }
        const int nig = WGM * nN, gid = wgid / nig, fm = gid * WGM, gsz = (nM - fm) < WGM ? (nM - fm) : WGM;
        u.pm = fm + ((wgid % nig) % gsz); u.pn = (wgid % nig) / gsz; return true;
    }
    __device__ __forceinline__ void a_ready(const Unit&) const {}
    __device__ __forceinline__ void done(const Unit&) const {}
};
__device__ __forceinline__ unsigned cvt_pk_bf16(float lo, float hi) { unsigned r; asm volatile("v_cvt_pk_bf16_f32 %0, %1, %2" : "=v"(r) : "v"(lo), "v"(hi)); return r; }
typedef float f32x2 __attribute__((ext_vector_type(2)));
struct EpiG {
    static constexpr bool PERM = true, AFTER_DRAIN = false;
    int mode;
    bf16_t* O; int ldc;
    const float* rpart_in;
    float* Xf; bf16_t* Xb; float* rpart_out;
    bf16_t *Qb, *Kb, *Vb; float *outKp, *outVp, *outKs, *outVs; unsigned* qkm;
    const PG8_LAS float* rl; int pm0;
    const float* XinP;
    __device__ __forceinline__ void operator()(const f32x4 (&acc)[2][2][4][2], const Unit& u, int wr, int wc, int fr, int fq) const {
        const int rowb = u.pm * BM + wr * 64 + fr;
        const int colb = u.pn * BM + wc * 32 + 8 * fq;
        if (mode == 2) {
#pragma unroll
            for (int ai = 0; ai < 2; ++ai) {
                u32x4 pre[4][2];
#pragma unroll
                for (int m = 0; m < 4; ++m) { const bf16_t* xi = Xb + (size_t)(rowb + ai * HALF + m * 16) * 1024 + colb;
#pragma unroll
                    for (int bj = 0; bj < 2; ++bj) pre[m][bj] = *(const u32x4*)(xi + bj * HALF); }
                asm volatile("" : "+v"(pre[0][0]), "+v"(pre[0][1]), "+v"(pre[1][0]), "+v"(pre[1][1]), "+v"(pre[2][0]), "+v"(pre[2][1]), "+v"(pre[3][0]), "+v"(pre[3][1]));
#pragma unroll
                for (int m = 0; m < 4; ++m) {
                    const int row = rowb + ai * HALF + m * 16;
                    bf16_t* bp = Xb + (size_t)row * 1024 + colb; float ss = 0.f;
#pragma unroll
                    for (int bj = 0; bj < 2; ++bj) {
                        const u32x4 pw = pre[m][bj];
                        f32x4 x0 = {__uint_as_float(pw.x << 16), __uint_as_float(pw.x & 0xffff0000u), __uint_as_float(pw.y << 16), __uint_as_float(pw.y & 0xffff0000u)};
                        f32x4 x1 = {__uint_as_float(pw.z << 16), __uint_as_float(pw.z & 0xffff0000u), __uint_as_float(pw.w << 16), __uint_as_float(pw.w & 0xffff0000u)};
                        x0 += acc[ai][bj][m][0]; x1 += acc[ai][bj][m][1];
                        if (Xf) { float* xp = Xf + (size_t)row * 1024 + colb; *(f32x4*)(xp + bj * HALF) = x0; *(f32x4*)(xp + bj * HALF + 4) = x1; }
                        ss += (x0[0] * x0[0] + x0[1] * x0[1]) + (x0[2] * x0[2] + x0[3] * x0[3]) + (x1[0] * x1[0] + x1[1] * x1[1]) + (x1[2] * x1[2] + x1[3] * x1[3]);
                        u32x4 w; w.x = cvt_pk_bf16(x0[0], x0[1]); w.y = cvt_pk_bf16(x0[2], x0[3]); w.z = cvt_pk_bf16(x1[0], x1[1]); w.w = cvt_pk_bf16(x1[2], x1[3]);
                        *(u32x4*)(bp + bj * HALF) = w;
                    }
                    ss += __shfl_xor(ss, 16); ss += __shfl_xor(ss, 32);
                    if (fq == 0) rpart_out[(size_t)row * 16 + u.pn * 4 + wc] = ss;
                }
            }
            return;
        }
        float rinv[2][4];
        if (u.pm == pm0) {
#pragma unroll
            for (int ai = 0; ai < 2; ++ai)
#pragma unroll
                for (int m = 0; m < 4; ++m) rinv[ai][m] = rl[wr * 64 + fr + ai * HALF + m * 16];
        } else
#pragma unroll
        for (int ai = 0; ai < 2; ++ai)
#pragma unroll
            for (int m = 0; m < 4; ++m) {
                const f32x4* rp = (const f32x4*)(rpart_in + (size_t)(rowb + ai * HALF + m * 16) * 16);
                const f32x4 a = rp[0], b = rp[1], c = rp[2], d = rp[3];
                const float s = ((a[0] + a[1]) + (a[2] + a[3])) + ((b[0] + b[1]) + (b[2] + b[3])) + ((c[0] + c[1]) + (c[2] + c[3])) + ((d[0] + d[1]) + (d[2] + d[3]));
                rinv[ai][m] = 1.0f / sqrtf(s * (1.0f / 1024.0f) + 1e-5f);
            }
        if (mode == 0 || mode == 3) {
#pragma unroll
            for (int ai = 0; ai < 2; ++ai)
#pragma unroll
                for (int m = 0; m < 4; ++m) {
                    bf16_t* rowp = O + (size_t)(rowb + ai * HALF + m * 16) * ldc + colb; const float r = rinv[ai][m];
#pragma unroll
                    for (int bj = 0; bj < 2; ++bj) {
                        f32x4 v0 = acc[ai][bj][m][0] * r, v1 = acc[ai][bj][m][1] * r;
                        if (mode == 3) {
#pragma unroll
                            for (int e = 0; e < 4; ++e) { const float a0 = fmaxf(v0[e], 0.f), a1 = fmaxf(v1[e], 0.f); v0[e] = a0 * a0; v1[e] = a1 * a1; }
                        }
                        u32x4 w; w.x = cvt_pk_bf16(v0[0], v0[1]); w.y = cvt_pk_bf16(v0[2], v0[3]); w.z = cvt_pk_bf16(v1[0], v1[1]); w.w = cvt_pk_bf16(v1[2], v1[3]);
                        *(u32x4*)(rowp + bj * HALF) = w;
                    }
                }
            return;
        }
        const int t = u.pn >> 2; const int colq = (u.pn & 3) * BM + wc * 32 + 8 * fq;
        const bool samp = (u.pm >= 64);
        float mx[2] = {0.f, 0.f};
#pragma unroll
        for (int ai = 0; ai < 2; ++ai)
#pragma unroll
            for (int m = 0; m < 4; ++m) {
                const int row = rowb + ai * HALF + m * 16; const float r = rinv[ai][m];
                const int sr = row - 16384;
                const size_t kvrow = samp ? (size_t)(16384 + (sr >> 5) * 2112 + 2048 + (sr & 31)) : (size_t)row;
#pragma unroll
                for (int bj = 0; bj < 2; ++bj) {
                    f32x4 v0 = acc[ai][bj][m][0] * r, v1 = acc[ai][bj][m][1] * r;
                    if (t < 2) {
                        float s = (v0[0] * v0[0] + v0[1] * v0[1]) + (v0[2] * v0[2] + v0[3] * v0[3]) + (v1[0] * v1[0] + v1[1] * v1[1]) + (v1[2] * v1[2] + v1[3] * v1[3]);
                        s += __shfl_xor(s, 16); s += __shfl_xor(s, 32); mx[bj] = fmaxf(mx[bj], s);
                    }
                    if (t == 0) {
                        v0 = v0 * 0.18033688011112042f; v1 = v1 * 0.18033688011112042f;
                        u32x4 w; w.x = cvt_pk_bf16(v0[0], v0[1]); w.y = cvt_pk_bf16(v0[2], v0[3]); w.z = cvt_pk_bf16(v1[0], v1[1]); w.w = cvt_pk_bf16(v1[2], v1[3]);
                        *(u32x4*)(Qb + (size_t)row * 1024 + colq + bj * HALF) = w;
                    } else {
                        u32x4 w; w.x = cvt_pk_bf16(v0[0], v0[1]); w.y = cvt_pk_bf16(v0[2], v0[3]); w.z = cvt_pk_bf16(v1[0], v1[1]); w.w = cvt_pk_bf16(v1[2], v1[3]);
                        bf16_t* kb = (t == 1 ? Kb : Vb) + kvrow * 1024 + colq + bj * HALF;
                        *(u32x4*)kb = w;
                        float* ob = samp ? ((t == 1 ? outKs : outVs) + (size_t)sr * 1024) : ((t == 1 ? outKp : outVp) + (size_t)row * 1024);
                        ob += colq + bj * HALF;
                        __builtin_nontemporal_store(v0, (f32x4*)ob); __builtin_nontemporal_store(v1, (f32x4*)(ob + 4));
                    }
                }
            }
        if (t < 2) {
#pragma unroll
            for (int bj = 0; bj < 2; ++bj) {
                float v = mx[bj];
                v = fmaxf(v, __shfl_xor(v, 1)); v = fmaxf(v, __shfl_xor(v, 2)); v = fmaxf(v, __shfl_xor(v, 4)); v = fmaxf(v, __shfl_xor(v, 8));
                const int head = (u.pn & 3) * 4 + bj * 2 + (wc >> 1);
                if ((threadIdx.x & 63) == 0) atomicMax(qkm + t * 32 + head * 2 + (wc & 1), __float_as_uint(v));
            }
        }
    }
};
template <class Epi, class Sched, bool ALIGN_EPI = false, bool SP2 = false>
__device__ __forceinline__ void gemm_phase(PG8_LAS unsigned char* lds, const Gemm g, const Sched& S, const Epi& E) {
    const int tid = threadIdx.x, wid = __builtin_amdgcn_readfirstlane(tid >> 6), lane = tid & 63, wr = wid >> 2, wc = wid & 3, fr = lane & 15, fq = lane >> 4;
    const int K = g.K, nt = K / BK;
    unsigned voffA[2], voffB[2];
#pragma unroll
    for (int i = 0; i < 2; ++i) { int R, C; stage_rc(tid * 16 + i * 8192, R, C); const int Rb = Epi::PERM ? ((R & ~31) + perm32(R & 31)) : R;
        voffA[i] = (unsigned)(R * g.lda + C) * 2u; voffB[i] = (unsigned)(Rb * g.ldb + C) * 2u; }
    const size_t kstep = (size_t)(BK * 2);
    const size_t hstep = (size_t)HALF * g.ldb * 2;
    const size_t tstep = 2 * hstep;
    const size_t hstepA = (size_t)HALF * g.lda * 2, tstepA = 2 * hstepA;
    const unsigned ldsw = (unsigned)wid * 1024u;
    const int aoff = lds_byte(wr * 64 + fr, fq * 8), boff = lds_byte(wc * 32 + fr, fq * 8);
#define PG8_SA(b, h) (((b) * 2 + (h)) * HTB)
#define PG8_SB(b, h) ((4 + (b) * 2 + (h)) * HTB)
#define PG8_STAGE(bufoff, gbase, voff) do { _Pragma("unroll") for (int _i = 0; _i < 2; ++_i) \
        __builtin_amdgcn_global_load_lds((const unsigned*)((const char*)(gbase) + (voff)[_i]), (PG8_LAS unsigned*)(lds + (bufoff) + ldsw + _i * 8192), 16, 0, 0); } while (0)
#define PG8_LDA(dst, b, h) do { _Pragma("unroll") for (int m = 0; m < 4; ++m) _Pragma("unroll") for (int k = 0; k < 2; ++k) dst[m][k] = *(const PG8_LAS bf16x8*)(lds + PG8_SA(b, h) + aoff + m * 2048 + k * 1024); } while (0)
#define PG8_LDB(dst, b, h) do { _Pragma("unroll") for (int n = 0; n < 2; ++n) _Pragma("unroll") for (int k = 0; k < 2; ++k) dst[n][k] = *(const PG8_LAS bf16x8*)(lds + PG8_SB(b, h) + boff + n * 2048 + k * 1024); } while (0)
#define PG8_MMA(ai, bj, At, Bt) do { __builtin_amdgcn_s_setprio(1); _Pragma("unroll") for (int m = 0; m < 4; ++m) _Pragma("unroll") for (int n = 0; n < 2; ++n) _Pragma("unroll") for (int k = 0; k < 2; ++k) \
        acc[ai][bj][m][n] = __builtin_amdgcn_mfma_f32_16x16x32_bf16(Bt[n][k], At[m][k], acc[ai][bj][m][n], 0, 0, 0); __builtin_amdgcn_s_setprio(0); } while (0)
#define PG8_WAIT_V(n) asm volatile("s_waitcnt vmcnt(" #n ")" ::: "memory")
#define PG8_WAIT_L(n) asm volatile("s_waitcnt lgkmcnt(" #n ")" ::: "memory")
#define PG8_BAR __builtin_amdgcn_s_barrier()
#define PG8_SCHED __builtin_amdgcn_sched_barrier(0)
    Unit cur, nxt; int ui = 0;
    if (!S.next(0, cur)) return;
    f32x4 acc[2][2][4][2];
#pragma unroll
    for (int a = 0; a < 2; ++a)
#pragma unroll
        for (int b = 0; b < 2; ++b)
#pragma unroll
            for (int m = 0; m < 4; ++m)
#pragma unroll
                for (int n = 0; n < 2; ++n) acc[a][b][m][n] = (f32x4){0.f, 0.f, 0.f, 0.f};
    bf16x8 At[4][2], B0[2][2], B1[2][2];
    const char* cA = (const char*)g.A + (size_t)cur.pm * tstepA; const char* cB = (const char*)g.Bt + (size_t)cur.pn * tstep;
    S.a_ready(cur);
    if constexpr (SP2) {
        PG8_STAGE(PG8_SB(0, 0), cB, voffB); PG8_STAGE(PG8_SB(0, 1), cB + hstep, voffB); PG8_STAGE(PG8_SA(0, 0), cA, voffA); PG8_STAGE(PG8_SA(0, 1), cA + hstepA, voffA);
        if (wr == 1) PG8_BAR;
        PG8_WAIT_V(2); PG8_BAR;
        PG8_STAGE(PG8_SB(1, 0), cB + kstep, voffB); PG8_STAGE(PG8_SA(1, 0), cA + kstep, voffA); PG8_STAGE(PG8_SB(1, 1), cB + hstep + kstep, voffB);
        PG8_WAIT_V(6); PG8_BAR;
    } else {
        PG8_STAGE(PG8_SB(0, 0), cB, voffB); PG8_STAGE(PG8_SA(0, 0), cA, voffA); PG8_STAGE(PG8_SB(0, 1), cB + hstep, voffB); PG8_STAGE(PG8_SA(0, 1), cA + hstepA, voffA);
        if (wr == 1) PG8_BAR;
        PG8_WAIT_V(4); PG8_BAR;
        PG8_STAGE(PG8_SB(1, 0), cB + kstep, voffB); PG8_STAGE(PG8_SA(1, 0), cA + kstep, voffA); PG8_STAGE(PG8_SB(1, 1), cB + hstep + kstep, voffB);
        PG8_WAIT_V(6); PG8_BAR;
    }
    for (;;) {
        const bool has_next = S.next(ui + 1, nxt);
        const char* nA = has_next ? (const char*)g.A + (size_t)nxt.pm * tstepA : cA; const char* nB = has_next ? (const char*)g.Bt + (size_t)nxt.pn * tstep : cB;
        for (int t = 0; t < nt; t += 2) {
            const bool last = (t == nt - 2);
            const char* a1 = cA + (size_t)(t + 1) * kstep;
            const char* a2 = last ? nA : cA + (size_t)(t + 2) * kstep; const char* b2 = last ? nB : cB + (size_t)(t + 2) * kstep;
            const char* a3 = a2 + kstep; const char* b3 = b2 + kstep;
            if (last && has_next) S.a_ready(nxt);
            if constexpr (SP2) {
            PG8_LDB(B0, 0, 0); PG8_LDB(B1, 0, 1); PG8_SCHED; PG8_LDA(At, 0, 0); PG8_STAGE(PG8_SA(1, 1), a1 + hstepA, voffA);
            PG8_WAIT_V(8); PG8_WAIT_L(0); PG8_BAR; PG8_MMA(0, 0, At, B0); PG8_MMA(0, 1, At, B1); PG8_BAR; PG8_SCHED;
            PG8_LDA(At, 0, 1); PG8_STAGE(PG8_SB(0, 0), b2, voffB); PG8_STAGE(PG8_SB(0, 1), b2 + hstep, voffB); PG8_STAGE(PG8_SA(0, 0), a2, voffA);
            PG8_WAIT_V(8); PG8_WAIT_L(0); PG8_BAR; PG8_MMA(1, 0, At, B0); PG8_MMA(1, 1, At, B1); PG8_BAR; PG8_SCHED;
            PG8_LDB(B0, 1, 0); PG8_LDB(B1, 1, 1); PG8_SCHED; PG8_LDA(At, 1, 0); PG8_STAGE(PG8_SA(0, 1), a2 + hstepA, voffA);
            PG8_WAIT_V(8); PG8_WAIT_L(0); PG8_BAR; PG8_MMA(0, 0, At, B0); PG8_MMA(0, 1, At, B1); PG8_BAR; PG8_SCHED;
            PG8_LDA(At, 1, 1); PG8_STAGE(PG8_SB(1, 0), b3, voffB); PG8_STAGE(PG8_SB(1, 1), b3 + hstep, voffB); PG8_STAGE(PG8_SA(1, 0), a3, voffA);
            PG8_WAIT_V(8); PG8_WAIT_L(0); PG8_BAR; PG8_MMA(1, 0, At, B0); PG8_MMA(1, 1, At, B1); PG8_BAR; PG8_SCHED;
            } else {
            PG8_LDB(B0, 0, 0); PG8_SCHED; PG8_LDA(At, 0, 0); PG8_STAGE(PG8_SA(1, 1), a1 + hstepA, voffA);
            PG8_WAIT_L(8); PG8_BAR; PG8_WAIT_L(0); PG8_MMA(0, 0, At, B0); PG8_BAR; PG8_SCHED;
            PG8_LDB(B1, 0, 1); PG8_STAGE(PG8_SB(0, 0), b2, voffB);
            PG8_BAR; PG8_WAIT_L(0); PG8_MMA(0, 1, At, B1); PG8_BAR;
            PG8_LDA(At, 0, 1); PG8_STAGE(PG8_SA(0, 0), a2, voffA);
            PG8_BAR; PG8_WAIT_L(0); PG8_MMA(1, 0, At, B0); PG8_BAR; PG8_SCHED;
            PG8_STAGE(PG8_SB(0, 1), b2 + hstep, voffB);
            PG8_WAIT_V(6); PG8_BAR; PG8_MMA(1, 1, At, B1); PG8_BAR;
            PG8_LDB(B0, 1, 0); PG8_SCHED; PG8_LDA(At, 1, 0); PG8_STAGE(PG8_SA(0, 1), a2 + hstepA, voffA);
            PG8_WAIT_L(8); PG8_BAR; PG8_WAIT_L(0); PG8_MMA(0, 0, At, B0); PG8_BAR; PG8_SCHED;
            PG8_LDB(B1, 1, 1); PG8_STAGE(PG8_SB(1, 0), b3, voffB);
            PG8_BAR; PG8_WAIT_L(0); PG8_MMA(0, 1, At, B1); PG8_BAR;
            PG8_LDA(At, 1, 1); PG8_STAGE(PG8_SA(1, 0), a3, voffA);
            PG8_BAR; PG8_WAIT_L(0); PG8_MMA(1, 0, At, B0); PG8_BAR; PG8_SCHED;
            PG8_STAGE(PG8_SB(1, 1), b3 + hstep, voffB);
            PG8_WAIT_V(6); PG8_BAR; PG8_MMA(1, 1, At, B1); PG8_BAR;
            }
        }
        if constexpr (ALIGN_EPI) { if (wr == 0) PG8_BAR; }
        if constexpr (!Epi::AFTER_DRAIN) { E(acc, cur, wr, wc, fr, fq); S.done(cur); }
        if (!has_next) break;
#pragma unroll
        for (int a = 0; a < 2; ++a)
#pragma unroll
            for (int b = 0; b < 2; ++b)
#pragma unroll
                for (int m = 0; m < 4; ++m)
#pragma unroll
                    for (int n = 0; n < 2; ++n) acc[a][b][m][n] = (f32x4){0.f, 0.f, 0.f, 0.f};
        cur = nxt; cA = nA; cB = nB; ++ui;
        if constexpr (ALIGN_EPI) { if (wr == 1) PG8_BAR; }
    }
    PG8_WAIT_V(0);
    if constexpr (!ALIGN_EPI) { if (wr == 0) PG8_BAR; }
    PG8_BAR;
    if constexpr (Epi::AFTER_DRAIN) { E.fused(acc, cur, wr, wc, fr, fq, lds, wid, lane); S.done(cur); }
#undef PG8_SA
#undef PG8_SB
#undef PG8_STAGE
#undef PG8_LDA
#undef PG8_LDB
#undef PG8_MMA
#undef PG8_WAIT_V
#undef PG8_WAIT_L
#undef PG8_BAR
#undef PG8_SCHED
}
}

#define LAS __attribute__((address_space(3)))
typedef unsigned short bf16_t;
typedef short bf16x8 __attribute__((ext_vector_type(8)));
typedef short s16x4 __attribute__((ext_vector_type(4)));
typedef float f32x4 __attribute__((ext_vector_type(4)));
typedef float f32x16 __attribute__((ext_vector_type(16)));
typedef unsigned u32x4 __attribute__((ext_vector_type(4)));
typedef unsigned u32x2 __attribute__((ext_vector_type(2)));
typedef float f32x2_t __attribute__((ext_vector_type(2)));
typedef __bf16 bf16x2_t __attribute__((ext_vector_type(2)));
__device__ __forceinline__ unsigned pk2(float lo, float hi) { f32x2_t v = {lo, hi}; bf16x2_t b = __builtin_convertvector(v, bf16x2_t); return __builtin_bit_cast(unsigned, b); }
__device__ __forceinline__ float bf_lo(unsigned w) { return __uint_as_float(w << 16); }
__device__ __forceinline__ float bf_hi(unsigned w) { return __uint_as_float(w & 0xffff0000u); }
__device__ __forceinline__ float wave_sum(float v) {
#pragma unroll
    for (int o = 1; o < 64; o <<= 1) v += __shfl_xor(v, o);
    return v;
}
__device__ __forceinline__ float rinv_row(const float* rpart, int row) {
    const f32x4* rp = (const f32x4*)(rpart + (size_t)row * 16);
    const f32x4 a = rp[0], b = rp[1], c = rp[2], d = rp[3];
    const float s = ((a[0] + a[1]) + (a[2] + a[3])) + ((b[0] + b[1]) + (b[2] + b[3])) + ((c[0] + c[1]) + (c[2] + c[3])) + ((d[0] + d[1]) + (d[2] + d[3]));
    return 1.0f / sqrtf(s * (1.0f / 1024.0f) + EPS);
}

constexpr size_t MiB = 1u << 20;
constexpr size_t WS_QKM = 0;
constexpr size_t WS_BAR = 65536;
constexpr size_t WS_RPART = 1 * MiB;
constexpr size_t WS_LF = 3 * MiB;
constexpr size_t WS_C2P = 5 * MiB;
constexpr size_t WS_C2S = 7 * MiB;
constexpr size_t WS_WF = 9 * MiB;
constexpr size_t WS_W = 10 * MiB;
constexpr size_t W_CIN = WS_W, W_COUT = WS_W + 12 * MiB, W_FIN = WS_W + 16 * MiB, W_FO = WS_W + 28 * MiB, W_1 = WS_W + 32 * MiB, W_2 = WS_W + 64 * MiB;
constexpr size_t WS_XF = 110 * MiB;
constexpr size_t WS_XB = 175 * MiB;
constexpr size_t WS_A2 = 208 * MiB;
constexpr size_t WS_OV = 241 * MiB;
constexpr size_t WS_Q = WS_OV, WS_K = WS_OV + 33 * MiB, WS_V = WS_OV + 99 * MiB;
constexpr size_t WS_END = WS_OV + 166 * MiB;

constexpr size_t O_Y = 0, O_PCONV = 17039360, O_PK = 17043456, O_PV = 50597888, O_PLF = 84152320, O_SCONV = 84676608, O_SK = 84709376, O_SV = 85233664, O_SLF = 85757952;

constexpr int WLDS = 17408;
constexpr int LDS_CTL = 8 * WLDS;
constexpr int LDS_BYTES = 8 * WLDS + 256;

struct Args { const float* in[17]; float* out; unsigned char* ws; int lo, hi; };

__device__ __forceinline__ int crow(int r, int hi) { return (r & 3) + 8 * (r >> 2) + 4 * hi; }
__device__ __forceinline__ void glds16(const void* gsrc, unsigned lds_dst) { unsigned keep;
    asm volatile("s_mov_b32 %0, m0\n\ts_mov_b32 m0, %2\n\ts_nop 0\n\tglobal_load_lds_dwordx4 %1, off\n\ts_mov_b32 m0, %0" : "=&s"(keep) : "v"(gsrc), "s"(lds_dst) : "memory"); }
__device__ __forceinline__ void glds4(const void* gsrc, unsigned lds_dst) { unsigned keep;
    asm volatile("s_mov_b32 %0, m0\n\ts_mov_b32 m0, %2\n\ts_nop 0\n\tglobal_load_lds_dword %1, off\n\ts_mov_b32 m0, %0" : "=&s"(keep) : "v"(gsrc), "s"(lds_dst) : "memory"); }
#define SBAR() __builtin_amdgcn_sched_barrier(0)
struct VFrag { s16x4 lo[8], hi[8]; };
template <int d0> __device__ __forceinline__ void pv_reads(VFrag& f, int vb) {
#pragma unroll
        for (int ks = 0; ks < 4; ++ks) {
            asm volatile("ds_read_b64_tr_b16 %0,%1 offset:%c2" : "=&v"(f.lo[d0 * 4 + ks]) : "v"(vb), "i"(d0 * 4096 + ks * 1024) : "memory");
            asm volatile("ds_read_b64_tr_b16 %0,%1 offset:%c2" : "=&v"(f.hi[d0 * 4 + ks]) : "v"(vb), "i"(d0 * 4096 + ks * 1024 + 512) : "memory"); }
}
__device__ __forceinline__ void pv_mfma(f32x16* o, VFrag& f, bf16x8 pa0, bf16x8 pa1, bf16x8 pa2, bf16x8 pa3) {
    asm volatile("s_waitcnt lgkmcnt(0)" : "+v"(f.lo[0]), "+v"(f.lo[1]), "+v"(f.lo[2]), "+v"(f.lo[3]), "+v"(f.lo[4]), "+v"(f.lo[5]), "+v"(f.lo[6]), "+v"(f.lo[7]),
                 "+v"(f.hi[0]), "+v"(f.hi[1]), "+v"(f.hi[2]), "+v"(f.hi[3]), "+v"(f.hi[4]), "+v"(f.hi[5]), "+v"(f.hi[6]), "+v"(f.hi[7]) :: "memory");
#define PK(k) (bf16x8){f.lo[k][0], f.lo[k][1], f.lo[k][2], f.lo[k][3], f.hi[k][0], f.hi[k][1], f.hi[k][2], f.hi[k][3]}
    o[0] = __builtin_amdgcn_mfma_f32_32x32x16_bf16(pa0, PK(0), o[0], 0, 0, 0);
    o[1] = __builtin_amdgcn_mfma_f32_32x32x16_bf16(pa0, PK(4), o[1], 0, 0, 0);
    o[0] = __builtin_amdgcn_mfma_f32_32x32x16_bf16(pa1, PK(1), o[0], 0, 0, 0);
    o[1] = __builtin_amdgcn_mfma_f32_32x32x16_bf16(pa1, PK(5), o[1], 0, 0, 0);
    o[0] = __builtin_amdgcn_mfma_f32_32x32x16_bf16(pa2, PK(2), o[0], 0, 0, 0);
    o[1] = __builtin_amdgcn_mfma_f32_32x32x16_bf16(pa2, PK(6), o[1], 0, 0, 0);
    o[0] = __builtin_amdgcn_mfma_f32_32x32x16_bf16(pa3, PK(3), o[0], 0, 0, 0);
    o[1] = __builtin_amdgcn_mfma_f32_32x32x16_bf16(pa3, PK(7), o[1], 0, 0, 0);
#undef PK
}
constexpr int ANS = 4;
constexpr int A_K = 0, A_V = ANS * 8192, A_C = 2 * ANS * 8192, A_WSF = A_C + ANS * 2048, A_OST = A_WSF + 2048, A_END = A_OST + 8 * 4096;
static_assert(A_END <= 8 * WLDS, "attention LDS map");
__device__ __forceinline__ void attn_unit(LAS unsigned char* sh, const bf16_t* Qb, const bf16_t* __restrict__ Kb, const bf16_t* __restrict__ Vb, bf16_t* Ob,
                                          const float* __restrict__ c2seq, long qrow0, long kvbase, int p0, int nrows, int h, float TH, float CS1, int lane, int wave) {
    const int r32 = lane & 31, hi = lane >> 5;
    const unsigned lbase = (unsigned)(uintptr_t)sh;
    const bool active = wave * 32 < nrows;
    const int pw = p0 + 32 * wave;
    bf16x8 qr[4];
    { const bf16_t* Qw = Qb + (qrow0 + (active ? wave * 32 : 0) + r32) * D + h * 64;
#pragma unroll
      for (int d0 = 0; d0 < 4; ++d0) qr[d0] = *(const bf16x8*)(Qw + d0 * 16 + hi * 8); }
    const int plast = p0 + nrows - 1, tl_u = plast >> 6, tl_w = (pw + 31) >> 6;
    float cref = c2seq[p0];
    float crefw = c2seq[active ? pw : p0];
    float cv0; { const int t = tl_u - lane; int idx = 64 * t + 63; idx = idx > plast ? plast : idx; cv0 = c2seq[idx < 0 ? 0 : idx]; }
    asm volatile("" : "+v"(cref), "+v"(crefw), "+v"(cv0), "+v"(qr[0]), "+v"(qr[1]), "+v"(qr[2]), "+v"(qr[3]));
    int tstart = 0;
    for (int tb = tl_u; tb >= 0; tb -= 64) {
        const int t = tb - lane; int idx = 64 * t + 63; idx = idx > plast ? plast : idx;
        const float cv = (tb == tl_u) ? cv0 : ((t >= 0) ? c2seq[idx] : 0.f);
        const bool skip = (t >= 0) && (cref - cv < -TH);
        const unsigned long long bal = __ballot(skip);
        if (bal) { tstart = tb - (__ffsll((long long)bal) - 1) + 1; break; }
    }
    tstart = __builtin_amdgcn_readfirstlane(tstart);
    const int n = tl_u - tstart + 1;
    const bf16_t* ksrc = Kb + (kvbase + lane) * D + h * 64 + wave * 8;
    const bf16_t* vsrc = Vb + (kvbase + 16 * (wave & 3) + (lane >> 2)) * D + h * 64 + (wave >> 2) * 32 + (lane & 3) * 8;
    const float* csrc = c2seq + lane;
#define ISSUE(i_) do { const int t_ = tl_u - (i_), sl_ = (i_) & (ANS - 1); \
    glds16(ksrc + (long)t_ * 64 * D, lbase + A_K + sl_ * 8192 + wave * 1024); \
    glds16(vsrc + (long)t_ * 64 * D, lbase + A_V + sl_ * 8192 + wave * 1024); \
    glds4(csrc + t_ * 64, lbase + A_C + sl_ * 2048 + wave * 256); } while (0)
    float mhat = 0.f, l_reg = 0.f; f32x16 o[2]; o[0] = f32x16{}; o[1] = f32x16{};
    float mmin = -INFINITY;
    bool wdone = false;
    LAS float* wsf = (LAS float*)(sh + A_WSF + wave * 256);
    const int vb0 = (int)(lbase + A_V) + ((lane >> 4) & 1) * 32 + (lane & 3) * 8 + (4 * hi + ((lane & 15) >> 2)) * 64;
    const LAS unsigned char* kb0 = sh + A_K + hi * 1024 + r32 * 16;
    asm volatile("" : "+v"(qr[0]), "+v"(qr[1]), "+v"(qr[2]), "+v"(qr[3]));
    if (0 < n) ISSUE(0);
    if (1 < n) ISSUE(1);
    if (2 < n) ISSUE(2);
    for (int i = 0; i < n; ++i) {
        const int rem = n - 1 - i;
        if (rem >= 2) asm volatile("s_waitcnt vmcnt(6)" ::: "memory"); else if (rem == 1) asm volatile("s_waitcnt vmcnt(3)" ::: "memory"); else asm volatile("s_waitcnt vmcnt(0)" ::: "memory");
        asm volatile("s_waitcnt lgkmcnt(0)\n\ts_barrier" ::: "memory");
        if (i + 3 < n) ISSUE(i + 3);
        const int t = tl_u - i, sl = i & (ANS - 1);
        const LAS unsigned char* cp = sh + A_C + sl * 2048 + wave * 256;
        if (active && t < tl_w && !wdone) { const float cend = *(const LAS float*)(cp + 63 * 4); if (crefw - cend < -TH || (cref - cend) + CS1 - mmin < -152.0f) wdone = true; }
        if (active && t <= tl_w && !wdone) {
            f32x16 p0v, p1v;
            const LAS unsigned char* kbp = kb0 + sl * 8192;
            bf16x8 kf[8];
#pragma unroll
            for (int d0 = 0; d0 < 4; ++d0) { kf[2 * d0] = *(const LAS bf16x8*)(kbp + d0 * 2048); kf[2 * d0 + 1] = *(const LAS bf16x8*)(kbp + d0 * 2048 + 512); }
            { const float X = cref - mhat;
#pragma unroll
              for (int g = 0; g < 4; ++g) {
                  const f32x4 ca = *(const LAS f32x4*)(cp + (8 * g + 4 * hi) * 4), cb = *(const LAS f32x4*)(cp + (32 + 8 * g + 4 * hi) * 4);
#pragma unroll
                  for (int e = 0; e < 4; ++e) { p0v[4 * g + e] = X - ca[e]; p1v[4 * g + e] = X - cb[e]; }
              } }
            asm volatile("" : "+v"(kf[0]), "+v"(kf[1]), "+v"(kf[2]), "+v"(kf[3]), "+v"(kf[4]), "+v"(kf[5]), "+v"(kf[6]), "+v"(kf[7]));
#pragma unroll
            for (int d0 = 0; d0 < 4; ++d0) {
                p0v = __builtin_amdgcn_mfma_f32_32x32x16_bf16(kf[2 * d0], qr[d0], p0v, 0, 0, 0);
                p1v = __builtin_amdgcn_mfma_f32_32x32x16_bf16(kf[2 * d0 + 1], qr[d0], p1v, 0, 0, 0);
            }
            if (t == tl_w) {
                const int qpos = pw + r32, kq = 64 * t + 4 * hi;
#pragma unroll
                for (int r = 0; r < 16; ++r) { const int kv = kq + (r & 3) + 8 * (r >> 2); if (kv > qpos) p0v[r] = -INFINITY; if (kv + 32 > qpos) p1v[r] = -INFINITY; }
            }
            float rm, rm2;
            { float a_ = __builtin_fmaxf(__builtin_fmaxf(p0v[0], p0v[1]), p1v[0]), b_ = __builtin_fmaxf(__builtin_fmaxf(p0v[2], p0v[3]), p1v[1]); a_ = __builtin_fmaxf(__builtin_fmaxf(a_, p1v[2]), p1v[3]);
#pragma unroll
              for (int r = 4; r < 16; r += 4) { a_ = __builtin_fmaxf(__builtin_fmaxf(a_, p0v[r]), p0v[r + 1]); b_ = __builtin_fmaxf(__builtin_fmaxf(b_, p0v[r + 2]), p0v[r + 3]); a_ = __builtin_fmaxf(__builtin_fmaxf(a_, p1v[r]), p1v[r + 1]); b_ = __builtin_fmaxf(__builtin_fmaxf(b_, p1v[r + 2]), p1v[r + 3]); }
              rm = __builtin_fmaxf(a_, b_); rm2 = rm; (void)rm2; }
            { auto rr = __builtin_amdgcn_permlane32_swap(__float_as_uint(rm), __float_as_uint(rm), false, false); rm = fmaxf(__uint_as_float(rr[0]), __uint_as_float(rr[1])); }
            if (t == tl_w) {
                mhat = rm;
                { float mm = mhat; mm = fminf(mm, __shfl_xor(mm, 1)); mm = fminf(mm, __shfl_xor(mm, 2)); mm = fminf(mm, __shfl_xor(mm, 4)); mm = fminf(mm, __shfl_xor(mm, 8)); mm = fminf(mm, __shfl_xor(mm, 16)); mmin = mm; }
#pragma unroll
                for (int r = 0; r < 16; ++r) { p0v[r] -= rm; p1v[r] -= rm; }
            } else if (__any(rm > 4.0f)) {
                const float dl = fmaxf(rm, 0.f); mhat += dl;
                { float mm = mhat; mm = fminf(mm, __shfl_xor(mm, 1)); mm = fminf(mm, __shfl_xor(mm, 2)); mm = fminf(mm, __shfl_xor(mm, 4)); mm = fminf(mm, __shfl_xor(mm, 8)); mm = fminf(mm, __shfl_xor(mm, 16)); mmin = mm; }
#pragma unroll
                for (int r = 0; r < 16; ++r) { p0v[r] -= dl; p1v[r] -= dl; }
                const float f = __builtin_amdgcn_exp2f(-dl); l_reg *= f;
                if (hi == 0) wsf[r32] = f;
                asm volatile("s_waitcnt lgkmcnt(0)" ::: "memory");
#pragma unroll
                for (int r = 0; r < 16; ++r) { const float fr_ = wsf[crow(r, hi)]; o[0][r] *= fr_; o[1][r] *= fr_; }
                asm volatile("s_waitcnt lgkmcnt(0)" ::: "memory");
            }
            float sacc = 0.f;
#pragma unroll
            for (int r = 0; r < 16; ++r) { p0v[r] = __builtin_amdgcn_exp2f(p0v[r]); p1v[r] = __builtin_amdgcn_exp2f(p1v[r]); sacc += p0v[r] + p1v[r]; }
            l_reg += sacc;
            VFrag vf; pv_reads<0>(vf, vb0 + sl * 8192); pv_reads<1>(vf, vb0 + sl * 8192);
            u32x4 pw0, pw1, pw2, pw3;
            pw0 = (u32x4){pk2(p0v[0], p0v[1]), pk2(p0v[2], p0v[3]), pk2(p0v[4], p0v[5]), pk2(p0v[6], p0v[7])};
            pw1 = (u32x4){pk2(p0v[8], p0v[9]), pk2(p0v[10], p0v[11]), pk2(p0v[12], p0v[13]), pk2(p0v[14], p0v[15])};
            pw2 = (u32x4){pk2(p1v[0], p1v[1]), pk2(p1v[2], p1v[3]), pk2(p1v[4], p1v[5]), pk2(p1v[6], p1v[7])};
            pw3 = (u32x4){pk2(p1v[8], p1v[9]), pk2(p1v[10], p1v[11]), pk2(p1v[12], p1v[13]), pk2(p1v[14], p1v[15])};
            pv_mfma(o, vf, __builtin_bit_cast(bf16x8, pw0), __builtin_bit_cast(bf16x8, pw1), __builtin_bit_cast(bf16x8, pw2), __builtin_bit_cast(bf16x8, pw3));
        }
    }
#undef ISSUE
    if (active) {
        { auto rr = __builtin_amdgcn_permlane32_swap(__float_as_uint(l_reg), __float_as_uint(l_reg), false, false); l_reg = __uint_as_float(rr[0]) + __uint_as_float(rr[1]); }
        if (hi == 0) wsf[32 + r32] = l_reg;
        asm volatile("s_waitcnt lgkmcnt(0)" ::: "memory");
        float rli[16];
#pragma unroll
        for (int r = 0; r < 16; ++r) rli[r] = __builtin_amdgcn_rcpf(wsf[32 + crow(r, hi)]);
        LAS bf16_t* stg = (LAS bf16_t*)(sh + A_OST + wave * 4096);
#pragma unroll
        for (int r = 0; r < 16; ++r) { const int orow = crow(r, hi);
#pragma unroll
            for (int d0 = 0; d0 < 2; ++d0) stg[orow * 64 + d0 * 32 + r32] = (bf16_t)(pk2(o[d0][r] * rli[r], 0.f) & 0xffffu); }
        asm volatile("s_waitcnt lgkmcnt(0)" ::: "memory");
        bf16_t* Ow = Ob + (qrow0 + wave * 32) * D + h * 64;
#pragma unroll
        for (int i = 0; i < 4; ++i) { const int row = i * 8 + (lane >> 3), ch = lane & 7; const u32x4 v = *(const LAS u32x4*)(stg + row * 64 + ch * 8); *(u32x4*)(Ow + (long)row * D + ch * 8) = v; }
    }
    asm volatile("s_waitcnt lgkmcnt(0)\n\ts_barrier" ::: "memory");
}

__device__ __forceinline__ void transpose_item(const float* W, int K, int N, int ldw, const float* g, bf16_t* WT, LAS float* scr, int item, int lane, int ldo = 0) {
    if (ldo == 0) ldo = K;
    const int nblk = N / 32, kb = item / nblk, nb = item % nblk, k0 = 64 * kb, n0 = 32 * nb;
    float tv[32];
#pragma unroll
    for (int i = 0; i < 32; ++i) tv[i] = W[(size_t)(k0 + 2 * i + (lane >> 5)) * ldw + n0 + (lane & 31)];
#pragma unroll
    for (int i = 0; i < 32; ++i) scr[(2 * i + (lane >> 5)) * 33 + (lane & 31)] = tv[i];
    asm volatile("s_waitcnt lgkmcnt(0)" ::: "memory");
    const int c = lane & 7;
    float gv[8];
#pragma unroll
    for (int e = 0; e < 8; ++e) gv[e] = g ? g[k0 + 8 * c + e] : 1.0f;
#pragma unroll
    for (int j = 0; j < 4; ++j) { const int n = (lane >> 3) + 8 * j; const LAS float* s = scr + (8 * c) * 33 + n;
        u32x4 o; o.x = pk2(s[0 * 33] * gv[0], s[1 * 33] * gv[1]); o.y = pk2(s[2 * 33] * gv[2], s[3 * 33] * gv[3]); o.z = pk2(s[4 * 33] * gv[4], s[5 * 33] * gv[5]); o.w = pk2(s[6 * 33] * gv[6], s[7 * 33] * gv[7]);
        *(u32x4*)(WT + (size_t)(n0 + n) * ldo + k0 + 8 * c) = o; }
    asm volatile("s_waitcnt lgkmcnt(0)" ::: "memory");
}


__device__ __forceinline__ void epi_small(const pg8::EpiG& E, int row, int col, f32x4 v, int lane, float r, const float* xinS) {
    if (E.mode == 2) {
        const u32x2 pw = *(const u32x2*)(E.Xb + (size_t)row * 1024 + col);
        f32x4 x = {__uint_as_float(pw.x << 16), __uint_as_float(pw.x & 0xffff0000u), __uint_as_float(pw.y << 16), __uint_as_float(pw.y & 0xffff0000u)};
        x += v; if (E.Xf) *(f32x4*)(E.Xf + (size_t)row * 1024 + col) = x;
        u32x2 w; w.x = pk2(x[0], x[1]); w.y = pk2(x[2], x[3]); *(u32x2*)(E.Xb + (size_t)row * 1024 + col) = w;
        float ss = (x[0] * x[0] + x[1] * x[1]) + (x[2] * x[2] + x[3] * x[3]);
        ss += __shfl_xor(ss, 1); ss += __shfl_xor(ss, 2); ss += __shfl_xor(ss, 4); ss += __shfl_xor(ss, 8);
        if ((lane & 15) == 0) E.rpart_out[(size_t)row * 16 + (col >> 6)] = ss;
        return;
    }
    v = v * r;
    if (E.mode == 0 || E.mode == 3) {
        if (E.mode == 3) {
#pragma unroll
            for (int e = 0; e < 4; ++e) { const float a0 = fmaxf(v[e], 0.f); v[e] = a0 * a0; } }
        u32x2 w; w.x = pk2(v[0], v[1]); w.y = pk2(v[2], v[3]); *(u32x2*)(E.O + (size_t)row * E.ldc + col) = w;
        return;
    }
    const int t = col >> 10, cq = col & 1023, sr = row - SEQ;
    if (t < 2) {
        float s = (v[0] * v[0] + v[1] * v[1]) + (v[2] * v[2] + v[3] * v[3]);
        s += __shfl_xor(s, 1); s += __shfl_xor(s, 2); s += __shfl_xor(s, 4); s += __shfl_xor(s, 8);
        if ((lane & 15) == 0) atomicMax(E.qkm + (t == 0 ? 80 : 64) + (cq >> 6), __float_as_uint(s));
    }
    if (t == 0) { v = v * QC2; u32x2 w; w.x = pk2(v[0], v[1]); w.y = pk2(v[2], v[3]); *(u32x2*)(E.Qb + (size_t)row * 1024 + cq) = w; }
    else {
        const size_t kvrow = (size_t)(SEQ + (sr >> 5) * LSP + PAST + (sr & 31));
        u32x2 w; w.x = pk2(v[0], v[1]); w.y = pk2(v[2], v[3]); *(u32x2*)((t == 1 ? E.Kb : E.Vb) + kvrow * 1024 + cq) = w;
        *(f32x4*)((t == 1 ? E.outKs : E.outVs) + (size_t)sr * 1024 + cq) = v;
    }
}
__device__ __forceinline__ void small_gemm(LAS unsigned char* lds, const bf16_t* A, int lda, const bf16_t* Bt, int ldb, int N, int K, const pg8::EpiG& E, int vcu, int G, int tid, int wave, const float* xinS) {
    const int lane = tid & 63, r32 = lane & 31, hi = lane >> 5, lrow = lane >> 3, lpc = lane & 7;
    LAS float* red = (LAS float*)lds;
    LAS unsigned char* stg = lds + wave * 13824;
    const int ntile = 8 * (N >> 6), kw = K >> 3;
    for (int tile = vcu; tile < ntile; tile += G) {
        const int rb = tile & 7, cb = tile >> 3;
        const bf16_t* ag = A + (size_t)(SEQ + rb * 32 + lrow) * lda + wave * kw + lpc * 8;
        const bf16_t* bg = Bt + (size_t)(cb * 64 + lrow) * ldb + wave * kw + lpc * 8;
        f32x16 c0 = f32x16{}, c1 = f32x16{};
        const float rrow = (E.mode == 2) ? 1.0f : rinv_row(E.rpart_in, SEQ + rb * 32 + (tid >> 4));
        for (int k0 = 0; k0 < kw; k0 += 128) {
            u32x4 ra[2][4], rv[2][8];
#pragma unroll
            for (int sb = 0; sb < 2; ++sb) {
#pragma unroll
                for (int i = 0; i < 4; ++i) ra[sb][i] = *(const u32x4*)(ag + (size_t)(8 * i) * lda + k0 + sb * 64);
#pragma unroll
                for (int i = 0; i < 8; ++i) rv[sb][i] = *(const u32x4*)(bg + (size_t)(8 * i) * ldb + k0 + sb * 64);
            }
            asm volatile("" : "+v"(ra[0][0]), "+v"(ra[0][1]), "+v"(ra[0][2]), "+v"(ra[0][3]), "+v"(ra[1][0]), "+v"(ra[1][1]), "+v"(ra[1][2]), "+v"(ra[1][3]),
                              "+v"(rv[0][0]), "+v"(rv[0][1]), "+v"(rv[0][2]), "+v"(rv[0][3]), "+v"(rv[0][4]), "+v"(rv[0][5]), "+v"(rv[0][6]), "+v"(rv[0][7]),
                              "+v"(rv[1][0]), "+v"(rv[1][1]), "+v"(rv[1][2]), "+v"(rv[1][3]), "+v"(rv[1][4]), "+v"(rv[1][5]), "+v"(rv[1][6]), "+v"(rv[1][7]));
#pragma unroll
            for (int sb = 0; sb < 2; ++sb) {
#pragma unroll
                for (int i = 0; i < 4; ++i) *(LAS u32x4*)(stg + (8 * i + lrow) * 144 + lpc * 16) = ra[sb][i];
#pragma unroll
                for (int i = 0; i < 8; ++i) *(LAS u32x4*)(stg + 4608 + (8 * i + lrow) * 144 + lpc * 16) = rv[sb][i];
                bf16x8 fa[4], fb0[4], fb1[4];
#pragma unroll
                for (int ks = 0; ks < 4; ++ks) { fa[ks] = *(const LAS bf16x8*)(stg + r32 * 144 + (2 * ks + hi) * 16);
                    fb0[ks] = *(const LAS bf16x8*)(stg + 4608 + r32 * 144 + (2 * ks + hi) * 16); fb1[ks] = *(const LAS bf16x8*)(stg + 4608 + (32 + r32) * 144 + (2 * ks + hi) * 16); }
#pragma unroll
                for (int ks = 0; ks < 4; ++ks) {
                    c0 = __builtin_amdgcn_mfma_f32_32x32x16_bf16(fb0[ks], fa[ks], c0, 0, 0, 0);
                    c1 = __builtin_amdgcn_mfma_f32_32x32x16_bf16(fb1[ks], fa[ks], c1, 0, 0, 0);
                }
            }
        }
        __syncthreads();
        LAS float* wr_ = red + wave * (32 * 68) + r32 * 68 + 4 * hi;
#pragma unroll
        for (int g = 0; g < 4; ++g) {
            *(LAS f32x4*)(wr_ + 8 * g) = (f32x4){c0[4 * g], c0[4 * g + 1], c0[4 * g + 2], c0[4 * g + 3]};
            *(LAS f32x4*)(wr_ + 32 + 8 * g) = (f32x4){c1[4 * g], c1[4 * g + 1], c1[4 * g + 2], c1[4 * g + 3]};
        }
        __syncthreads();
        const int m = tid >> 4, c4 = (tid & 15) * 4;
        f32x4 v = *(const LAS f32x4*)(red + m * 68 + c4);
#pragma unroll
        for (int w = 1; w < 8; ++w) v += *(const LAS f32x4*)(red + w * (32 * 68) + m * 68 + c4);
        epi_small(E, SEQ + rb * 32 + m, cb * 64 + c4, v, lane, rrow, xinS);
        __syncthreads();
    }
}

#define XB_TMO      128
#define XB_XCNT(j)  (256  + 64 * (j))
#define XB_XSUB(j)  (1280 + 64 * (j))
#define XB_XGEN(j)  (2304 + 64 * (j))
#define XB_TOP      3328
#define XB_TOPGEN   3392
#define XCD_BAR_WORDS 3456
#define XB_SPIN_CAP (1u << 18)

__device__ __forceinline__ unsigned xb_ld(unsigned* p)              { return __hip_atomic_load(p, __ATOMIC_RELAXED, __HIP_MEMORY_SCOPE_AGENT); }
__device__ __forceinline__ unsigned xb_add(unsigned* p, unsigned v) { return __hip_atomic_fetch_add(p, v, __ATOMIC_RELAXED, __HIP_MEMORY_SCOPE_AGENT); }
__device__ __forceinline__ unsigned xb_xcc_id() { return (unsigned)__builtin_amdgcn_s_getreg((3 << 11) | 20) & 0xFu; }
#define XB_SPIN(cond, bar) do { unsigned _sp = 0; while (cond) { __builtin_amdgcn_s_sleep(1); \
    if ((++_sp & 255u) == 0u) { if (xb_ld(&(bar)[XB_TMO])) break; if (_sp > XB_SPIN_CAP) { atomicAdd(&(bar)[XB_TMO], 1u); break; } } } } while (0)

struct XcdBarrier {
    unsigned* bar; unsigned x;
    volatile LAS unsigned* st;
};

__device__ __forceinline__ XcdBarrier xcd_barrier_post(unsigned* bar, volatile LAS unsigned* st) {
    XcdBarrier b; b.bar = bar; b.x = xb_xcc_id(); b.st = st;
    if (threadIdx.x == 0) (void)xb_add(&bar[XB_XCNT(b.x)], 1u);
    return b;
}
__device__ __forceinline__ void xcd_barrier_complete(unsigned* bar, unsigned x, unsigned& nloc, unsigned& nx) {
    const unsigned G = gridDim.x * gridDim.y * gridDim.z;
    unsigned sum, cnt, mine, sp = 0u;
    for (;;) {
        sum = 0u; cnt = 0u; mine = 0u;
#pragma unroll
        for (unsigned j = 0; j < 16; ++j) { const unsigned c = xb_ld(&bar[XB_XCNT(j)]); sum += c; cnt += (c > 0u) ? 1u : 0u; mine = (j == x) ? c : mine; }
        if (sum == G) break;
        __builtin_amdgcn_s_sleep(1);
        if ((++sp & 255u) == 0u) { if (xb_ld(&bar[XB_TMO])) break; if (sp > XB_SPIN_CAP) { atomicAdd(&bar[XB_TMO], 1u); break; } }
    }
    nloc = mine > 0u ? mine : 1u; nx = cnt > 0u ? cnt : 1u;
}

__device__ __forceinline__ void xcd_barrier(const XcdBarrier& b) {
    asm volatile("s_waitcnt vmcnt(0)" ::: "memory");
    __syncthreads();
    if (threadIdx.x == 0) {
        unsigned* bar = b.bar;
        __builtin_amdgcn_s_waitcnt(0);
        unsigned nloc = b.st[0], nx = b.st[1];
        if (nloc == 0u) { xcd_barrier_complete(bar, b.x, nloc, nx); b.st[0] = nloc; b.st[1] = nx; }
        const unsigned old = xb_add(&bar[XB_XSUB(b.x)], 1u);
        const unsigned gen = old / nloc;
        if (old + 1u == (gen + 1u) * nloc) {
            __builtin_amdgcn_fence(__ATOMIC_RELEASE, "agent");
            asm volatile("s_waitcnt vmcnt(0)" ::: "memory");
            const unsigned og = xb_add(&bar[XB_TOP], 1u);
            const unsigned tg = og / nx;
            if (og + 1u == (tg + 1u) * nx) xb_add(&bar[XB_TOPGEN], 1u);
            else XB_SPIN(xb_ld(&bar[XB_TOPGEN]) == tg, bar);
            __builtin_amdgcn_fence(__ATOMIC_ACQUIRE, "agent");
            xb_add(&bar[XB_XGEN(b.x)], 1u);
            asm volatile("s_waitcnt vmcnt(0)" ::: "memory");
        } else {
            XB_SPIN(xb_ld(&bar[XB_XGEN(b.x)]) == gen, bar);
            __builtin_amdgcn_fence(__ATOMIC_ACQUIRE, "agent");
            asm volatile("s_waitcnt vmcnt(0)" ::: "memory");
        }
    }
    __syncthreads();
}

#define F1_EXTRAS() do { \
                const bf16_t* Wf = (const bf16_t*)(ws + WS_WF) + (size_t)j * 16 * 1024; \
                const int fr = lane & 15, fq = lane >> 4; \
                for (int grp = gw; grp < M / 16; grp += NGW) { \
                    const int row = grp * 16 + fr; \
                    const bf16_t* xp = Xb + (size_t)row * 1024 + fq * 8; const bf16_t* wp = Wf + (size_t)fr * 1024 + fq * 8; \
                    f32x4 acc = {0.f, 0.f, 0.f, 0.f}; \
                    const float r = rinv_row(rpart, row); \
                    const f32x4 bf = *(const f32x4*)(fox_b_f + j * 16 + 4 * fq); \
                    for (int k0 = 0; k0 < 32; k0 += 8) { \
                        bf16x8 xa[8], wa[8]; \
_Pragma("unroll") \
                        for (int ks = 0; ks < 8; ++ks) { xa[ks] = *(const bf16x8*)(xp + (k0 + ks) * 32); wa[ks] = *(const bf16x8*)(wp + (k0 + ks) * 32); } \
                        asm volatile("" : "+v"(xa[0]), "+v"(xa[1]), "+v"(xa[2]), "+v"(xa[3]), "+v"(xa[4]), "+v"(xa[5]), "+v"(xa[6]), "+v"(xa[7]), \
                                          "+v"(wa[0]), "+v"(wa[1]), "+v"(wa[2]), "+v"(wa[3]), "+v"(wa[4]), "+v"(wa[5]), "+v"(wa[6]), "+v"(wa[7])); \
_Pragma("unroll") \
                        for (int ks = 0; ks < 8; ++ks) acc = __builtin_amdgcn_mfma_f32_16x16x32_bf16(wa[ks], xa[ks], acc, 0, 0, 0); \
                    } \
                    f32x4 lf; \
_Pragma("unroll") \
                    for (int e = 0; e < 4; ++e) { const float x = acc[e] * r + bf[e]; lf[e] = fminf(x, 0.f) - log1pf(expf(-fabsf(x))); } \
                    *(f32x4*)(LF + (size_t)row * 16 + 4 * fq) = lf; \
                    float* op = (row < SEQ) ? out + O_PLF + ((size_t)j * SEQ + row) * 16 : out + O_SLF + ((size_t)j * MS + (row - SEQ)) * 16; \
                    *(f32x4*)(op + 4 * fq) = lf; \
                } \
                { \
                    const float* ck = cache_k + (size_t)j * NSB * PAST * 1024; const float* cv = cache_v + (size_t)j * NSB * PAST * 1024; \
                    float kmax = 0.f; \
                    for (int hr0 = gw; hr0 < NSB * PAST * 2; hr0 += 4 * NGW) { \
                        f32x4 kk[4][2], vv[4][2]; \
_Pragma("unroll") \
                        for (int q = 0; q < 4; ++q) { const int hr = hr0 + q * NGW; const int b = hr >> 12, pos = (hr >> 1) & 2047, half = hr & 1; \
                            const size_t so = ((size_t)(b * PAST + pos)) * 1024 + half * 512 + lane * 8; \
                            kk[q][0] = *(const f32x4*)(ck + so); kk[q][1] = *(const f32x4*)(ck + so + 4); vv[q][0] = *(const f32x4*)(cv + so); vv[q][1] = *(const f32x4*)(cv + so + 4); } \
_Pragma("unroll") \
                        for (int q = 0; q < 4; ++q) { const int hr = hr0 + q * NGW; const int b = hr >> 12, pos = (hr >> 1) & 2047, half = hr & 1; \
                            const size_t dofs = ((size_t)(SEQ + b * LSP + pos)) * 1024 + half * 512 + lane * 8; \
                            const f32x4 k0 = kk[q][0], k1 = kk[q][1], v0 = vv[q][0], v1 = vv[q][1]; \
                            u32x4 w; w.x = pk2(k0[0], k0[1]); w.y = pk2(k0[2], k0[3]); w.z = pk2(k1[0], k1[1]); w.w = pk2(k1[2], k1[3]); \
                            *(u32x4*)(Kb + dofs) = w; \
                            w.x = pk2(v0[0], v0[1]); w.y = pk2(v0[2], v0[3]); w.z = pk2(v1[0], v1[1]); w.w = pk2(v1[2], v1[3]); \
                            *(u32x4*)(Vb + dofs) = w; \
                            float s = (k0[0] * k0[0] + k0[1] * k0[1]) + (k0[2] * k0[2] + k0[3] * k0[3]) + (k1[0] * k1[0] + k1[1] * k1[1]) + (k1[2] * k1[2] + k1[3] * k1[3]); \
                            s += __shfl_xor(s, 1); s += __shfl_xor(s, 2); s += __shfl_xor(s, 4); \
                            kmax = fmaxf(kmax, s); } \
                    } \
                    if ((lane & 7) == 0) atomicMax((unsigned*)(ws + WS_QKM) + j * 128 + 64 + (gw & 1) * 8 + (lane >> 3), __float_as_uint(kmax)); \
                    if (gw < NSB * 32) { \
                        const size_t dofs = ((size_t)(SEQ + (gw >> 5) * LSP + PAST + TS + (gw & 31))) * 1024 + lane * 16; \
                        const u32x4 z = {0u, 0u, 0u, 0u}; \
                        *(u32x4*)(Kb + dofs) = z; *(u32x4*)(Kb + dofs + 8) = z; *(u32x4*)(Vb + dofs) = z; *(u32x4*)(Vb + dofs + 8) = z; \
                    } \
                } \
} while (0)

template <bool COOP>
__global__ void __launch_bounds__(512, 2) fwd(Args a) {
    extern __shared__ __attribute__((aligned(16))) unsigned char smem[];
    LAS unsigned char* lds = (LAS unsigned char*)smem;
    const int tid0 = threadIdx.x, wave = __builtin_amdgcn_readfirstlane(tid0 >> 6);
    const int G = gridDim.x, bx = blockIdx.x;
    const int vcu = (G % 8 == 0) ? (bx % 8) * (G / 8) + bx / 8 : bx;
    const int gw = vcu * 8 + wave, NGW = G * 8;
    unsigned char* ws = a.ws;
    float* rpart = (float*)(ws + WS_RPART);
    float* LF = (float*)(ws + WS_LF);
    float* c2p = (float*)(ws + WS_C2P);
    float* c2s = (float*)(ws + WS_C2S);
    float* Xf = (float*)(ws + WS_XF);
    bf16_t* Xb = (bf16_t*)(ws + WS_XB);
    bf16_t* A2 = (bf16_t*)(ws + WS_A2);
    bf16_t* OV = (bf16_t*)(ws + WS_OV);
    bf16_t* Qb = (bf16_t*)(ws + WS_Q);
    bf16_t* Kb = (bf16_t*)(ws + WS_K);
    bf16_t* Vb = (bf16_t*)(ws + WS_V);
    const float* x_prompt = a.in[0]; const float* x_sample = a.in[1]; const float* state_conv = a.in[2];
    const float* cache_k = a.in[3]; const float* cache_v = a.in[4]; const float* cache_lf = a.in[5];
    const float* norm_mix = a.in[6]; const float* norm_mlp = a.in[7]; const float* norm_final = a.in[8];
    const float* conv_w_in = a.in[9]; const float* conv_w = a.in[10]; const float* conv_w_out = a.in[11];
    const float* fox_w_in = a.in[12]; const float* fox_b_f = a.in[13]; const float* fox_w_out = a.in[14];
    const float* mlp_w1 = a.in[15]; const float* mlp_w2 = a.in[16];
    float* out = a.out;
    volatile LAS unsigned* misc = (volatile LAS unsigned*)(lds + LDS_CTL);
    if (tid0 < 4) misc[tid0] = 0u;
    __syncthreads();
    XcdBarrier xbar; xbar.bar = (unsigned*)(ws + WS_BAR); xbar.x = 0; xbar.st = misc;

    for (int step = a.lo; step < a.hi; ++step) {
        if constexpr (COOP) {
            if (step == a.lo + 1) { cg::this_grid().sync(); xbar = xcd_barrier_post((unsigned*)(ws + WS_BAR), misc); }
            else if (step > a.lo + 1) xcd_barrier(xbar);
        }
        int kind;
        int j = 0, layer = 0;
        if (step == 0) kind = 0;
        else if (step == 23) kind = 10;
        else { const int s = step - 1; j = s / 11; const int r = s % 11;
            if (r < 5) { layer = 2 * j; kind = (r < 3) ? 1 + r : 4 + (r - 3); }
            else { layer = 2 * j + 1; const int q = r - 5; kind = (q < 4) ? 6 + q : 4 + (q - 4); } }

        for (int rep = 0; rep < ((kind == REPEAT_KIND) ? 2 : 1); ++rep) {
        int tid = tid0; asm volatile("" : "+v"(tid));
        const int lane = tid & 63;
        if (kind == 1 || kind == 3 || kind == 4 || kind == 5 || kind == 6 || kind == 9) {
            pg8::Gemm g; pg8::EpiG E{};
            E.rpart_in = rpart; E.rpart_out = rpart; E.Xf = nullptr; E.Xb = Xb;
            if (kind == 1) { g = pg8::Gemm{Xb, (const bf16_t*)(ws + W_CIN + (size_t)j * 6 * MiB), M, 3072, 1024, 1024, 1024}; E.mode = 0; E.O = OV; E.ldc = 3072; }
            else if (kind == 3) { g = pg8::Gemm{A2, (const bf16_t*)(ws + W_COUT + (size_t)j * 2 * MiB), M, 1024, 1024, 1024, 1024}; E.mode = 2; }
            else if (kind == 4) { g = pg8::Gemm{Xb, (const bf16_t*)(ws + W_1 + (size_t)layer * 8 * MiB), M, 4096, 1024, 1024, 1024}; E.mode = 3; E.O = OV; E.ldc = HLD; }
            else if (kind == 5) { g = pg8::Gemm{OV, (const bf16_t*)(ws + W_2 + (size_t)layer * 9 * MiB), M, 1024, 4096, HLD, HLD}; E.mode = 2; }
            else if (kind == 6) { g = pg8::Gemm{Xb, (const bf16_t*)(ws + W_FIN + (size_t)j * 6 * MiB), M, 3072, 1024, 1024, 1024}; E.mode = 1;
                E.Qb = Qb; E.Kb = Kb; E.Vb = Vb; E.qkm = (unsigned*)(ws + WS_QKM) + j * 128;
                E.outKp = out + O_PK + (size_t)j * SEQ * 1024; E.outVp = out + O_PV + (size_t)j * SEQ * 1024;
                E.outKs = out + O_SK + (size_t)j * MS * 1024; E.outVs = out + O_SV + (size_t)j * MS * 1024; }
            else { g = pg8::Gemm{A2, (const bf16_t*)(ws + W_FO + (size_t)j * 2 * MiB), M, 1024, 1024, 1024, 1024}; E.mode = 2; }
            if (rep == 1 && E.mode == 2) { E.Xf = (float*)(ws + 410 * MiB); E.Xb = (bf16_t*)(ws + 479 * MiB); E.rpart_out = (float*)(ws + 514 * MiB); }
            const bool first_res = (kind == 3 && j == 0);
            E.XinP = first_res ? x_prompt : Xf; const float* xinS = first_res ? x_sample : Xf + (size_t)SEQ * 1024;
            E.rl = (const PG8_LAS float*)(lds + 131072); E.pm0 = -1;
            g.M = SEQ;
            pg8::StaticOrder S; S.init(g.M, g.N, G, bx);
            if (kind == 6 && (bx & 1)) F1_EXTRAS();
            if (E.mode != 2) {
                pg8::Unit u0; S.next(0, u0); E.pm0 = u0.pm;
                const int row = u0.pm * 256 + (tid >> 1); const f32x4* rp = (const f32x4*)(rpart + (size_t)row * 16 + (tid & 1) * 8);
                const f32x4 a_ = rp[0], b_ = rp[1]; float s_ = ((a_[0] + a_[1]) + (a_[2] + a_[3])) + ((b_[0] + b_[1]) + (b_[2] + b_[3]));
                s_ += __shfl_xor(s_, 1);
                if ((tid & 1) == 0) ((LAS float*)(lds + 131072))[tid >> 1] = 1.0f / sqrtf(s_ * (1.0f / 1024.0f) + EPS);
                __syncthreads();
            }
            pg8::gemm_phase<pg8::EpiG, pg8::StaticOrder, true, true>(lds, g, S, E);
            small_gemm(lds, g.A, g.lda, g.Bt, g.ldb, g.N, g.K, E, vcu, G, tid, wave, xinS);
            if (kind == 6 && !(bx & 1)) F1_EXTRAS();
        } else if (kind == 0) {
            LAS float* scr = (LAS float*)(lds + wave * 16384);
            for (int it = gw; it < 24576; it += NGW) {
                if (it < 8192) { const int jj = it >> 12, r = it & 4095;
                    if (r < 1536) transpose_item(conv_w_in + (size_t)jj * 1024 * 3072, 1024, 3072, 3072, norm_mix + (2 * jj) * 1024, (bf16_t*)(ws + W_CIN + (size_t)jj * 6 * MiB), scr, r, lane);
                    else if (r < 2048) transpose_item(conv_w_out + (size_t)jj * 1024 * 1024, 1024, 1024, 1024, nullptr, (bf16_t*)(ws + W_COUT + (size_t)jj * 2 * MiB), scr, r - 1536, lane);
                    else if (r < 3584) transpose_item(fox_w_in + (size_t)jj * 1024 * 3088, 1024, 3072, 3088, norm_mix + (2 * jj + 1) * 1024, (bf16_t*)(ws + W_FIN + (size_t)jj * 6 * MiB), scr, r - 2048, lane);
                    else transpose_item(fox_w_out + (size_t)jj * 1024 * 1024, 1024, 1024, 1024, nullptr, (bf16_t*)(ws + W_FO + (size_t)jj * 2 * MiB), scr, r - 3584, lane);
                } else { const int r0 = it - 8192, i = r0 >> 12, r = r0 & 4095;
                    if (r < 2048) transpose_item(mlp_w1 + (size_t)i * 1024 * 4096, 1024, 4096, 4096, norm_mlp + i * 1024, (bf16_t*)(ws + W_1 + (size_t)i * 8 * MiB), scr, r, lane);
                    else transpose_item(mlp_w2 + (size_t)i * 4096 * 1024, 4096, 1024, 1024, nullptr, (bf16_t*)(ws + W_2 + (size_t)i * 9 * MiB), scr, r - 2048, lane, HLD);
                }
            }
            for (int idx = gw * 64 + lane; idx < 2 * 16 * 1024; idx += NGW * 64) {
                const int jj = idx >> 14, hh = (idx >> 10) & 15, k = idx & 1023;
                const float v = fox_w_in[(size_t)jj * 1024 * 3088 + (size_t)k * 3088 + 3072 + hh] * norm_mix[(2 * jj + 1) * 1024 + k];
                ((bf16_t*)(ws + WS_WF))[idx] = (bf16_t)(pk2(v, 0.f) & 0xffffu);
            }
            for (int m = gw; m < M; m += NGW) {
                const float* xr = (m < SEQ) ? x_prompt + (size_t)m * 1024 : x_sample + (size_t)(m - SEQ) * 1024;
                f32x4 v[4]; float s = 0.f;
#pragma unroll
                for (int q = 0; q < 4; ++q) { v[q] = *(const f32x4*)(xr + q * 256 + lane * 4); s += (v[q][0] * v[q][0] + v[q][1] * v[q][1]) + (v[q][2] * v[q][2] + v[q][3] * v[q][3]); }
                s = wave_sum(s);
#pragma unroll
                for (int q = 0; q < 4; ++q) {
                    u32x2 w; w.x = pk2(v[q][0], v[q][1]); w.y = pk2(v[q][2], v[q][3]); *(u32x2*)(Xb + (size_t)m * 1024 + q * 256 + lane * 4) = w; }
                if (lane < 16) rpart[(size_t)m * 16 + lane] = (lane == 0) ? s : 0.f;
            }
            if (bx == 0) { ((unsigned*)(ws + WS_QKM))[tid] = 0u; for (int i = tid; i < XCD_BAR_WORDS; i += 512) ((unsigned*)(ws + WS_BAR))[i] = 0u; }
        } else if (kind == 2) {
            const bf16_t* BCH = OV; const float* cw = conv_w + (size_t)j * 3 * 1024;
            for (int it = gw; it < 2 * (M / 16); it += NGW) {
                const int ch = it & 1, row0 = (it >> 1) * 16, col = ch * 512 + lane * 8;
                float w0[8], w1[8], w2[8], um2[8], um1[8];
#pragma unroll
                for (int e = 0; e < 8; ++e) { w0[e] = cw[col + e]; w1[e] = cw[1024 + col + e]; w2[e] = cw[2048 + col + e]; }
                const bool samp = row0 >= SEQ; const int t0 = samp ? ((row0 - SEQ) & 31) : row0;
                if (t0 == 0) {
                    if (samp) { const int b = (row0 - SEQ) >> 5; const float* sp = state_conv + ((size_t)(j * NSB + b) * 2) * 1024 + col;
#pragma unroll
                        for (int e = 0; e < 8; ++e) { um2[e] = sp[e]; um1[e] = sp[1024 + e]; } }
                    else {
#pragma unroll
                        for (int e = 0; e < 8; ++e) { um2[e] = 0.f; um1[e] = 0.f; } }
                } else {
#pragma unroll
                    for (int q = 0; q < 2; ++q) { const bf16_t* rp = BCH + (size_t)(row0 - 2 + q) * 3072 + col;
                        const u32x4 c = *(const u32x4*)(rp + 1024), hh = *(const u32x4*)(rp + 2048);
#pragma unroll
                        for (int e = 0; e < 4; ++e) { const float ulo = bf_lo(c[e]) * bf_lo(hh[e]), uhi = bf_hi(c[e]) * bf_hi(hh[e]);
                            if (q == 0) { um2[2 * e] = ulo; um2[2 * e + 1] = uhi; } else { um1[2 * e] = ulo; um1[2 * e + 1] = uhi; } } }
                }
                for (int r4 = 0; r4 < 16; r4 += 4) {
                u32x4 bbq[4], cq[4], hq[4];
#pragma unroll
                for (int q = 0; q < 4; ++q) { const bf16_t* rp = BCH + (size_t)(row0 + r4 + q) * 3072 + col; bbq[q] = *(const u32x4*)rp; cq[q] = *(const u32x4*)(rp + 1024); hq[q] = *(const u32x4*)(rp + 2048); }
                asm volatile("" : "+v"(bbq[0]), "+v"(bbq[1]), "+v"(bbq[2]), "+v"(bbq[3]), "+v"(cq[0]), "+v"(cq[1]), "+v"(cq[2]), "+v"(cq[3]), "+v"(hq[0]), "+v"(hq[1]), "+v"(hq[2]), "+v"(hq[3]));
#pragma unroll
                for (int q = 0; q < 4; ++q) {
                    const int r = r4 + q; const int row = row0 + r;
                    const u32x4 bb = bbq[q], c = cq[q], hh = hq[q];
                    float uu[8], vv[8];
#pragma unroll
                    for (int e = 0; e < 4; ++e) { uu[2 * e] = bf_lo(c[e]) * bf_lo(hh[e]); uu[2 * e + 1] = bf_hi(c[e]) * bf_hi(hh[e]); }
#pragma unroll
                    for (int e = 0; e < 4; ++e) {
                        vv[2 * e] = bf_lo(bb[e]) * (w0[2 * e] * um2[2 * e] + w1[2 * e] * um1[2 * e] + w2[2 * e] * uu[2 * e]);
                        vv[2 * e + 1] = bf_hi(bb[e]) * (w0[2 * e + 1] * um2[2 * e + 1] + w1[2 * e + 1] * um1[2 * e + 1] + w2[2 * e + 1] * uu[2 * e + 1]); }
                    u32x4 w; w.x = pk2(vv[0], vv[1]); w.y = pk2(vv[2], vv[3]); w.z = pk2(vv[4], vv[5]); w.w = pk2(vv[6], vv[7]);
                    *(u32x4*)(A2 + (size_t)row * 1024 + col) = w;
                    float* so = nullptr;
                    if (!samp) { if (row >= SEQ - 2) so = out + O_PCONV + ((size_t)j * 2 + (row - (SEQ - 2))) * 1024 + col; }
                    else { const int sr = row - SEQ, tt = sr & 31; if (tt >= 30) so = out + O_SCONV + ((size_t)(j * NSB + (sr >> 5)) * 2 + (tt - 30)) * 1024 + col; }
                    if (so) { *(f32x4*)so = (f32x4){uu[0], uu[1], uu[2], uu[3]}; *(f32x4*)(so + 4) = (f32x4){uu[4], uu[5], uu[6], uu[7]}; }
#pragma unroll
                    for (int e = 0; e < 8; ++e) { um2[e] = um1[e]; um1[e] = uu[e]; }
                }
                }
            }
        } else if (kind == 7) {
            if (bx < 144) {
                LAS float* red = (LAS float*)(lds + 80 * 1024);
                LAS float* sv = (LAS float*)lds;
                const bool pr = bx < 16; const int hh = pr ? bx : ((bx - 16) & 15), b = pr ? 0 : ((bx - 16) >> 4);
                const int n = pr ? SEQ : (PAST + TS), per = pr ? 32 : 5;
                const float* clf = cache_lf + ((size_t)(j * NSB + b) * PAST) * 16 + hh;
                const float* nlf = pr ? LF + hh : LF + (size_t)(SEQ + b * 32) * 16 + hh;
                float* dst = pr ? c2p + (size_t)hh * SEQ : c2s + (size_t)(b * 16 + hh) * LSP;
                if (pr) {
                    float v[32];
#pragma unroll
                    for (int i = 0; i < 32; ++i) v[i] = nlf[(size_t)(i * 512 + tid) * 16];
#pragma unroll
                    for (int i = 0; i < 32; ++i) { const int pos = i * 512 + tid; sv[pos + (pos >> 5)] = v[i]; }
                } else {
                    float v[5];
#pragma unroll
                    for (int i = 0; i < 5; ++i) { const int pos = i * 512 + tid; v[i] = (pos < PAST) ? clf[(size_t)pos * 16] : (pos < n ? nlf[(size_t)(pos - PAST) * 16] : 0.f); }
#pragma unroll
                    for (int i = 0; i < 5; ++i) { const int pos = i * 512 + tid; sv[pos + (pos >> 5)] = v[i]; }
                }
                __syncthreads();
                const int s0 = tid * per; float tot = 0.f;
                for (int i = 0; i < per; ++i) { const int pos = s0 + i; if (pos < n) tot += sv[pos + (pos >> 5)]; }
                float inc = tot;
#pragma unroll
                for (int o = 1; o < 64; o <<= 1) { const float t = __shfl_up(inc, o); if (lane >= o) inc += t; }
                if (lane == 63) red[wave] = inc;
                __syncthreads();
                float run = inc - tot;
                for (int w = 0; w < wave; ++w) run += red[w];
                for (int i = 0; i < per; ++i) { const int pos = s0 + i; if (pos < n) { run += sv[pos + (pos >> 5)]; sv[pos + (pos >> 5)] = run * LOG2E; } }
                __syncthreads();
                for (int pos = tid; pos < n; pos += 512) dst[pos] = sv[pos + (pos >> 5)];
                __syncthreads();
            }
        } else if (kind == 8) {
            const unsigned* qkm = (const unsigned*)(ws + WS_QKM) + j * 128;
            unsigned* qctr = (unsigned*)(ws + WS_QKM) + 256 + j * 64;
            volatile LAS int* aord = (volatile LAS int*)(lds + A_END); volatile LAS float* atot = (volatile LAS float*)(lds + A_END + 64); volatile LAS unsigned* aq = (volatile LAS unsigned*)(lds + A_END + 128);
            volatile LAS float* acs = (volatile LAS float*)(lds + A_END + 192);
            if (tid < 16) { atot[tid] = c2p[(size_t)tid * SEQ + SEQ - 1];
                const float qn2_ = fmaxf(__uint_as_float(qkm[tid * 2]) + __uint_as_float(qkm[tid * 2 + 1]), __uint_as_float(qkm[80 + tid]));
                const float kn2_ = fmaxf(__uint_as_float(qkm[32 + tid * 2]) + __uint_as_float(qkm[32 + tid * 2 + 1]), __uint_as_float(qkm[64 + tid]));
                acs[tid] = QC2 * 1.02f * sqrtf(qn2_ * kn2_); }
            __syncthreads();
            if (tid < 16) { const float me = atot[tid]; int rk = 0; for (int o2 = 0; o2 < 16; ++o2) { const float ot = atot[o2]; rk += (ot > me || (ot == me && o2 < tid)) ? 1 : 0; } aord[rk] = tid; }
            __syncthreads();
            if (tid == 0) aq[0] = atomicAdd(qctr, 1u);
            __syncthreads();
            int q = (int)aq[0];
            while (q < 1024 + 128) {
                unsigned nq = 0u; if (tid == 0) nq = atomicAdd(qctr, 1u);
                int hh, nrows, p0; long qrow0, kvbase; const float* c2seq;
                if (q >= 128) { const int qq = q - 128; hh = aord[qq >> 6]; const int qb = 63 - (qq & 63); qrow0 = 256 * qb; kvbase = 0; p0 = 256 * qb; nrows = 256; c2seq = c2p + (size_t)hh * SEQ; }
                else { const int sI = q, b = sI >> 4;   hh = sI & 15; qrow0 = SEQ + 32 * b; kvbase = SEQ + (long)b * LSP; p0 = PAST; nrows = 32; c2seq = c2s + (size_t)(b * 16 + hh) * LSP; }
                const float CS1 = acs[hh];
                const float TH = 2.0f * CS1 + 152.0f;
                attn_unit(lds, Qb, Kb, Vb, A2, c2seq, qrow0, kvbase, p0, nrows, hh, TH, CS1, lane, wave);
                if (tid == 0) aq[0] = nq;
                __syncthreads();
                q = (int)aq[0];
                __syncthreads();
            }
        } else {
            f32x4 gg[4];
#pragma unroll
            for (int q = 0; q < 4; ++q) gg[q] = *(const f32x4*)(norm_final + q * 256 + lane * 4);
            for (int m = gw; m < M; m += NGW) {
                const f32x4* rp = (const f32x4*)(rpart + (size_t)m * 16);
                f32x4 ra = rp[0], rb = rp[1], rc = rp[2], rd = rp[3], v[4];
                u32x2 xw[4];
#pragma unroll
                for (int q = 0; q < 4; ++q) xw[q] = *(const u32x2*)(Xb + (size_t)m * 1024 + q * 256 + lane * 4);
                asm volatile("" : "+v"(ra), "+v"(rb), "+v"(rc), "+v"(rd), "+v"(xw[0]), "+v"(xw[1]), "+v"(xw[2]), "+v"(xw[3]));
#pragma unroll
                for (int q = 0; q < 4; ++q) v[q] = (f32x4){__uint_as_float(xw[q].x << 16), __uint_as_float(xw[q].x & 0xffff0000u), __uint_as_float(xw[q].y << 16), __uint_as_float(xw[q].y & 0xffff0000u)};
                const float sN = ((ra[0] + ra[1]) + (ra[2] + ra[3])) + ((rb[0] + rb[1]) + (rb[2] + rb[3])) + ((rc[0] + rc[1]) + (rc[2] + rc[3])) + ((rd[0] + rd[1]) + (rd[2] + rd[3]));
                const float r = 1.0f / sqrtf(sN * (1.0f / 1024.0f) + EPS);
#pragma unroll
                for (int q = 0; q < 4; ++q) __builtin_nontemporal_store(v[q] * r * gg[q], (f32x4*)(out + O_Y + (size_t)m * 1024 + q * 256 + lane * 4));
            }
        }
        }
    }
}

constexpr int NSTEPS = 24;
extern "C" void kernel_launch(void* const* d_in, const int* in_sizes, int n_in, void* d_out, int out_size, void* d_ws, size_t ws_size, hipStream_t stream) {
    static int grid = 0;
    if (grid == 0) {
        if (n_in != 17 || ws_size < WS_END) { fprintf(stderr, "kernel_launch: unexpected n_in %d or workspace %zu < %zu\n", n_in, ws_size, (size_t)WS_END); grid = -1; return; }
        int dev = 0, cus = 0, per_cu = 0;
        hipGetDevice(&dev); hipDeviceGetAttribute(&cus, hipDeviceAttributeMultiprocessorCount, dev);
        hipFuncSetAttribute((const void*)fwd<true>, hipFuncAttributeMaxDynamicSharedMemorySize, LDS_BYTES);
        hipFuncSetAttribute((const void*)fwd<false>, hipFuncAttributeMaxDynamicSharedMemorySize, LDS_BYTES);
        hipOccupancyMaxActiveBlocksPerMultiprocessor(&per_cu, (const void*)fwd<true>, 512, LDS_BYTES);
        (void)hipGetLastError();
        if (per_cu < 1) per_cu = 1;
        grid = cus * 1;
        fprintf(stderr, "kernel_launch: cus %d per_cu %d grid %d\n", cus, per_cu, grid);
    }
    if (grid < 0) return;
    Args a{};
    for (int i = 0; i < 17; ++i) a.in[i] = (const float*)d_in[i];
    a.out = (float*)d_out; a.ws = (unsigned char*)d_ws;
#if MULTI_LAUNCH
    for (int p = 0; p < NSTEPS; ++p) { a.lo = p; a.hi = p + 1; hipLaunchKernelGGL(fwd<false>, dim3(grid), dim3(512), LDS_BYTES, stream, a); }
#else
    a.lo = 0; a.hi = NSTEPS;
    void* args[] = {&a};
    hipError_t e = hipLaunchCooperativeKernel((const void*)fwd<true>, dim3(grid), dim3(512), args, LDS_BYTES, stream);
    if (e != hipSuccess) fprintf(stderr, "cooperative launch failed: %s (grid %d)\n", hipGetErrorString(e), grid);
#endif
}
```

```cpp
#include <hip/hip_runtime.h>
#include <hip/hip_cooperative_groups.h>
#include <cstdio>
#include <cstdint>
namespace cg = cooperative_groups;
#ifndef REPEAT_KIND
#define REPEAT_KIND -1
#endif
#ifndef MULTI_LAUNCH
#define MULTI_LAUNCH 0
#endif
constexpr int D = 1024, SEQ = 16384, NSB = 8, TS = 32, PAST = 2048, MS = NSB * TS, M = SEQ + MS, FF = 4096, NH = 16;
constexpr int HLD = 4096 + 64;
constexpr int LSP = 2112;
constexpr int KVROWS = SEQ + NSB * LSP;
constexpr float EPS = 1e-5f;
constexpr float LOG2E = 1.4426950408889634f;
constexpr float QC2 = 0.125f * 1.4426950408889634f;
namespace pg8 {
#define PG8_LAS __attribute__((address_space(3)))
typedef unsigned short bf16_t;
typedef short bf16x8 __attribute__((ext_vector_type(8)));
typedef float f32x4 __attribute__((ext_vector_type(4)));
typedef unsigned u32x4 __attribute__((ext_vector_type(4)));
constexpr int BM = 256, BK = 64, HALF = 128, HTB = HALF * BK * 2  , STAGE_BYTES = 8 * HTB, NXCD = 8, WGM = 8;

__host__ __device__ __forceinline__ int lds_byte(int r, int c) { const int st = (r >> 4) * 2 + (c >> 5), rr = r & 15, cc = c & 31, ob = rr * 64 + cc * 2; return st * 1024 + (ob ^ (((ob >> 9) & 1) << 5)); }
__host__ __device__ __forceinline__ void stage_rc(int b, int& R, int& C) { const int st = b / 1024, sb = b % 1024, swz = sb ^ (((sb >> 9) & 1) << 5); R = (st >> 1) * 16 + swz / 64; C = (st & 1) * 32 + (swz % 64) / 2; }
__host__ __device__ __forceinline__ int perm32(int rho) { const int n = rho >> 4, i = rho & 15; return 8 * (i >> 2) + 4 * n + (i & 3); }

struct Unit { int pm, pn; };
struct Gemm { const bf16_t* A; const bf16_t* Bt; int M, N, K, lda, ldb; };

struct StaticOrder {
    int nM, nN, nwg, G, c;
    __host__ __device__ void init(int M, int N, int G_, int c_) { nM = M / BM; nN = N / BM; nwg = nM * nN; G = G_; c = c_; }
    __host__ __device__ bool next(int i, Unit& u) const {
        const long L = (long)i * G + c; if (L >= nwg) return false;
        int wgid = (int)L; { const int q = nwg / NXCD, r = nwg % NXCD, xcd = wgid % NXCD, off = wgid / NXCD; wgid = (xcd < r ? xcd * (q + 1) : r * (q + 1) + (xcd - r) * q) + off; }
        const int nig = WGM * nN, gid = wgid / nig, fm = gid * WGM, gsz = (nM - fm) < WGM ? (nM - fm) : WGM;
        u.pm = fm + ((wgid % nig) % gsz); u.pn = (wgid % nig) / gsz; return true;
    }
    __device__ __forceinline__ void a_ready(const Unit&) const {}
    __device__ __forceinline__ void done(const Unit&) const {}
};
__device__ __forceinline__ unsigned cvt_pk_bf16(float lo, float hi) { unsigned r; asm volatile("v_cvt_pk_bf16_f32 %0, %1, %2" : "=v"(r) : "v"(lo), "v"(hi)); return r; }
typedef float f32x2 __attribute__((ext_vector_type(2)));
struct EpiG {
    static constexpr bool PERM = true, AFTER_DRAIN = false;
    int mode;
    bf16_t* O; int ldc;
    const float* rpart_in;
    float* Xf; bf16_t* Xb; float* rpart_out;
    bf16_t *Qb, *Kb, *Vb; float *outKp, *outVp, *outKs, *outVs; unsigned* qkm;
    const PG8_LAS float* rl; int pm0;
    const float* XinP;
    __device__ __forceinline__ void operator()(const f32x4 (&acc)[2][2][4][2], const Unit& u, int wr, int wc, int fr, int fq) const {
        const int rowb = u.pm * BM + wr * 64 + fr;
        const int colb = u.pn * BM + wc * 32 + 8 * fq;
        if (mode == 2) {
#pragma unroll
            for (int ai = 0; ai < 2; ++ai) {
                u32x4 pre[4][2];
#pragma unroll
                for (int m = 0; m < 4; ++m) { const bf16_t* xi = Xb + (size_t)(rowb + ai * HALF + m * 16) * 1024 + colb;
#pragma unroll
                    for (int bj = 0; bj < 2; ++bj) pre[m][bj] = *(const u32x4*)(xi + bj * HALF); }
                asm volatile("" : "+v"(pre[0][0]), "+v"(pre[0][1]), "+v"(pre[1][0]), "+v"(pre[1][1]), "+v"(pre[2][0]), "+v"(pre[2][1]), "+v"(pre[3][0]), "+v"(pre[3][1]));
#pragma unroll
                for (int m = 0; m < 4; ++m) {
                    const int row = rowb + ai * HALF + m * 16;
                    bf16_t* bp = Xb + (size_t)row * 1024 + colb; float ss = 0.f;
#pragma unroll
                    for (int bj = 0; bj < 2; ++bj) {
                        const u32x4 pw = pre[m][bj];
                        f32x4 x0 = {__uint_as_float(pw.x << 16), __uint_as_float(pw.x & 0xffff0000u), __uint_as_float(pw.y << 16), __uint_as_float(pw.y & 0xffff0000u)};
                        f32x4 x1 = {__uint_as_float(pw.z << 16), __uint_as_float(pw.z & 0xffff0000u), __uint_as_float(pw.w << 16), __uint_as_float(pw.w & 0xffff0000u)};
                        x0 += acc[ai][bj][m][0]; x1 += acc[ai][bj][m][1];
                        if (Xf) { float* xp = Xf + (size_t)row * 1024 + colb; *(f32x4*)(xp + bj * HALF) = x0; *(f32x4*)(xp + bj * HALF + 4) = x1; }
                        ss += (x0[0] * x0[0] + x0[1] * x0[1]) + (x0[2] * x0[2] + x0[3] * x0[3]) + (x1[0] * x1[0] + x1[1] * x1[1]) + (x1[2] * x1[2] + x1[3] * x1[3]);
                        u32x4 w; w.x = cvt_pk_bf16(x0[0], x0[1]); w.y = cvt_pk_bf16(x0[2], x0[3]); w.z = cvt_pk_bf16(x1[0], x1[1]); w.w = cvt_pk_bf16(x1[2], x1[3]);
                        *(u32x4*)(bp + bj * HALF) = w;
                    }
                    ss += __shfl_xor(ss, 16); ss += __shfl_xor(ss, 32);
                    if (fq == 0) rpart_out[(size_t)row * 16 + u.pn * 4 + wc] = ss;
                }
            }
            return;
        }
        float rinv[2][4];
        if (u.pm == pm0) {
#pragma unroll
            for (int ai = 0; ai < 2; ++ai)
#pragma unroll
                for (int m = 0; m < 4; ++m) rinv[ai][m] = rl[wr * 64 + fr + ai * HALF + m * 16];
        } else
#pragma unroll
        for (int ai = 0; ai < 2; ++ai)
#pragma unroll
            for (int m = 0; m < 4; ++m) {
                const f32x4* rp = (const f32x4*)(rpart_in + (size_t)(rowb + ai * HALF + m * 16) * 16);
                const f32x4 a = rp[0], b = rp[1], c = rp[2], d = rp[3];
                const float s = ((a[0] + a[1]) + (a[2] + a[3])) + ((b[0] + b[1]) + (b[2] + b[3])) + ((c[0] + c[1]) + (c[2] + c[3])) + ((d[0] + d[1]) + (d[2] + d[3]));
                rinv[ai][m] = 1.0f / sqrtf(s * (1.0f / 1024.0f) + 1e-5f);
            }
        if (mode == 0 || mode == 3) {
#pragma unroll
            for (int ai = 0; ai < 2; ++ai)
#pragma unroll
                for (int m = 0; m < 4; ++m) {
                    bf16_t* rowp = O + (size_t)(rowb + ai * HALF + m * 16) * ldc + colb; const float r = rinv[ai][m];
#pragma unroll
                    for (int bj = 0; bj < 2; ++bj) {
                        f32x4 v0 = acc[ai][bj][m][0] * r, v1 = acc[ai][bj][m][1] * r;
                        if (mode == 3) {
#pragma unroll
                            for (int e = 0; e < 4; ++e) { const float a0 = fmaxf(v0[e], 0.f), a1 = fmaxf(v1[e], 0.f); v0[e] = a0 * a0; v1[e] = a1 * a1; }
                        }
                        u32x4 w; w.x = cvt_pk_bf16(v0[0], v0[1]); w.y = cvt_pk_bf16(v0[2], v0[3]); w.z = cvt_pk_bf16(v1[0], v1[1]); w.w = cvt_pk_bf16(v1[2], v1[3]);
                        *(u32x4*)(rowp + bj * HALF) = w;
                    }
                }
            return;
        }
        const int t = u.pn >> 2; const int colq = (u.pn & 3) * BM + wc * 32 + 8 * fq;
        const bool samp = (u.pm >= 64);
        float mx[2] = {0.f, 0.f};
#pragma unroll
        for (int ai = 0; ai < 2; ++ai)
#pragma unroll
            for (int m = 0; m < 4; ++m) {
                const int row = rowb + ai * HALF + m * 16; const float r = rinv[ai][m];
                const int sr = row - 16384;
                const size_t kvrow = samp ? (size_t)(16384 + (sr >> 5) * 2112 + 2048 + (sr & 31)) : (size_t)row;
#pragma unroll
                for (int bj = 0; bj < 2; ++bj) {
                    f32x4 v0 = acc[ai][bj][m][0] * r, v1 = acc[ai][bj][m][1] * r;
                    if (t < 2) {
                        float s = (v0[0] * v0[0] + v0[1] * v0[1]) + (v0[2] * v0[2] + v0[3] * v0[3]) + (v1[0] * v1[0] + v1[1] * v1[1]) + (v1[2] * v1[2] + v1[3] * v1[3]);
                        s += __shfl_xor(s, 16); s += __shfl_xor(s, 32); mx[bj] = fmaxf(mx[bj], s);
                    }
                    if (t == 0) {
                        v0 = v0 * 0.18033688011112042f; v1 = v1 * 0.18033688011112042f;
                        u32x4 w; w.x = cvt_pk_bf16(v0[0], v0[1]); w.y = cvt_pk_bf16(v0[2], v0[3]); w.z = cvt_pk_bf16(v1[0], v1[1]); w.w = cvt_pk_bf16(v1[2], v1[3]);
                        *(u32x4*)(Qb + (size_t)row * 1024 + colq + bj * HALF) = w;
                    } else {
                        u32x4 w; w.x = cvt_pk_bf16(v0[0], v0[1]); w.y = cvt_pk_bf16(v0[2], v0[3]); w.z = cvt_pk_bf16(v1[0], v1[1]); w.w = cvt_pk_bf16(v1[2], v1[3]);
                        bf16_t* kb = (t == 1 ? Kb : Vb) + kvrow * 1024 + colq + bj * HALF;
                        *(u32x4*)kb = w;
                        float* ob = samp ? ((t == 1 ? outKs : outVs) + (size_t)sr * 1024) : ((t == 1 ? outKp : outVp) + (size_t)row * 1024);
                        ob += colq + bj * HALF;
                        __builtin_nontemporal_store(v0, (f32x4*)ob); __builtin_nontemporal_store(v1, (f32x4*)(ob + 4));
                    }
                }
            }
        if (t < 2) {
#pragma unroll
            for (int bj = 0; bj < 2; ++bj) {
                float v = mx[bj];
                v = fmaxf(v, __shfl_xor(v, 1)); v = fmaxf(v, __shfl_xor(v, 2)); v = fmaxf(v, __shfl_xor(v, 4)); v = fmaxf(v, __shfl_xor(v, 8));
                const int head = (u.pn & 3) * 4 + bj * 2 + (wc >> 1);
                if ((threadIdx.x & 63) == 0) atomicMax(qkm + t * 32 + head * 2 + (wc & 1), __float_as_uint(v));
            }
        }
    }
};
template <class Epi, class Sched, bool ALIGN_EPI = false, bool SP2 = false>
__device__ __forceinline__ void gemm_phase(PG8_LAS unsigned char* lds, const Gemm g, const Sched& S, const Epi& E) {
    const int tid = threadIdx.x, wid = __builtin_amdgcn_readfirstlane(tid >> 6), lane = tid & 63, wr = wid >> 2, wc = wid & 3, fr = lane & 15, fq = lane >> 4;
    const int K = g.K, nt = K / BK;
    unsigned voffA[2], voffB[2];
#pragma unroll
    for (int i = 0; i < 2; ++i) { int R, C; stage_rc(tid * 16 + i * 8192, R, C); const int Rb = Epi::PERM ? ((R & ~31) + perm32(R & 31)) : R;
        voffA[i] = (unsigned)(R * g.lda + C) * 2u; voffB[i] = (unsigned)(Rb * g.ldb + C) * 2u; }
    const size_t kstep = (size_t)(BK * 2);
    const size_t hstep = (size_t)HALF * g.ldb * 2;
    const size_t tstep = 2 * hstep;
    const size_t hstepA = (size_t)HALF * g.lda * 2, tstepA = 2 * hstepA;
    const unsigned ldsw = (unsigned)wid * 1024u;
    const int aoff = lds_byte(wr * 64 + fr, fq * 8), boff = lds_byte(wc * 32 + fr, fq * 8);
#define PG8_SA(b, h) (((b) * 2 + (h)) * HTB)
#define PG8_SB(b, h) ((4 + (b) * 2 + (h)) * HTB)
#define PG8_STAGE(bufoff, gbase, voff) do { _Pragma("unroll") for (int _i = 0; _i < 2; ++_i) \
        __builtin_amdgcn_global_load_lds((const unsigned*)((const char*)(gbase) + (voff)[_i]), (PG8_LAS unsigned*)(lds + (bufoff) + ldsw + _i * 8192), 16, 0, 0); } while (0)
#define PG8_LDA(dst, b, h) do { _Pragma("unroll") for (int m = 0; m < 4; ++m) _Pragma("unroll") for (int k = 0; k < 2; ++k) dst[m][k] = *(const PG8_LAS bf16x8*)(lds + PG8_SA(b, h) + aoff + m * 2048 + k * 1024); } while (0)
#define PG8_LDB(dst, b, h) do { _Pragma("unroll") for (int n = 0; n < 2; ++n) _Pragma("unroll") for (int k = 0; k < 2; ++k) dst[n][k] = *(const PG8_LAS bf16x8*)(lds + PG8_SB(b, h) + boff + n * 2048 + k * 1024); } while (0)
#define PG8_MMA(ai, bj, At, Bt) do { __builtin_amdgcn_s_setprio(1); _Pragma("unroll") for (int m = 0; m < 4; ++m) _Pragma("unroll") for (int n = 0; n < 2; ++n) _Pragma("unroll") for (int k = 0; k < 2; ++k) \
        acc[ai][bj][m][n] = __builtin_amdgcn_mfma_f32_16x16x32_bf16(Bt[n][k], At[m][k], acc[ai][bj][m][n], 0, 0, 0); __builtin_amdgcn_s_setprio(0); } while (0)
#define PG8_WAIT_V(n) asm volatile("s_waitcnt vmcnt(" #n ")" ::: "memory")
#define PG8_WAIT_L(n) asm volatile("s_waitcnt lgkmcnt(" #n ")" ::: "memory")
#define PG8_BAR __builtin_amdgcn_s_barrier()
#define PG8_SCHED __builtin_amdgcn_sched_barrier(0)
    Unit cur, nxt; int ui = 0;
    if (!S.next(0, cur)) return;
    f32x4 acc[2][2][4][2];
#pragma unroll
    for (int a = 0; a < 2; ++a)
#pragma unroll
        for (int b = 0; b < 2; ++b)
#pragma unroll
            for (int m = 0; m < 4; ++m)
#pragma unroll
                for (int n = 0; n < 2; ++n) acc[a][b][m][n] = (f32x4){0.f, 0.f, 0.f, 0.f};
    bf16x8 At[4][2], B0[2][2], B1[2][2];
    const char* cA = (const char*)g.A + (size_t)cur.pm * tstepA; const char* cB = (const char*)g.Bt + (size_t)cur.pn * tstep;
    S.a_ready(cur);
    if constexpr (SP2) {
        PG8_STAGE(PG8_SB(0, 0), cB, voffB); PG8_STAGE(PG8_SB(0, 1), cB + hstep, voffB); PG8_STAGE(PG8_SA(0, 0), cA, voffA); PG8_STAGE(PG8_SA(0, 1), cA + hstepA, voffA);
        if (wr == 1) PG8_BAR;
        PG8_WAIT_V(2); PG8_BAR;
        PG8_STAGE(PG8_SB(1, 0), cB + kstep, voffB); PG8_STAGE(PG8_SA(1, 0), cA + kstep, voffA); PG8_STAGE(PG8_SB(1, 1), cB + hstep + kstep, voffB);
        PG8_WAIT_V(6); PG8_BAR;
    } else {
        PG8_STAGE(PG8_SB(0, 0), cB, voffB); PG8_STAGE(PG8_SA(0, 0), cA, voffA); PG8_STAGE(PG8_SB(0, 1), cB + hstep, voffB); PG8_STAGE(PG8_SA(0, 1), cA + hstepA, voffA);
        if (wr == 1) PG8_BAR;
        PG8_WAIT_V(4); PG8_BAR;
        PG8_STAGE(PG8_SB(1, 0), cB + kstep, voffB); PG8_STAGE(PG8_SA(1, 0), cA + kstep, voffA); PG8_STAGE(PG8_SB(1, 1), cB + hstep + kstep, voffB);
        PG8_WAIT_V(6); PG8_BAR;
    }
    for (;;) {
        const bool has_next = S.next(ui + 1, nxt);
        const char* nA = has_next ? (const char*)g.A + (size_t)nxt.pm * tstepA : cA; const char* nB = has_next ? (const char*)g.Bt + (size_t)nxt.pn * tstep : cB;
        for (int t = 0; t < nt; t += 2) {
            const bool last = (t == nt - 2);
            const char* a1 = cA + (size_t)(t + 1) * kstep;
            const char* a2 = last ? nA : cA + (size_t)(t + 2) * kstep; const char* b2 = last ? nB : cB + (size_t)(t + 2) * kstep;
            const char* a3 = a2 + kstep; const char* b3 = b2 + kstep;
            if (last && has_next) S.a_ready(nxt);
            if constexpr (SP2) {
            PG8_LDB(B0, 0, 0); PG8_LDB(B1, 0, 1); PG8_SCHED; PG8_LDA(At, 0, 0); PG8_STAGE(PG8_SA(1, 1), a1 + hstepA, voffA);
            PG8_WAIT_V(8); PG8_WAIT_L(0); PG8_BAR; PG8_MMA(0, 0, At, B0); PG8_MMA(0, 1, At, B1); PG8_BAR; PG8_SCHED;
            PG8_LDA(At, 0, 1); PG8_STAGE(PG8_SB(0, 0), b2, voffB); PG8_STAGE(PG8_SB(0, 1), b2 + hstep, voffB); PG8_STAGE(PG8_SA(0, 0), a2, voffA);
            PG8_WAIT_V(8); PG8_WAIT_L(0); PG8_BAR; PG8_MMA(1, 0, At, B0); PG8_MMA(1, 1, At, B1); PG8_BAR; PG8_SCHED;
            PG8_LDB(B0, 1, 0); PG8_LDB(B1, 1, 1); PG8_SCHED; PG8_LDA(At, 1, 0); PG8_STAGE(PG8_SA(0, 1), a2 + hstepA, voffA);
            PG8_WAIT_V(8); PG8_WAIT_L(0); PG8_BAR; PG8_MMA(0, 0, At, B0); PG8_MMA(0, 1, At, B1); PG8_BAR; PG8_SCHED;
            PG8_LDA(At, 1, 1); PG8_STAGE(PG8_SB(1, 0), b3, voffB); PG8_STAGE(PG8_SB(1, 1), b3 + hstep, voffB); PG8_STAGE(PG8_SA(1, 0), a3, voffA);
            PG8_WAIT_V(8); PG8_WAIT_L(0); PG8_BAR; PG8_MMA(1, 0, At, B0); PG8_MMA(1, 1, At, B1); PG8_BAR; PG8_SCHED;
            } else {
            PG8_LDB(B0, 0, 0); PG8_SCHED; PG8_LDA(At, 0, 0); PG8_STAGE(PG8_SA(1, 1), a1 + hstepA, voffA);
            PG8_WAIT_L(8); PG8_BAR; PG8_WAIT_L(0); PG8_MMA(0, 0, At, B0); PG8_BAR; PG8_SCHED;
            PG8_LDB(B1, 0, 1); PG8_STAGE(PG8_SB(0, 0), b2, voffB);
            PG8_BAR; PG8_WAIT_L(0); PG8_MMA(0, 1, At, B1); PG8_BAR;
            PG8_LDA(At, 0, 1); PG8_STAGE(PG8_SA(0, 0), a2, voffA);
            PG8_BAR; PG8_WAIT_L(0); PG8_MMA(1, 0, At, B0); PG8_BAR; PG8_SCHED;
            PG8_STAGE(PG8_SB(0, 1), b2 + hstep, voffB);
            PG8_WAIT_V(6); PG8_BAR; PG8_MMA(1, 1, At, B1); PG8_BAR;
            PG8_LDB(B0, 1, 0); PG8_SCHED; PG8_LDA(At, 1, 0); PG8_STAGE(PG8_SA(0, 1), a2 + hstepA, voffA);
            PG8_WAIT_L(8); PG8_BAR; PG8_WAIT_L(0); PG8_MMA(0, 0, At, B0); PG8_BAR; PG8_SCHED;
            PG8_LDB(B1, 1, 1); PG8_STAGE(PG8_SB(1, 0), b3, voffB);
            PG8_BAR; PG8_WAIT_L(0); PG8_MMA(0, 1, At, B1); PG8_BAR;
            PG8_LDA(At, 1, 1); PG8_STAGE(PG8_SA(1, 0), a3, voffA);
            PG8_BAR; PG8_WAIT_L(0); PG8_MMA(1, 0, At, B0); PG8_BAR; PG8_SCHED;
            PG8_STAGE(PG8_SB(1, 1), b3 + hstep, voffB);
            PG8_WAIT_V(6); PG8_BAR; PG8_MMA(1, 1, At, B1); PG8_BAR;
            }
        }
        if constexpr (ALIGN_EPI) { if (wr == 0) PG8_BAR; }
        if constexpr (!Epi::AFTER_DRAIN) { E(acc, cur, wr, wc, fr, fq); S.done(cur); }
        if (!has_next) break;
#pragma unroll
        for (int a = 0; a < 2; ++a)
#pragma unroll
            for (int b = 0; b < 2; ++b)
#pragma unroll
                for (int m = 0; m < 4; ++m)
#pragma unroll
                    for (int n = 0; n < 2; ++n) acc[a][b][m][n] = (f32x4){0.f, 0.f, 0.f, 0.f};
        cur = nxt; cA = nA; cB = nB; ++ui;
        if constexpr (ALIGN_EPI) { if (wr == 1) PG8_BAR; }
    }
    PG8_WAIT_V(0);
    if constexpr (!ALIGN_EPI) { if (wr == 0) PG8_BAR; }
    PG8_BAR;
    if constexpr (Epi::AFTER_DRAIN) { E.fused(acc, cur, wr, wc, fr, fq, lds, wid, lane); S.done(cur); }
#undef PG8_SA
#undef PG8_SB
#undef PG8_STAGE
#undef PG8_LDA
#undef PG8_LDB
#undef PG8_MMA
#undef PG8_WAIT_V
#undef PG8_WAIT_L
#undef PG8_BAR
#undef PG8_SCHED
}
}

#define LAS __attribute__((address_space(3)))
typedef unsigned short bf16_t;
typedef short bf16x8 __attribute__((ext_vector_type(8)));
typedef short s16x4 __attribute__((ext_vector_type(4)));
typedef float f32x4 __attribute__((ext_vector_type(4)));
typedef float f32x16 __attribute__((ext_vector_type(16)));
typedef unsigned u32x4 __attribute__((ext_vector_type(4)));
typedef unsigned u32x2 __attribute__((ext_vector_type(2)));
typedef float f32x2_t __attribute__((ext_vector_type(2)));
typedef __bf16 bf16x2_t __attribute__((ext_vector_type(2)));
__device__ __forceinline__ unsigned pk2(float lo, float hi) { f32x2_t v = {lo, hi}; bf16x2_t b = __builtin_convertvector(v, bf16x2_t); return __builtin_bit_cast(unsigned, b); }
__device__ __forceinline__ float bf_lo(unsigned w) { return __uint_as_float(w << 16); }
__device__ __forceinline__ float bf_hi(unsigned w) { return __uint_as_float(w & 0xffff0000u); }
__device__ __forceinline__ float wave_sum(float v) {
#pragma unroll
    for (int o = 1; o < 64; o <<= 1) v += __shfl_xor(v, o);
    return v;
}
__device__ __forceinline__ float rinv_row(const float* rpart, int row) {
    const f32x4* rp = (const f32x4*)(rpart + (size_t)row * 16);
    const f32x4 a = rp[0], b = rp[1], c = rp[2], d = rp[3];
    const float s = ((a[0] + a[1]) + (a[2] + a[3])) + ((b[0] + b[1]) + (b[2] + b[3])) + ((c[0] + c[1]) + (c[2] + c[3])) + ((d[0] + d[1]) + (d[2] + d[3]));
    return 1.0f / sqrtf(s * (1.0f / 1024.0f) + EPS);
}

constexpr size_t MiB = 1u << 20;
constexpr size_t WS_QKM = 0;
constexpr size_t WS_BAR = 65536;
constexpr size_t WS_RPART = 1 * MiB;
constexpr size_t WS_LF = 3 * MiB;
constexpr size_t WS_C2P = 5 * MiB;
constexpr size_t WS_C2S = 7 * MiB;
constexpr size_t WS_WF = 9 * MiB;
constexpr size_t WS_W = 10 * MiB;
constexpr size_t W_CIN = WS_W, W_COUT = WS_W + 12 * MiB, W_FIN = WS_W + 16 * MiB, W_FO = WS_W + 28 * MiB, W_1 = WS_W + 32 * MiB, W_2 = WS_W + 64 * MiB;
constexpr size_t WS_XF = 110 * MiB;
constexpr size_t WS_XB = 175 * MiB;
constexpr size_t WS_A2 = 208 * MiB;
constexpr size_t WS_OV = 241 * MiB;
constexpr size_t WS_Q = WS_OV, WS_K = WS_OV + 33 * MiB, WS_V = WS_OV + 99 * MiB;
constexpr size_t WS_END = WS_OV + 166 * MiB;

constexpr size_t O_Y = 0, O_PCONV = 17039360, O_PK = 17043456, O_PV = 50597888, O_PLF = 84152320, O_SCONV = 84676608, O_SK = 84709376, O_SV = 85233664, O_SLF = 85757952;

constexpr int WLDS = 17408;
constexpr int LDS_CTL = 8 * WLDS;
constexpr int LDS_BYTES = 8 * WLDS + 256;

struct Args { const float* in[17]; float* out; unsigned char* ws; int lo, hi; };

__device__ __forceinline__ int crow(int r, int hi) { return (r & 3) + 8 * (r >> 2) + 4 * hi; }
__device__ __forceinline__ void glds16(const void* gsrc, unsigned lds_dst) { unsigned keep;
    asm volatile("s_mov_b32 %0, m0\n\ts_mov_b32 m0, %2\n\ts_nop 0\n\tglobal_load_lds_dwordx4 %1, off\n\ts_mov_b32 m0, %0" : "=&s"(keep) : "v"(gsrc), "s"(lds_dst) : "memory"); }
__device__ __forceinline__ void glds4(const void* gsrc, unsigned lds_dst) { unsigned keep;
    asm volatile("s_mov_b32 %0, m0\n\ts_mov_b32 m0, %2\n\ts_nop 0\n\tglobal_load_lds_dword %1, off\n\ts_mov_b32 m0, %0" : "=&s"(keep) : "v"(gsrc), "s"(lds_dst) : "memory"); }
#define SBAR() __builtin_amdgcn_sched_barrier(0)
struct VFrag { s16x4 lo[8], hi[8]; };
template <int d0> __device__ __forceinline__ void pv_reads(VFrag& f, int vb) {
#pragma unroll
        for (int ks = 0; ks < 4; ++ks) {
            asm volatile("ds_read_b64_tr_b16 %0,%1 offset:%c2" : "=&v"(f.lo[d0 * 4 + ks]) : "v"(vb), "i"(d0 * 4096 + ks * 1024) : "memory");
            asm volatile("ds_read_b64_tr_b16 %0,%1 offset:%c2" : "=&v"(f.hi[d0 * 4 + ks]) : "v"(vb), "i"(d0 * 4096 + ks * 1024 + 512) : "memory"); }
}
__device__ __forceinline__ void pv_mfma(f32x16* o, VFrag& f, bf16x8 pa0, bf16x8 pa1, bf16x8 pa2, bf16x8 pa3) {
    asm volatile("s_waitcnt lgkmcnt(0)" : "+v"(f.lo[0]), "+v"(f.lo[1]), "+v"(f.lo[2]), "+v"(f.lo[3]), "+v"(f.lo[4]), "+v"(f.lo[5]), "+v"(f.lo[6]), "+v"(f.lo[7]),
                 "+v"(f.hi[0]), "+v"(f.hi[1]), "+v"(f.hi[2]), "+v"(f.hi[3]), "+v"(f.hi[4]), "+v"(f.hi[5]), "+v"(f.hi[6]), "+v"(f.hi[7]) :: "memory");
#define PK(k) (bf16x8){f.lo[k][0], f.lo[k][1], f.lo[k][2], f.lo[k][3], f.hi[k][0], f.hi[k][1], f.hi[k][2], f.hi[k][3]}
    o[0] = __builtin_amdgcn_mfma_f32_32x32x16_bf16(pa0, PK(0), o[0], 0, 0, 0);
    o[1] = __builtin_amdgcn_mfma_f32_32x32x16_bf16(pa0, PK(4), o[1], 0, 0, 0);
    o[0] = __builtin_amdgcn_mfma_f32_32x32x16_bf16(pa1, PK(1), o[0], 0, 0, 0);
    o[1] = __builtin_amdgcn_mfma_f32_32x32x16_bf16(pa1, PK(5), o[1], 0, 0, 0);
    o[0] = __builtin_amdgcn_mfma_f32_32x32x16_bf16(pa2, PK(2), o[0], 0, 0, 0);
    o[1] = __builtin_amdgcn_mfma_f32_32x32x16_bf16(pa2, PK(6), o[1], 0, 0, 0);
    o[0] = __builtin_amdgcn_mfma_f32_32x32x16_bf16(pa3, PK(3), o[0], 0, 0, 0);
    o[1] = __builtin_amdgcn_mfma_f32_32x32x16_bf16(pa3, PK(7), o[1], 0, 0, 0);
#undef PK
}
constexpr int ANS = 4;
constexpr int A_K = 0, A_V = ANS * 8192, A_C = 2 * ANS * 8192, A_WSF = A_C + ANS * 2048, A_OST = A_WSF + 2048, A_END = A_OST + 8 * 4096;
static_assert(A_END <= 8 * WLDS, "attention LDS map");
__device__ __forceinline__ void attn_unit(LAS unsigned char* sh, const bf16_t* Qb, const bf16_t* __restrict__ Kb, const bf16_t* __restrict__ Vb, bf16_t* Ob,
                                          const float* __restrict__ c2seq, long qrow0, long kvbase, int p0, int nrows, int h, float TH, float CS1, int lane, int wave) {
    const int r32 = lane & 31, hi = lane >> 5;
    const unsigned lbase = (unsigned)(uintptr_t)sh;
    const bool active = wave * 32 < nrows;
    const int pw = p0 + 32 * wave;
    bf16x8 qr[4];
    { const bf16_t* Qw = Qb + (qrow0 + (active ? wave * 32 : 0) + r32) * D + h * 64;
#pragma unroll
      for (int d0 = 0; d0 < 4; ++d0) qr[d0] = *(const bf16x8*)(Qw + d0 * 16 + hi * 8); }
    const int plast = p0 + nrows - 1, tl_u = plast >> 6, tl_w = (pw + 31) >> 6;
    float cref = c2seq[p0];
    float crefw = c2seq[active ? pw : p0];
    float cv0; { const int t = tl_u - lane; int idx = 64 * t + 63; idx = idx > plast ? plast : idx; cv0 = c2seq[idx < 0 ? 0 : idx]; }
    asm volatile("" : "+v"(cref), "+v"(crefw), "+v"(cv0), "+v"(qr[0]), "+v"(qr[1]), "+v"(qr[2]), "+v"(qr[3]));
    int tstart = 0;
    for (int tb = tl_u; tb >= 0; tb -= 64) {
        const int t = tb - lane; int idx = 64 * t + 63; idx = idx > plast ? plast : idx;
        const float cv = (tb == tl_u) ? cv0 : ((t >= 0) ? c2seq[idx] : 0.f);
        const bool skip = (t >= 0) && (cref - cv < -TH);
        const unsigned long long bal = __ballot(skip);
        if (bal) { tstart = tb - (__ffsll((long long)bal) - 1) + 1; break; }
    }
    tstart = __builtin_amdgcn_readfirstlane(tstart);
    const int n = tl_u - tstart + 1;
    const bf16_t* ksrc = Kb + (kvbase + lane) * D + h * 64 + wave * 8;
    const bf16_t* vsrc = Vb + (kvbase + 16 * (wave & 3) + (lane >> 2)) * D + h * 64 + (wave >> 2) * 32 + (lane & 3) * 8;
    const float* csrc = c2seq + lane;
#define ISSUE(i_) do { const int t_ = tl_u - (i_), sl_ = (i_) & (ANS - 1); \
    glds16(ksrc + (long)t_ * 64 * D, lbase + A_K + sl_ * 8192 + wave * 1024); \
    glds16(vsrc + (long)t_ * 64 * D, lbase + A_V + sl_ * 8192 + wave * 1024); \
    glds4(csrc + t_ * 64, lbase + A_C + sl_ * 2048 + wave * 256); } while (0)
    float mhat = 0.f, l_reg = 0.f; f32x16 o[2]; o[0] = f32x16{}; o[1] = f32x16{};
    float mmin = -INFINITY;
    bool wdone = false;
    LAS float* wsf = (LAS float*)(sh + A_WSF + wave * 256);
    const int vb0 = (int)(lbase + A_V) + ((lane >> 4) & 1) * 32 + (lane & 3) * 8 + (4 * hi + ((lane & 15) >> 2)) * 64;
    const LAS unsigned char* kb0 = sh + A_K + hi * 1024 + r32 * 16;
    asm volatile("" : "+v"(qr[0]), "+v"(qr[1]), "+v"(qr[2]), "+v"(qr[3]));
    if (0 < n) ISSUE(0);
    if (1 < n) ISSUE(1);
    if (2 < n) ISSUE(2);
    for (int i = 0; i < n; ++i) {
        const int rem = n - 1 - i;
        if (rem >= 2) asm volatile("s_waitcnt vmcnt(6)" ::: "memory"); else if (rem == 1) asm volatile("s_waitcnt vmcnt(3)" ::: "memory"); else asm volatile("s_waitcnt vmcnt(0)" ::: "memory");
        asm volatile("s_waitcnt lgkmcnt(0)\n\ts_barrier" ::: "memory");
        if (i + 3 < n) ISSUE(i + 3);
        const int t = tl_u - i, sl = i & (ANS - 1);
        const LAS unsigned char* cp = sh + A_C + sl * 2048 + wave * 256;
        if (active && t < tl_w && !wdone) { const float cend = *(const LAS float*)(cp + 63 * 4); if (crefw - cend < -TH || (cref - cend) + CS1 - mmin < -152.0f) wdone = true; }
        if (active && t <= tl_w && !wdone) {
            f32x16 p0v, p1v;
            const LAS unsigned char* kbp = kb0 + sl * 8192;
            bf16x8 kf[8];
#pragma unroll
            for (int d0 = 0; d0 < 4; ++d0) { kf[2 * d0] = *(const LAS bf16x8*)(kbp + d0 * 2048); kf[2 * d0 + 1] = *(const LAS bf16x8*)(kbp + d0 * 2048 + 512); }
            { const float X = cref - mhat;
#pragma unroll
              for (int g = 0; g < 4; ++g) {
                  const f32x4 ca = *(const LAS f32x4*)(cp + (8 * g + 4 * hi) * 4), cb = *(const LAS f32x4*)(cp + (32 + 8 * g + 4 * hi) * 4);
#pragma unroll
                  for (int e = 0; e < 4; ++e) { p0v[4 * g + e] = X - ca[e]; p1v[4 * g + e] = X - cb[e]; }
              } }
            asm volatile("" : "+v"(kf[0]), "+v"(kf[1]), "+v"(kf[2]), "+v"(kf[3]), "+v"(kf[4]), "+v"(kf[5]), "+v"(kf[6]), "+v"(kf[7]));
#pragma unroll
            for (int d0 = 0; d0 < 4; ++d0) {
                p0v = __builtin_amdgcn_mfma_f32_32x32x16_bf16(kf[2 * d0], qr[d0], p0v, 0, 0, 0);
                p1v = __builtin_amdgcn_mfma_f32_32x32x16_bf16(kf[2 * d0 + 1], qr[d0], p1v, 0, 0, 0);
            }
            if (t == tl_w) {
                const int qpos = pw + r32, kq = 64 * t + 4 * hi;
#pragma unroll
                for (int r = 0; r < 16; ++r) { const int kv = kq + (r & 3) + 8 * (r >> 2); if (kv > qpos) p0v[r] = -INFINITY; if (kv + 32 > qpos) p1v[r] = -INFINITY; }
            }
            float rm, rm2;
            { float a_ = __builtin_fmaxf(__builtin_fmaxf(p0v[0], p0v[1]), p1v[0]), b_ = __builtin_fmaxf(__builtin_fmaxf(p0v[2], p0v[3]), p1v[1]); a_ = __builtin_fmaxf(__builtin_fmaxf(a_, p1v[2]), p1v[3]);
#pragma unroll
              for (int r = 4; r < 16; r += 4) { a_ = __builtin_fmaxf(__builtin_fmaxf(a_, p0v[r]), p0v[r + 1]); b_ = __builtin_fmaxf(__builtin_fmaxf(b_, p0v[r + 2]), p0v[r + 3]); a_ = __builtin_fmaxf(__builtin_fmaxf(a_, p1v[r]), p1v[r + 1]); b_ = __builtin_fmaxf(__builtin_fmaxf(b_, p1v[r + 2]), p1v[r + 3]); }
              rm = __builtin_fmaxf(a_, b_); rm2 = rm; (void)rm2; }
            { auto rr = __builtin_amdgcn_permlane32_swap(__float_as_uint(rm), __float_as_uint(rm), false, false); rm = fmaxf(__uint_as_float(rr[0]), __uint_as_float(rr[1])); }
            if (t == tl_w) {
                mhat = rm;
                { float mm = mhat; mm = fminf(mm, __shfl_xor(mm, 1)); mm = fminf(mm, __shfl_xor(mm, 2)); mm = fminf(mm, __shfl_xor(mm, 4)); mm = fminf(mm, __shfl_xor(mm, 8)); mm = fminf(mm, __shfl_xor(mm, 16)); mmin = mm; }
#pragma unroll
                for (int r = 0; r < 16; ++r) { p0v[r] -= rm; p1v[r] -= rm; }
            } else if (__any(rm > 4.0f)) {
                const float dl = fmaxf(rm, 0.f); mhat += dl;
                { float mm = mhat; mm = fminf(mm, __shfl_xor(mm, 1)); mm = fminf(mm, __shfl_xor(mm, 2)); mm = fminf(mm, __shfl_xor(mm, 4)); mm = fminf(mm, __shfl_xor(mm, 8)); mm = fminf(mm, __shfl_xor(mm, 16)); mmin = mm; }
#pragma unroll
                for (int r = 0; r < 16; ++r) { p0v[r] -= dl; p1v[r] -= dl; }
                const float f = __builtin_amdgcn_exp2f(-dl); l_reg *= f;
                if (hi == 0) wsf[r32] = f;
                asm volatile("s_waitcnt lgkmcnt(0)" ::: "memory");
#pragma unroll
                for (int r = 0; r < 16; ++r) { const float fr_ = wsf[crow(r, hi)]; o[0][r] *= fr_; o[1][r] *= fr_; }
                asm volatile("s_waitcnt lgkmcnt(0)" ::: "memory");
            }
            float sacc = 0.f;
#pragma unroll
            for (int r = 0; r < 16; ++r) { p0v[r] = __builtin_amdgcn_exp2f(p0v[r]); p1v[r] = __builtin_amdgcn_exp2f(p1v[r]); sacc += p0v[r] + p1v[r]; }
            l_reg += sacc;
            VFrag vf; pv_reads<0>(vf, vb0 + sl * 8192); pv_reads<1>(vf, vb0 + sl * 8192);
            u32x4 pw0, pw1, pw2, pw3;
            pw0 = (u32x4){pk2(p0v[0], p0v[1]), pk2(p0v[2], p0v[3]), pk2(p0v[4], p0v[5]), pk2(p0v[6], p0v[7])};
            pw1 = (u32x4){pk2(p0v[8], p0v[9]), pk2(p0v[10], p0v[11]), pk2(p0v[12], p0v[13]), pk2(p0v[14], p0v[15])};
            pw2 = (u32x4){pk2(p1v[0], p1v[1]), pk2(p1v[2], p1v[3]), pk2(p1v[4], p1v[5]), pk2(p1v[6], p1v[7])};
            pw3 = (u32x4){pk2(p1v[8], p1v[9]), pk2(p1v[10], p1v[11]), pk2(p1v[12], p1v[13]), pk2(p1v[14], p1v[15])};
            pv_mfma(o, vf, __builtin_bit_cast(bf16x8, pw0), __builtin_bit_cast(bf16x8, pw1), __builtin_bit_cast(bf16x8, pw2), __builtin_bit_cast(bf16x8, pw3));
        }
    }
#undef ISSUE
    if (active) {
        { auto rr = __builtin_amdgcn_permlane32_swap(__float_as_uint(l_reg), __float_as_uint(l_reg), false, false); l_reg = __uint_as_float(rr[0]) + __uint_as_float(rr[1]); }
        if (hi == 0) wsf[32 + r32] = l_reg;
        asm volatile("s_waitcnt lgkmcnt(0)" ::: "memory");
        float rli[16];
#pragma unroll
        for (int r = 0; r < 16; ++r) rli[r] = __builtin_amdgcn_rcpf(wsf[32 + crow(r, hi)]);
        LAS bf16_t* stg = (LAS bf16_t*)(sh + A_OST + wave * 4096);
#pragma unroll
        for (int r = 0; r < 16; ++r) { const int orow = crow(r, hi);
#pragma unroll
            for (int d0 = 0; d0 < 2; ++d0) stg[orow * 64 + d0 * 32 + r32] = (bf16_t)(pk2(o[d0][r] * rli[r], 0.f) & 0xffffu); }
        asm volatile("s_waitcnt lgkmcnt(0)" ::: "memory");
        bf16_t* Ow = Ob + (qrow0 + wave * 32) * D + h * 64;
#pragma unroll
        for (int i = 0; i < 4; ++i) { const int row = i * 8 + (lane >> 3), ch = lane & 7; const u32x4 v = *(const LAS u32x4*)(stg + row * 64 + ch * 8); *(u32x4*)(Ow + (long)row * D + ch * 8) = v; }
    }
    asm volatile("s_waitcnt lgkmcnt(0)\n\ts_barrier" ::: "memory");
}

__device__ __forceinline__ void transpose_item(const float* W, int K, int N, int ldw, const float* g, bf16_t* WT, LAS float* scr, int item, int lane, int ldo = 0) {
    if (ldo == 0) ldo = K;
    const int nblk = N / 32, kb = item / nblk, nb = item % nblk, k0 = 64 * kb, n0 = 32 * nb;
    float tv[32];
#pragma unroll
    for (int i = 0; i < 32; ++i) tv[i] = W[(size_t)(k0 + 2 * i + (lane >> 5)) * ldw + n0 + (lane & 31)];
#pragma unroll
    for (int i = 0; i < 32; ++i) scr[(2 * i + (lane >> 5)) * 33 + (lane & 31)] = tv[i];
    asm volatile("s_waitcnt lgkmcnt(0)" ::: "memory");
    const int c = lane & 7;
    float gv[8];
#pragma unroll
    for (int e = 0; e < 8; ++e) gv[e] = g ? g[k0 + 8 * c + e] : 1.0f;
#pragma unroll
    for (int j = 0; j < 4; ++j) { const int n = (lane >> 3) + 8 * j; const LAS float* s = scr + (8 * c) * 33 + n;
        u32x4 o; o.x = pk2(s[0 * 33] * gv[0], s[1 * 33] * gv[1]); o.y = pk2(s[2 * 33] * gv[2], s[3 * 33] * gv[3]); o.z = pk2(s[4 * 33] * gv[4], s[5 * 33] * gv[5]); o.w = pk2(s[6 * 33] * gv[6], s[7 * 33] * gv[7]);
        *(u32x4*)(WT + (size_t)(n0 + n) * ldo + k0 + 8 * c) = o; }
    asm volatile("s_waitcnt lgkmcnt(0)" ::: "memory");
}


__device__ __forceinline__ void epi_small(const pg8::EpiG& E, int row, int col, f32x4 v, int lane, float r, const float* xinS) {
    if (E.mode == 2) {
        const u32x2 pw = *(const u32x2*)(E.Xb + (size_t)row * 1024 + col);
        f32x4 x = {__uint_as_float(pw.x << 16), __uint_as_float(pw.x & 0xffff0000u), __uint_as_float(pw.y << 16), __uint_as_float(pw.y & 0xffff0000u)};
        x += v; if (E.Xf) *(f32x4*)(E.Xf + (size_t)row * 1024 + col) = x;
        u32x2 w; w.x = pk2(x[0], x[1]); w.y = pk2(x[2], x[3]); *(u32x2*)(E.Xb + (size_t)row * 1024 + col) = w;
        float ss = (x[0] * x[0] + x[1] * x[1]) + (x[2] * x[2] + x[3] * x[3]);
        ss += __shfl_xor(ss, 1); ss += __shfl_xor(ss, 2); ss += __shfl_xor(ss, 4); ss += __shfl_xor(ss, 8);
        if ((lane & 15) == 0) E.rpart_out[(size_t)row * 16 + (col >> 6)] = ss;
        return;
    }
    v = v * r;
    if (E.mode == 0 || E.mode == 3) {
        if (E.mode == 3) {
#pragma unroll
            for (int e = 0; e < 4; ++e) { const float a0 = fmaxf(v[e], 0.f); v[e] = a0 * a0; } }
        u32x2 w; w.x = pk2(v[0], v[1]); w.y = pk2(v[2], v[3]); *(u32x2*)(E.O + (size_t)row * E.ldc + col) = w;
        return;
    }
    const int t = col >> 10, cq = col & 1023, sr = row - SEQ;
    if (t < 2) {
        float s = (v[0] * v[0] + v[1] * v[1]) + (v[2] * v[2] + v[3] * v[3]);
        s += __shfl_xor(s, 1); s += __shfl_xor(s, 2); s += __shfl_xor(s, 4); s += __shfl_xor(s, 8);
        if ((lane & 15) == 0) atomicMax(E.qkm + (t == 0 ? 80 : 64) + (cq >> 6), __float_as_uint(s));
    }
    if (t == 0) { v = v * QC2; u32x2 w; w.x = pk2(v[0], v[1]); w.y = pk2(v[2], v[3]); *(u32x2*)(E.Qb + (size_t)row * 1024 + cq) = w; }
    else {
        const size_t kvrow = (size_t)(SEQ + (sr >> 5) * LSP + PAST + (sr & 31));
        u32x2 w; w.x = pk2(v[0], v[1]); w.y = pk2(v[2], v[3]); *(u32x2*)((t == 1 ? E.Kb : E.Vb) + kvrow * 1024 + cq) = w;
        *(f32x4*)((t == 1 ? E.outKs : E.outVs) + (size_t)sr * 1024 + cq) = v;
    }
}
__device__ __forceinline__ void small_gemm(LAS unsigned char* lds, const bf16_t* A, int lda, const bf16_t* Bt, int ldb, int N, int K, const pg8::EpiG& E, int vcu, int G, int tid, int wave, const float* xinS) {
    const int lane = tid & 63, r32 = lane & 31, hi = lane >> 5, lrow = lane >> 3, lpc = lane & 7;
    LAS float* red = (LAS float*)lds;
    LAS unsigned char* stg = lds + wave * 13824;
    const int ntile = 8 * (N >> 6), kw = K >> 3;
    for (int tile = vcu; tile < ntile; tile += G) {
        const int rb = tile & 7, cb = tile >> 3;
        const bf16_t* ag = A + (size_t)(SEQ + rb * 32 + lrow) * lda + wave * kw + lpc * 8;
        const bf16_t* bg = Bt + (size_t)(cb * 64 + lrow) * ldb + wave * kw + lpc * 8;
        f32x16 c0 = f32x16{}, c1 = f32x16{};
        const float rrow = (E.mode == 2) ? 1.0f : rinv_row(E.rpart_in, SEQ + rb * 32 + (tid >> 4));
        for (int k0 = 0; k0 < kw; k0 += 128) {
            u32x4 ra[2][4], rv[2][8];
#pragma unroll
            for (int sb = 0; sb < 2; ++sb) {
#pragma unroll
                for (int i = 0; i < 4; ++i) ra[sb][i] = *(const u32x4*)(ag + (size_t)(8 * i) * lda + k0 + sb * 64);
#pragma unroll
                for (int i = 0; i < 8; ++i) rv[sb][i] = *(const u32x4*)(bg + (size_t)(8 * i) * ldb + k0 + sb * 64);
            }
            asm volatile("" : "+v"(ra[0][0]), "+v"(ra[0][1]), "+v"(ra[0][2]), "+v"(ra[0][3]), "+v"(ra[1][0]), "+v"(ra[1][1]), "+v"(ra[1][2]), "+v"(ra[1][3]),
                              "+v"(rv[0][0]), "+v"(rv[0][1]), "+v"(rv[0][2]), "+v"(rv[0][3]), "+v"(rv[0][4]), "+v"(rv[0][5]), "+v"(rv[0][6]), "+v"(rv[0][7]),
                              "+v"(rv[1][0]), "+v"(rv[1][1]), "+v"(rv[1][2]), "+v"(rv[1][3]), "+v"(rv[1][4]), "+v"(rv[1][5]), "+v"(rv[1][6]), "+v"(rv[1][7]));
#pragma unroll
            for (int sb = 0; sb < 2; ++sb) {
#pragma unroll
                for (int i = 0; i < 4; ++i) *(LAS u32x4*)(stg + (8 * i + lrow) * 144 + lpc * 16) = ra[sb][i];
#pragma unroll
                for (int i = 0; i < 8; ++i) *(LAS u32x4*)(stg + 4608 + (8 * i + lrow) * 144 + lpc * 16) = rv[sb][i];
                bf16x8 fa[4], fb0[4], fb1[4];
#pragma unroll
                for (int ks = 0; ks < 4; ++ks) { fa[ks] = *(const LAS bf16x8*)(stg + r32 * 144 + (2 * ks + hi) * 16);
                    fb0[ks] = *(const LAS bf16x8*)(stg + 4608 + r32 * 144 + (2 * ks + hi) * 16); fb1[ks] = *(const LAS bf16x8*)(stg + 4608 + (32 + r32) * 144 + (2 * ks + hi) * 16); }
#pragma unroll
                for (int ks = 0; ks < 4; ++ks) {
                    c0 = __builtin_amdgcn_mfma_f32_32x32x16_bf16(fb0[ks], fa[ks], c0, 0, 0, 0);
                    c1 = __builtin_amdgcn_mfma_f32_32x32x16_bf16(fb1[ks], fa[ks], c1, 0, 0, 0);
                }
            }
        }
        __syncthreads();
        LAS float* wr_ = red + wave * (32 * 68) + r32 * 68 + 4 * hi;
#pragma unroll
        for (int g = 0; g < 4; ++g) {
            *(LAS f32x4*)(wr_ + 8 * g) = (f32x4){c0[4 * g], c0[4 * g + 1], c0[4 * g + 2], c0[4 * g + 3]};
            *(LAS f32x4*)(wr_ + 32 + 8 * g) = (f32x4){c1[4 * g], c1[4 * g + 1], c1[4 * g + 2], c1[4 * g + 3]};
        }
        __syncthreads();
        const int m = tid >> 4, c4 = (tid & 15) * 4;
        f32x4 v = *(const LAS f32x4*)(red + m * 68 + c4);
#pragma unroll
        for (int w = 1; w < 8; ++w) v += *(const LAS f32x4*)(red + w * (32 * 68) + m * 68 + c4);
        epi_small(E, SEQ + rb * 32 + m, cb * 64 + c4, v, lane, rrow, xinS);
        __syncthreads();
    }
}

#define XB_TMO      128
#define XB_XCNT(j)  (256  + 64 * (j))
#define XB_XSUB(j)  (1280 + 64 * (j))
#define XB_XGEN(j)  (2304 + 64 * (j))
#define XB_TOP      3328
#define XB_TOPGEN   3392
#define XCD_BAR_WORDS 3456
#define XB_SPIN_CAP (1u << 18)

__device__ __forceinline__ unsigned xb_ld(unsigned* p)              { return __hip_atomic_load(p, __ATOMIC_RELAXED, __HIP_MEMORY_SCOPE_AGENT); }
__device__ __forceinline__ unsigned xb_add(unsigned* p, unsigned v) { return __hip_atomic_fetch_add(p, v, __ATOMIC_RELAXED, __HIP_MEMORY_SCOPE_AGENT); }
__device__ __forceinline__ unsigned xb_xcc_id() { return (unsigned)__builtin_amdgcn_s_getreg((3 << 11) | 20) & 0xFu; }
#define XB_SPIN(cond, bar) do { unsigned _sp = 0; while (cond) { __builtin_amdgcn_s_sleep(1); \
    if ((++_sp & 255u) == 0u) { if (xb_ld(&(bar)[XB_TMO])) break; if (_sp > XB_SPIN_CAP) { atomicAdd(&(bar)[XB_TMO], 1u); break; } } } } while (0)

struct XcdBarrier {
    unsigned* bar; unsigned x;
    volatile LAS unsigned* st;
};

__device__ __forceinline__ XcdBarrier xcd_barrier_post(unsigned* bar, volatile LAS unsigned* st) {
    XcdBarrier b; b.bar = bar; b.x = xb_xcc_id(); b.st = st;
    if (threadIdx.x == 0) (void)xb_add(&bar[XB_XCNT(b.x)], 1u);
    return b;
}
__device__ __forceinline__ void xcd_barrier_complete(unsigned* bar, unsigned x, unsigned& nloc, unsigned& nx) {
    const unsigned G = gridDim.x * gridDim.y * gridDim.z;
    unsigned sum, cnt, mine, sp = 0u;
    for (;;) {
        sum = 0u; cnt = 0u; mine = 0u;
#pragma unroll
        for (unsigned j = 0; j < 16; ++j) { const unsigned c = xb_ld(&bar[XB_XCNT(j)]); sum += c; cnt += (c > 0u) ? 1u : 0u; mine = (j == x) ? c : mine; }
        if (sum == G) break;
        __builtin_amdgcn_s_sleep(1);
        if ((++sp & 255u) == 0u) { if (xb_ld(&bar[XB_TMO])) break; if (sp > XB_SPIN_CAP) { atomicAdd(&bar[XB_TMO], 1u); break; } }
    }
    nloc = mine > 0u ? mine : 1u; nx = cnt > 0u ? cnt : 1u;
}

__device__ __forceinline__ void xcd_barrier(const XcdBarrier& b) {
    asm volatile("s_waitcnt vmcnt(0)" ::: "memory");
    __syncthreads();
    if (threadIdx.x == 0) {
        unsigned* bar = b.bar;
        __builtin_amdgcn_s_waitcnt(0);
        unsigned nloc = b.st[0], nx = b.st[1];
        if (nloc == 0u) { xcd_barrier_complete(bar, b.x, nloc, nx); b.st[0] = nloc; b.st[1] = nx; }
        const unsigned old = xb_add(&bar[XB_XSUB(b.x)], 1u);
        const unsigned gen = old / nloc;
        if (old + 1u == (gen + 1u) * nloc) {
            __builtin_amdgcn_fence(__ATOMIC_RELEASE, "agent");
            asm volatile("s_waitcnt vmcnt(0)" ::: "memory");
            const unsigned og = xb_add(&bar[XB_TOP], 1u);
            const unsigned tg = og / nx;
            if (og + 1u == (tg + 1u) * nx) xb_add(&bar[XB_TOPGEN], 1u);
            else XB_SPIN(xb_ld(&bar[XB_TOPGEN]) == tg, bar);
            __builtin_amdgcn_fence(__ATOMIC_ACQUIRE, "agent");
            xb_add(&bar[XB_XGEN(b.x)], 1u);
            asm volatile("s_waitcnt vmcnt(0)" ::: "memory");
        } else {
            XB_SPIN(xb_ld(&bar[XB_XGEN(b.x)]) == gen, bar);
            __builtin_amdgcn_fence(__ATOMIC_ACQUIRE, "agent");
            asm volatile("s_waitcnt vmcnt(0)" ::: "memory");
        }
    }
    __syncthreads();
}

#define F1_EXTRAS() do { \
                const bf16_t* Wf = (const bf16_t*)(ws + WS_WF) + (size_t)j * 16 * 1024; \
                const int fr = lane & 15, fq = lane >> 4; \
                for (int grp = gw; grp < M / 16; grp += NGW) { \
                    const int row = grp * 16 + fr; \
                    const bf16_t* xp = Xb + (size_t)row * 1024 + fq * 8; const bf16_t* wp = Wf + (size_t)fr * 1024 + fq * 8; \
                    f32x4 acc = {0.f, 0.f, 0.f, 0.f}; \
                    const float r = rinv_row(rpart, row); \
                    const f32x4 bf = *(const f32x4*)(fox_b_f + j * 16 + 4 * fq); \
                    for (int k0 = 0; k0 < 32; k0 += 8) { \
                        bf16x8 xa[8], wa[8]; \
_Pragma("unroll") \
                        for (int ks = 0; ks < 8; ++ks) { xa[ks] = *(const bf16x8*)(xp + (k0 + ks) * 32); wa[ks] = *(const bf16x8*)(wp + (k0 + ks) * 32); } \
                        asm volatile("" : "+v"(xa[0]), "+v"(xa[1]), "+v"(xa[2]), "+v"(xa[3]), "+v"(xa[4]), "+v"(xa[5]), "+v"(xa[6]), "+v"(xa[7]), \
                                          "+v"(wa[0]), "+v"(wa[1]), "+v"(wa[2]), "+v"(wa[3]), "+v"(wa[4]), "+v"(wa[5]), "+v"(wa[6]), "+v"(wa[7])); \
_Pragma("unroll") \
                        for (int ks = 0; ks < 8; ++ks) acc = __builtin_amdgcn_mfma_f32_16x16x32_bf16(wa[ks], xa[ks], acc, 0, 0, 0); \
                    } \
                    f32x4 lf; \
_Pragma("unroll") \
                    for (int e = 0; e < 4; ++e) { const float x = acc[e] * r + bf[e]; lf[e] = fminf(x, 0.f) - log1pf(expf(-fabsf(x))); } \
                    *(f32x4*)(LF + (size_t)row * 16 + 4 * fq) = lf; \
                    float* op = (row < SEQ) ? out + O_PLF + ((size_t)j * SEQ + row) * 16 : out + O_SLF + ((size_t)j * MS + (row - SEQ)) * 16; \
                    *(f32x4*)(op + 4 * fq) = lf; \
                } \
                { \
                    const float* ck = cache_k + (size_t)j * NSB * PAST * 1024; const float* cv = cache_v + (size_t)j * NSB * PAST * 1024; \
                    float kmax = 0.f; \
                    for (int hr0 = gw; hr0 < NSB * PAST * 2; hr0 += 4 * NGW) { \
                        f32x4 kk[4][2], vv[4][2]; \
_Pragma("unroll") \
                        for (int q = 0; q < 4; ++q) { const int hr = hr0 + q * NGW; const int b = hr >> 12, pos = (hr >> 1) & 2047, half = hr & 1; \
                            const size_t so = ((size_t)(b * PAST + pos)) * 1024 + half * 512 + lane * 8; \
                            kk[q][0] = *(const f32x4*)(ck + so); kk[q][1] = *(const f32x4*)(ck + so + 4); vv[q][0] = *(const f32x4*)(cv + so); vv[q][1] = *(const f32x4*)(cv + so + 4); } \
_Pragma("unroll") \
                        for (int q = 0; q < 4; ++q) { const int hr = hr0 + q * NGW; const int b = hr >> 12, pos = (hr >> 1) & 2047, half = hr & 1; \
                            const size_t dofs = ((size_t)(SEQ + b * LSP + pos)) * 1024 + half * 512 + lane * 8; \
                            const f32x4 k0 = kk[q][0], k1 = kk[q][1], v0 = vv[q][0], v1 = vv[q][1]; \
                            u32x4 w; w.x = pk2(k0[0], k0[1]); w.y = pk2(k0[2], k0[3]); w.z = pk2(k1[0], k1[1]); w.w = pk2(k1[2], k1[3]); \
                            *(u32x4*)(Kb + dofs) = w; \
                            w.x = pk2(v0[0], v0[1]); w.y = pk2(v0[2], v0[3]); w.z = pk2(v1[0], v1[1]); w.w = pk2(v1[2], v1[3]); \
                            *(u32x4*)(Vb + dofs) = w; \
                            float s = (k0[0] * k0[0] + k0[1] * k0[1]) + (k0[2] * k0[2] + k0[3] * k0[3]) + (k1[0] * k1[0] + k1[1] * k1[1]) + (k1[2] * k1[2] + k1[3] * k1[3]); \
                            s += __shfl_xor(s, 1); s += __shfl_xor(s, 2); s += __shfl_xor(s, 4); \
                            kmax = fmaxf(kmax, s); } \
                    } \
                    if ((lane & 7) == 0) atomicMax((unsigned*)(ws + WS_QKM) + j * 128 + 64 + (gw & 1) * 8 + (lane >> 3), __float_as_uint(kmax)); \
                    if (gw < NSB * 32) { \
                        const size_t dofs = ((size_t)(SEQ + (gw >> 5) * LSP + PAST + TS + (gw & 31))) * 1024 + lane * 16; \
                        const u32x4 z = {0u, 0u, 0u, 0u}; \
                        *(u32x4*)(Kb + dofs) = z; *(u32x4*)(Kb + dofs + 8) = z; *(u32x4*)(Vb + dofs) = z; *(u32x4*)(Vb + dofs + 8) = z; \
                    } \
                } \
} while (0)

template <bool COOP>
__global__ void __launch_bounds__(512, 2) fwd(Args a) {
    extern __shared__ __attribute__((aligned(16))) unsigned char smem[];
    LAS unsigned char* lds = (LAS unsigned char*)smem;
    const int tid0 = threadIdx.x, wave = __builtin_amdgcn_readfirstlane(tid0 >> 6);
    const int G = gridDim.x, bx = blockIdx.x;
    const int vcu = (G % 8 == 0) ? (bx % 8) * (G / 8) + bx / 8 : bx;
    const int gw = vcu * 8 + wave, NGW = G * 8;
    unsigned char* ws = a.ws;
    float* rpart = (float*)(ws + WS_RPART);
    float* LF = (float*)(ws + WS_LF);
    float* c2p = (float*)(ws + WS_C2P);
    float* c2s = (float*)(ws + WS_C2S);
    float* Xf = (float*)(ws + WS_XF);
    bf16_t* Xb = (bf16_t*)(ws + WS_XB);
    bf16_t* A2 = (bf16_t*)(ws + WS_A2);
    bf16_t* OV = (bf16_t*)(ws + WS_OV);
    bf16_t* Qb = (bf16_t*)(ws + WS_Q);
    bf16_t* Kb = (bf16_t*)(ws + WS_K);
    bf16_t* Vb = (bf16_t*)(ws + WS_V);
    const float* x_prompt = a.in[0]; const float* x_sample = a.in[1]; const float* state_conv = a.in[2];
    const float* cache_k = a.in[3]; const float* cache_v = a.in[4]; const float* cache_lf = a.in[5];
    const float* norm_mix = a.in[6]; const float* norm_mlp = a.in[7]; const float* norm_final = a.in[8];
    const float* conv_w_in = a.in[9]; const float* conv_w = a.in[10]; const float* conv_w_out = a.in[11];
    const float* fox_w_in = a.in[12]; const float* fox_b_f = a.in[13]; const float* fox_w_out = a.in[14];
    const float* mlp_w1 = a.in[15]; const float* mlp_w2 = a.in[16];
    float* out = a.out;
    volatile LAS unsigned* misc = (volatile LAS unsigned*)(lds + LDS_CTL);
    if (tid0 < 4) misc[tid0] = 0u;
    __syncthreads();
    XcdBarrier xbar; xbar.bar = (unsigned*)(ws + WS_BAR); xbar.x = 0; xbar.st = misc;

    for (int step = a.lo; step < a.hi; ++step) {
        if constexpr (COOP) {
            if (step == a.lo + 1) { cg::this_grid().sync(); xbar = xcd_barrier_post((unsigned*)(ws + WS_BAR), misc); }
            else if (step > a.lo + 1) xcd_barrier(xbar);
        }
        int kind;
        int j = 0, layer = 0;
        if (step == 0) kind = 0;
        else if (step == 23) kind = 10;
        else { const int s = step - 1; j = s / 11; const int r = s % 11;
            if (r < 5) { layer = 2 * j; kind = (r < 3) ? 1 + r : 4 + (r - 3); }
            else { layer = 2 * j + 1; const int q = r - 5; kind = (q < 4) ? 6 + q : 4 + (q - 4); } }

        for (int rep = 0; rep < ((kind == REPEAT_KIND) ? 2 : 1); ++rep) {
        int tid = tid0; asm volatile("" : "+v"(tid));
        const int lane = tid & 63;
        if (kind == 1 || kind == 3 || kind == 4 || kind == 5 || kind == 6 || kind == 9) {
            pg8::Gemm g; pg8::EpiG E{};
            E.rpart_in = rpart; E.rpart_out = rpart; E.Xf = nullptr; E.Xb = Xb;
            if (kind == 1) { g = pg8::Gemm{Xb, (const bf16_t*)(ws + W_CIN + (size_t)j * 6 * MiB), M, 3072, 1024, 1024, 1024}; E.mode = 0; E.O = OV; E.ldc = 3072; }
            else if (kind == 3) { g = pg8::Gemm{A2, (const bf16_t*)(ws + W_COUT + (size_t)j * 2 * MiB), M, 1024, 1024, 1024, 1024}; E.mode = 2; }
            else if (kind == 4) { g = pg8::Gemm{Xb, (const bf16_t*)(ws + W_1 + (size_t)layer * 8 * MiB), M, 4096, 1024, 1024, 1024}; E.mode = 3; E.O = OV; E.ldc = HLD; }
            else if (kind == 5) { g = pg8::Gemm{OV, (const bf16_t*)(ws + W_2 + (size_t)layer * 9 * MiB), M, 1024, 4096, HLD, HLD}; E.mode = 2; }
            else if (kind == 6) { g = pg8::Gemm{Xb, (const bf16_t*)(ws + W_FIN + (size_t)j * 6 * MiB), M, 3072, 1024, 1024, 1024}; E.mode = 1;
                E.Qb = Qb; E.Kb = Kb; E.Vb = Vb; E.qkm = (unsigned*)(ws + WS_QKM) + j * 128;
                E.outKp = out + O_PK + (size_t)j * SEQ * 1024; E.outVp = out + O_PV + (size_t)j * SEQ * 1024;
                E.outKs = out + O_SK + (size_t)j * MS * 1024; E.outVs = out + O_SV + (size_t)j * MS * 1024; }
            else { g = pg8::Gemm{A2, (const bf16_t*)(ws + W_FO + (size_t)j * 2 * MiB), M, 1024, 1024, 1024, 1024}; E.mode = 2; }
            if (rep == 1 && E.mode == 2) { E.Xf = (float*)(ws + 410 * MiB); E.Xb = (bf16_t*)(ws + 479 * MiB); E.rpart_out = (float*)(ws + 514 * MiB); }
            const bool first_res = (kind == 3 && j == 0);
            E.XinP = first_res ? x_prompt : Xf; const float* xinS = first_res ? x_sample : Xf + (size_t)SEQ * 1024;
            E.rl = (const PG8_LAS float*)(lds + 131072); E.pm0 = -1;
            g.M = SEQ;
            pg8::StaticOrder S; S.init(g.M, g.N, G, bx);
            if (kind == 6 && (bx & 1)) F1_EXTRAS();
            if (E.mode != 2) {
                pg8::Unit u0; S.next(0, u0); E.pm0 = u0.pm;
                const int row = u0.pm * 256 + (tid >> 1); const f32x4* rp = (const f32x4*)(rpart + (size_t)row * 16 + (tid & 1) * 8);
                const f32x4 a_ = rp[0], b_ = rp[1]; float s_ = ((a_[0] + a_[1]) + (a_[2] + a_[3])) + ((b_[0] + b_[1]) + (b_[2] + b_[3]));
                s_ += __shfl_xor(s_, 1);
                if ((tid & 1) == 0) ((LAS float*)(lds + 131072))[tid >> 1] = 1.0f / sqrtf(s_ * (1.0f / 1024.0f) + EPS);
                __syncthreads();
            }
            pg8::gemm_phase<pg8::EpiG, pg8::StaticOrder, true, true>(lds, g, S, E);
            small_gemm(lds, g.A, g.lda, g.Bt, g.ldb, g.N, g.K, E, vcu, G, tid, wave, xinS);
            if (kind == 6 && !(bx & 1)) F1_EXTRAS();
        } else if (kind == 0) {
            LAS float* scr = (LAS float*)(lds + wave * 16384);
            for (int it = gw; it < 24576; it += NGW) {
                if (it < 8192) { const int jj = it >> 12, r = it & 4095;
                    if (r < 1536) transpose_item(conv_w_in + (size_t)jj * 1024 * 3072, 1024, 3072, 3072, norm_mix + (2 * jj) * 1024, (bf16_t*)(ws + W_CIN + (size_t)jj * 6 * MiB), scr, r, lane);
                    else if (r < 2048) transpose_item(conv_w_out + (size_t)jj * 1024 * 1024, 1024, 1024, 1024, nullptr, (bf16_t*)(ws + W_COUT + (size_t)jj * 2 * MiB), scr, r - 1536, lane);
                    else if (r < 3584) transpose_item(fox_w_in + (size_t)jj * 1024 * 3088, 1024, 3072, 3088, norm_mix + (2 * jj + 1) * 1024, (bf16_t*)(ws + W_FIN + (size_t)jj * 6 * MiB), scr, r - 2048, lane);
                    else transpose_item(fox_w_out + (size_t)jj * 1024 * 1024, 1024, 1024, 1024, nullptr, (bf16_t*)(ws + W_FO + (size_t)jj * 2 * MiB), scr, r - 3584, lane);
                } else { const int r0 = it - 8192, i = r0 >> 12, r = r0 & 4095;
                    if (r < 2048) transpose_item(mlp_w1 + (size_t)i * 1024 * 4096, 1024, 4096, 4096, norm_mlp + i * 1024, (bf16_t*)(ws + W_1 + (size_t)i * 8 * MiB), scr, r, lane);
                    else transpose_item(mlp_w2 + (size_t)i * 4096 * 1024, 4096, 1024, 1024, nullptr, (bf16_t*)(ws + W_2 + (size_t)i * 9 * MiB), scr, r - 2048, lane, HLD);
                }
            }
            for (int idx = gw * 64 + lane; idx < 2 * 16 * 1024; idx += NGW * 64) {
                const int jj = idx >> 14, hh = (idx >> 10) & 15, k = idx & 1023;
                const float v = fox_w_in[(size_t)jj * 1024 * 3088 + (size_t)k * 3088 + 3072 + hh] * norm_mix[(2 * jj + 1) * 1024 + k];
                ((bf16_t*)(ws + WS_WF))[idx] = (bf16_t)(pk2(v, 0.f) & 0xffffu);
            }
            for (int m = gw; m < M; m += NGW) {
                const float* xr = (m < SEQ) ? x_prompt + (size_t)m * 1024 : x_sample + (size_t)(m - SEQ) * 1024;
                f32x4 v[4]; float s = 0.f;
#pragma unroll
                for (int q = 0; q < 4; ++q) { v[q] = *(const f32x4*)(xr + q * 256 + lane * 4); s += (v[q][0] * v[q][0] + v[q][1] * v[q][1]) + (v[q][2] * v[q][2] + v[q][3] * v[q][3]); }
                s = wave_sum(s);
#pragma unroll
                for (int q = 0; q < 4; ++q) {
                    u32x2 w; w.x = pk2(v[q][0], v[q][1]); w.y = pk2(v[q][2], v[q][3]); *(u32x2*)(Xb + (size_t)m * 1024 + q * 256 + lane * 4) = w; }
                if (lane < 16) rpart[(size_t)m * 16 + lane] = (lane == 0) ? s : 0.f;
            }
            if (bx == 0) { ((unsigned*)(ws + WS_QKM))[tid] = 0u; for (int i = tid; i < XCD_BAR_WORDS; i += 512) ((unsigned*)(ws + WS_BAR))[i] = 0u; }
        } else if (kind == 2) {
            const bf16_t* BCH = OV; const float* cw = conv_w + (size_t)j * 3 * 1024;
            for (int it = gw; it < 2 * (SEQ / 16) + 2 * (MS / 4); it += NGW) {
                int ch, row0, R;
                if (it < 2 * (SEQ / 16)) { ch = it & 1; row0 = (it >> 1) * 16; R = 16; } else { const int s_ = it - 2 * (SEQ / 16); ch = s_ & 1; row0 = SEQ + (s_ >> 1) * 4; R = 4; }
                const int col = ch * 512 + lane * 8;
                float w0[8], w1[8], w2[8], um2[8], um1[8];
#pragma unroll
                for (int e = 0; e < 8; ++e) { w0[e] = cw[col + e]; w1[e] = cw[1024 + col + e]; w2[e] = cw[2048 + col + e]; }
                const bool samp = row0 >= SEQ; const int t0 = samp ? ((row0 - SEQ) & 31) : row0;
                if (t0 == 0) {
                    if (samp) { const int b = (row0 - SEQ) >> 5; const float* sp = state_conv + ((size_t)(j * NSB + b) * 2) * 1024 + col;
#pragma unroll
                        for (int e = 0; e < 8; ++e) { um2[e] = sp[e]; um1[e] = sp[1024 + e]; } }
                    else {
#pragma unroll
                        for (int e = 0; e < 8; ++e) { um2[e] = 0.f; um1[e] = 0.f; } }
                } else {
#pragma unroll
                    for (int q = 0; q < 2; ++q) { const bf16_t* rp = BCH + (size_t)(row0 - 2 + q) * 3072 + col;
                        const u32x4 c = *(const u32x4*)(rp + 1024), hh = *(const u32x4*)(rp + 2048);
#pragma unroll
                        for (int e = 0; e < 4; ++e) { const float ulo = bf_lo(c[e]) * bf_lo(hh[e]), uhi = bf_hi(c[e]) * bf_hi(hh[e]);
                            if (q == 0) { um2[2 * e] = ulo; um2[2 * e + 1] = uhi; } else { um1[2 * e] = ulo; um1[2 * e + 1] = uhi; } } }
                }
                for (int r4 = 0; r4 < R; r4 += 4) {
                u32x4 bbq[4], cq[4], hq[4];
#pragma unroll
                for (int q = 0; q < 4; ++q) { const bf16_t* rp = BCH + (size_t)(row0 + r4 + q) * 3072 + col; bbq[q] = *(const u32x4*)rp; cq[q] = *(const u32x4*)(rp + 1024); hq[q] = *(const u32x4*)(rp + 2048); }
                asm volatile("" : "+v"(bbq[0]), "+v"(bbq[1]), "+v"(bbq[2]), "+v"(bbq[3]), "+v"(cq[0]), "+v"(cq[1]), "+v"(cq[2]), "+v"(cq[3]), "+v"(hq[0]), "+v"(hq[1]), "+v"(hq[2]), "+v"(hq[3]));
#pragma unroll
                for (int q = 0; q < 4; ++q) {
                    const int r = r4 + q; const int row = row0 + r;
                    const u32x4 bb = bbq[q], c = cq[q], hh = hq[q];
                    float uu[8], vv[8];
#pragma unroll
                    for (int e = 0; e < 4; ++e) { uu[2 * e] = bf_lo(c[e]) * bf_lo(hh[e]); uu[2 * e + 1] = bf_hi(c[e]) * bf_hi(hh[e]); }
#pragma unroll
                    for (int e = 0; e < 4; ++e) {
                        vv[2 * e] = bf_lo(bb[e]) * (w0[2 * e] * um2[2 * e] + w1[2 * e] * um1[2 * e] + w2[2 * e] * uu[2 * e]);
                        vv[2 * e + 1] = bf_hi(bb[e]) * (w0[2 * e + 1] * um2[2 * e + 1] + w1[2 * e + 1] * um1[2 * e + 1] + w2[2 * e + 1] * uu[2 * e + 1]); }
                    u32x4 w; w.x = pk2(vv[0], vv[1]); w.y = pk2(vv[2], vv[3]); w.z = pk2(vv[4], vv[5]); w.w = pk2(vv[6], vv[7]);
                    *(u32x4*)(A2 + (size_t)row * 1024 + col) = w;
                    float* so = nullptr;
                    if (!samp) { if (row >= SEQ - 2) so = out + O_PCONV + ((size_t)j * 2 + (row - (SEQ - 2))) * 1024 + col; }
                    else { const int sr = row - SEQ, tt = sr & 31; if (tt >= 30) so = out + O_SCONV + ((size_t)(j * NSB + (sr >> 5)) * 2 + (tt - 30)) * 1024 + col; }
                    if (so) { *(f32x4*)so = (f32x4){uu[0], uu[1], uu[2], uu[3]}; *(f32x4*)(so + 4) = (f32x4){uu[4], uu[5], uu[6], uu[7]}; }
#pragma unroll
                    for (int e = 0; e < 8; ++e) { um2[e] = um1[e]; um1[e] = uu[e]; }
                }
                }
            }
        } else if (kind == 7) {
            if (bx < 144) {
                LAS float* red = (LAS float*)(lds + 80 * 1024);
                LAS float* sv = (LAS float*)lds;
                const bool pr = bx < 16; const int hh = pr ? bx : ((bx - 16) & 15), b = pr ? 0 : ((bx - 16) >> 4);
                const int n = pr ? SEQ : (PAST + TS), per = pr ? 32 : 5;
                const float* clf = cache_lf + ((size_t)(j * NSB + b) * PAST) * 16 + hh;
                const float* nlf = pr ? LF + hh : LF + (size_t)(SEQ + b * 32) * 16 + hh;
                float* dst = pr ? c2p + (size_t)hh * SEQ : c2s + (size_t)(b * 16 + hh) * LSP;
                if (pr) {
                    float v[32];
#pragma unroll
                    for (int i = 0; i < 32; ++i) v[i] = nlf[(size_t)(i * 512 + tid) * 16];
#pragma unroll
                    for (int i = 0; i < 32; ++i) { const int pos = i * 512 + tid; sv[pos + (pos >> 5)] = v[i]; }
                } else {
                    float v[5];
#pragma unroll
                    for (int i = 0; i < 5; ++i) { const int pos = i * 512 + tid; v[i] = (pos < PAST) ? clf[(size_t)pos * 16] : (pos < n ? nlf[(size_t)(pos - PAST) * 16] : 0.f); }
#pragma unroll
                    for (int i = 0; i < 5; ++i) { const int pos = i * 512 + tid; sv[pos + (pos >> 5)] = v[i]; }
                }
                __syncthreads();
                const int s0 = tid * per; float tot = 0.f;
                for (int i = 0; i < per; ++i) { const int pos = s0 + i; if (pos < n) tot += sv[pos + (pos >> 5)]; }
                float inc = tot;
#pragma unroll
                for (int o = 1; o < 64; o <<= 1) { const float t = __shfl_up(inc, o); if (lane >= o) inc += t; }
                if (lane == 63) red[wave] = inc;
                __syncthreads();
                float run = inc - tot;
                for (int w = 0; w < wave; ++w) run += red[w];
                for (int i = 0; i < per; ++i) { const int pos = s0 + i; if (pos < n) { run += sv[pos + (pos >> 5)]; sv[pos + (pos >> 5)] = run * LOG2E; } }
                __syncthreads();
                for (int pos = tid; pos < n; pos += 512) dst[pos] = sv[pos + (pos >> 5)];
                __syncthreads();
            }
        } else if (kind == 8) {
            const unsigned* qkm = (const unsigned*)(ws + WS_QKM) + j * 128;
            unsigned* qctr = (unsigned*)(ws + WS_QKM) + 256 + j * 64;
            volatile LAS int* aord = (volatile LAS int*)(lds + A_END); volatile LAS float* atot = (volatile LAS float*)(lds + A_END + 64); volatile LAS unsigned* aq = (volatile LAS unsigned*)(lds + A_END + 128);
            volatile LAS float* acs = (volatile LAS float*)(lds + A_END + 192);
            if (tid < 16) { atot[tid] = c2p[(size_t)tid * SEQ + SEQ - 1];
                const float qn2_ = fmaxf(__uint_as_float(qkm[tid * 2]) + __uint_as_float(qkm[tid * 2 + 1]), __uint_as_float(qkm[80 + tid]));
                const float kn2_ = fmaxf(__uint_as_float(qkm[32 + tid * 2]) + __uint_as_float(qkm[32 + tid * 2 + 1]), __uint_as_float(qkm[64 + tid]));
                acs[tid] = QC2 * 1.02f * sqrtf(qn2_ * kn2_); }
            __syncthreads();
            if (tid < 16) { const float me = atot[tid]; int rk = 0; for (int o2 = 0; o2 < 16; ++o2) { const float ot = atot[o2]; rk += (ot > me || (ot == me && o2 < tid)) ? 1 : 0; } aord[rk] = tid; }
            __syncthreads();
            if (tid == 0) aq[0] = atomicAdd(qctr, 1u);
            __syncthreads();
            int q = (int)aq[0];
            while (q < 1024 + 128) {
                unsigned nq = 0u; if (tid == 0) nq = atomicAdd(qctr, 1u);
                int hh, nrows, p0; long qrow0, kvbase; const float* c2seq;
                if (q >= 128) { const int qq = q - 128; hh = aord[qq >> 6]; const int qb = 63 - (qq & 63); qrow0 = 256 * qb; kvbase = 0; p0 = 256 * qb; nrows = 256; c2seq = c2p + (size_t)hh * SEQ; }
                else { const int sI = q, b = sI >> 4;   hh = sI & 15; qrow0 = SEQ + 32 * b; kvbase = SEQ + (long)b * LSP; p0 = PAST; nrows = 32; c2seq = c2s + (size_t)(b * 16 + hh) * LSP; }
                const float CS1 = acs[hh];
                const float TH = 2.0f * CS1 + 152.0f;
                attn_unit(lds, Qb, Kb, Vb, A2, c2seq, qrow0, kvbase, p0, nrows, hh, TH, CS1, lane, wave);
                if (tid == 0) aq[0] = nq;
                __syncthreads();
                q = (int)aq[0];
                __syncthreads();
            }
        } else {
            f32x4 gg[4];
#pragma unroll
            for (int q = 0; q < 4; ++q) gg[q] = *(const f32x4*)(norm_final + q * 256 + lane * 4);
            for (int m = gw; m < M; m += NGW) {
                const f32x4* rp = (const f32x4*)(rpart + (size_t)m * 16);
                f32x4 ra = rp[0], rb = rp[1], rc = rp[2], rd = rp[3], v[4];
                u32x2 xw[4];
#pragma unroll
                for (int q = 0; q < 4; ++q) xw[q] = *(const u32x2*)(Xb + (size_t)m * 1024 + q * 256 + lane * 4);
                asm volatile("" : "+v"(ra), "+v"(rb), "+v"(rc), "+v"(rd), "+v"(xw[0]), "+v"(xw[1]), "+v"(xw[2]), "+v"(xw[3]));
#pragma unroll
                for (int q = 0; q < 4; ++q) v[q] = (f32x4){__uint_as_float(xw[q].x << 16), __uint_as_float(xw[q].x & 0xffff0000u), __uint_as_float(xw[q].y << 16), __uint_as_float(xw[q].y & 0xffff0000u)};
                const float sN = ((ra[0] + ra[1]) + (ra[2] + ra[3])) + ((rb[0] + rb[1]) + (rb[2] + rb[3])) + ((rc[0] + rc[1]) + (rc[2] + rc[3])) + ((rd[0] + rd[1]) + (rd[2] + rd[3]));
                const float r = 1.0f / sqrtf(sN * (1.0f / 1024.0f) + EPS);
#pragma unroll
                for (int q = 0; q < 4; ++q) __builtin_nontemporal_store(v[q] * r * gg[q], (f32x4*)(out + O_Y + (size_t)m * 1024 + q * 256 + lane * 4));
            }
        }
        }
    }
}

constexpr int NSTEPS = 24;
extern "C" void kernel_launch(void* const* d_in, const int* in_sizes, int n_in, void* d_out, int out_size, void* d_ws, size_t ws_size, hipStream_t stream) {
    static int grid = 0;
    if (grid == 0) {
        if (n_in != 17 || ws_size < WS_END) { fprintf(stderr, "kernel_launch: unexpected n_in %d or workspace %zu < %zu\n", n_in, ws_size, (size_t)WS_END); grid = -1; return; }
        int dev = 0, cus = 0, per_cu = 0;
        hipGetDevice(&dev); hipDeviceGetAttribute(&cus, hipDeviceAttributeMultiprocessorCount, dev);
        hipFuncSetAttribute((const void*)fwd<true>, hipFuncAttributeMaxDynamicSharedMemorySize, LDS_BYTES);
        hipFuncSetAttribute((const void*)fwd<false>, hipFuncAttributeMaxDynamicSharedMemorySize, LDS_BYTES);
        hipOccupancyMaxActiveBlocksPerMultiprocessor(&per_cu, (const void*)fwd<true>, 512, LDS_BYTES);
        (void)hipGetLastError();
        if (per_cu < 1) per_cu = 1;
        grid = cus * 1;
        fprintf(stderr, "kernel_launch: cus %d per_cu %d grid %d\n", cus, per_cu, grid);
    }
    if (grid < 0) return;
    Args a{};
    for (int i = 0; i < 17; ++i) a.in[i] = (const float*)d_in[i];
    a.out = (float*)d_out; a.ws = (unsigned char*)d_ws;
#if MULTI_LAUNCH
    for (int p = 0; p < NSTEPS; ++p) { a.lo = p; a.hi = p + 1; hipLaunchKernelGGL(fwd<false>, dim3(grid), dim3(512), LDS_BYTES, stream, a); }
#else
    a.lo = 0; a.hi = NSTEPS;
    void* args[] = {&a};
    hipError_t e = hipLaunchCooperativeKernel((const void*)fwd<true>, dim3(grid), dim3(512), args, LDS_BYTES, stream);
    if (e != hipSuccess) fprintf(stderr, "cooperative launch failed: %s (grid %d)\n", hipGetErrorString(e), grid);
#endif
}
```
